# Optimizing an MI355X kernel written in HIP

```python
import math
import jax, jax.numpy as jnp
from jax import lax
import numpy as np

D_MODEL = 1024
BATCH = 1
SEQ = 16384
DEPTH = 4

GRID_W = 64
CTX_LEN = 256
HEAD_DIM = 64
BLK = 128
WINDOW = 128
ROPE_THETA = 10000.0
EPS = 1e-6
NEG = -1e30
N_HEADS_A = 8
N_KV_A = 2
GROUP_A = N_HEADS_A // N_KV_A
N_HEADS_B = 8
N_KV_B = 2
GROUP_B = N_HEADS_B // N_KV_B
QA_W = N_HEADS_A * HEAD_DIM
KVA_W = N_KV_A * HEAD_DIM
QB_W = N_HEADS_B * HEAD_DIM
KVB_W = N_KV_B * HEAD_DIM
IN_AB = QA_W + 2 * KVA_W + QB_W + 2 * KVB_W
AB_SPLITS = (QA_W, QA_W + KVA_W, QA_W + 2 * KVA_W, QA_W + 2 * KVA_W + QB_W, QA_W + 2 * KVA_W + QB_W + KVB_W)
MIX_AB = QA_W + QB_W
N_HEADS_C = 8
DV_C = 2 * HEAD_DIM
IN_C = 3 * N_HEADS_C * DV_C
MIX_C = N_HEADS_C * DV_C
N_GROUPS = 4
EXPERTS_PER_GROUP = 8
N_EXPERTS = N_GROUPS * EXPERTS_PER_GROUP
TOP_K = 2
D_EXPERT = 512
N_EVEN = (DEPTH + 1) // 2
N_ODD = DEPTH // 2

kernel_name = 'hybrid_dit_window_axial_diffattn_hmoe'


def rms_norm(x, g):
    xf = x.astype(jnp.float32)
    y = xf * lax.rsqrt(jnp.mean(xf * xf, axis=-1, keepdims=True) + EPS)
    return (y * g.astype(jnp.float32)).astype(x.dtype)


def modulate(x, g, shift, scale):
    return rms_norm(x, g) * (1 + scale) + shift


def axial_rope_tables(rows_n):
    rows = jnp.broadcast_to(jnp.arange(rows_n, dtype=jnp.float32)[:, None], (rows_n, GRID_W)).reshape(-1)
    cols = jnp.broadcast_to(jnp.arange(GRID_W, dtype=jnp.float32)[None, :], (rows_n, GRID_W)).reshape(-1)
    half = HEAD_DIM // 2
    inv = ROPE_THETA ** (-jnp.arange(0, half, 2, dtype=jnp.float32) / half)
    ang = jnp.concatenate([rows[:, None] * inv, cols[:, None] * inv], axis=-1)
    return jnp.cos(ang), jnp.sin(ang)


def apply_rope(x, cos, sin):
    shp = (1, cos.shape[0]) + (1,) * (x.ndim - 3) + (cos.shape[1],)
    cos = cos.reshape(shp)
    sin = sin.reshape(shp)
    x1, x2 = jnp.split(x.astype(jnp.float32), 2, axis=-1)
    return jnp.concatenate([x1 * cos - x2 * sin, x2 * cos + x1 * sin], axis=-1).astype(x.dtype)


def gqa_sweep(q, k, v):
    b, l, hkv, g, d = q.shape
    qb = q.reshape(b, l // BLK, BLK, hkv, g, d).transpose(1, 0, 2, 3, 4, 5)
    scale = d ** -0.5

    def one_block(qi):
        s = jnp.einsum('bqhgd,bkhd->bhgqk', qi, k).astype(jnp.float32) * scale
        p = jax.nn.softmax(s, axis=-1).astype(v.dtype)
        return jnp.einsum('bhgqk,bkhd->bqhgd', p, v)

    o = lax.map(one_block, qb)
    return o.transpose(1, 0, 2, 3, 4, 5).reshape(b, l, hkv, g, d)


def window_sink_attention(q, k, v, kc, vc, sink):
    b, seq, hkv, g, d = q.shape
    nb = seq // BLK
    qb = q.reshape(b, nb, BLK, hkv, g, d)

    def bands(t):
        tp = jnp.pad(t, ((0, 0), (BLK, BLK), (0, 0), (0, 0))).reshape(b, nb + 2, BLK, hkv, d)
        return jnp.concatenate([tp[:, :-2], tp[:, 1:-1], tp[:, 2:]], axis=2)

    kw, vw = bands(k), bands(v)
    qi = jnp.arange(BLK)[:, None]
    ki = jnp.arange(3 * BLK)[None, :]
    rel = ki - BLK - qi
    kpos = jnp.arange(nb)[:, None, None] * BLK + ki[None] - BLK
    mask = (jnp.abs(rel)[None] <= WINDOW) & (kpos >= 0) & (kpos < seq)
    scale = d ** -0.5
    s_loc = jnp.einsum('bnqhgd,bnkhd->bnhgqk', qb, kw).astype(jnp.float32) * scale
    s_loc = jnp.where(mask[None, :, None, None], s_loc, NEG)
    s_ctx = jnp.einsum('bnqhgd,bchd->bnhgqc', qb, kc).astype(jnp.float32) * scale
    sink_col = jnp.broadcast_to(sink.astype(jnp.float32)[None, None, :, :, None, None], s_loc.shape[:-1] + (1,))
    p = jax.nn.softmax(jnp.concatenate([s_loc, s_ctx, sink_col], axis=-1), axis=-1).astype(v.dtype)
    o = (jnp.einsum('bnhgqk,bnkhd->bnqhgd', p[..., :3 * BLK], vw)
         + jnp.einsum('bnhgqc,bchd->bnqhgd', p[..., 3 * BLK:-1], vc))
    return o.reshape(b, seq, hkv, g, d)


def ctx_sink_attention(q, k, v, sink):
    scale = q.shape[-1] ** -0.5
    s = jnp.einsum('bqhgd,bkhd->bhgqk', q, k).astype(jnp.float32) * scale
    sink_col = jnp.broadcast_to(sink.astype(jnp.float32)[None, :, :, None, None], s.shape[:-1] + (1,))
    p = jax.nn.softmax(jnp.concatenate([s, sink_col], axis=-1), axis=-1)[..., :-1].astype(v.dtype)
    return jnp.einsum('bhgqk,bkhd->bqhgd', p, v)


def diff_sweep(q, k, v, lam):
    b, l, h, _, d = q.shape
    qb = q.reshape(b, l // BLK, BLK, h, 2, d).transpose(1, 0, 2, 3, 4, 5)
    scale = d ** -0.5

    def one_block(qi):
        s = jnp.einsum('bqhcd,bkhcd->bhcqk', qi, k).astype(jnp.float32) * scale
        p = jax.nn.softmax(s, axis=-1)
        a = p[:, :, 0] - lam * p[:, :, 1]
        return jnp.einsum('bhqk,bkhe->bqhe', a.astype(v.dtype), v)

    o = lax.map(one_block, qb)
    return o.transpose(1, 0, 2, 3, 4).reshape(b, l, h, v.shape[-1])


def mixer_ab(h_lat, h_ctx, cos, sin, w_in, w_out, qn_a, kn_a, sink_a, qn_b, kn_b, with_ctx_out):
    def project(h, rope):
        bb, ll, _ = h.shape
        qa, ka, va, qb, kb, vb = jnp.split(h @ w_in, AB_SPLITS, axis=-1)
        qa = rms_norm(qa.reshape(bb, ll, N_KV_A, GROUP_A, HEAD_DIM), qn_a)
        ka = rms_norm(ka.reshape(bb, ll, N_KV_A, HEAD_DIM), kn_a)
        va = va.reshape(bb, ll, N_KV_A, HEAD_DIM)
        qb = rms_norm(qb.reshape(bb, ll, N_KV_B, GROUP_B, HEAD_DIM), qn_b)
        kb = rms_norm(kb.reshape(bb, ll, N_KV_B, HEAD_DIM), kn_b)
        vb = vb.reshape(bb, ll, N_KV_B, HEAD_DIM)
        if rope:
            qa, ka = apply_rope(qa, cos, sin), apply_rope(ka, cos, sin)
            qb, kb = apply_rope(qb, cos, sin), apply_rope(kb, cos, sin)
        return qa, ka, va, qb, kb, vb

    b, seq, _ = h_lat.shape
    qa, ka, va, qb, kb, vb = project(h_lat, True)
    cqa, cka, cva, cqb, ckb, cvb = project(h_ctx, False)
    sink = sink_a.reshape(N_KV_A, GROUP_A)
    oa = window_sink_attention(qa, ka, va, cka, cva, sink)
    ob = gqa_sweep(qb, jnp.concatenate([kb, ckb], axis=1), jnp.concatenate([vb, cvb], axis=1))
    o_lat = jnp.concatenate([oa.reshape(b, seq, QA_W), ob.reshape(b, seq, QB_W)], axis=-1) @ w_out
    o_ctx = None
    if with_ctx_out:
        cl = h_ctx.shape[1]
        oca = ctx_sink_attention(cqa, cka, cva, sink)
        ocb = gqa_sweep(cqb, ckb, cvb)
        o_ctx = jnp.concatenate([oca.reshape(b, cl, QA_W), ocb.reshape(b, cl, QB_W)], axis=-1) @ w_out
    return o_lat, o_ctx


def mixer_c(h_lat, h_ctx, cos, sin, w_in, w_out, qn, kn, lam_p, subln, lam_init, with_ctx_out):
    lp = lam_p.astype(jnp.float32)
    lam = jnp.exp(jnp.sum(lp[0] * lp[1])) - jnp.exp(jnp.sum(lp[2] * lp[3])) + lam_init

    def project(h, rope):
        bb, ll, _ = h.shape
        q, k, v = jnp.split(h @ w_in, 3, axis=-1)
        q = rms_norm(q.reshape(bb, ll, N_HEADS_C, 2, HEAD_DIM), qn)
        k = rms_norm(k.reshape(bb, ll, N_HEADS_C, 2, HEAD_DIM), kn)
        v = v.reshape(bb, ll, N_HEADS_C, DV_C)
        if rope:
            q, k = apply_rope(q, cos, sin), apply_rope(k, cos, sin)
        return q, k, v

    def finish(o):
        o = rms_norm(o, subln) * (1 - lam_init)
        return o.reshape(o.shape[0], o.shape[1], MIX_C) @ w_out

    q_l, k_l, v_l = project(h_lat, True)
    q_c, k_c, v_c = project(h_ctx, False)
    o_lat = finish(diff_sweep(q_l, jnp.concatenate([k_l, k_c], axis=1), jnp.concatenate([v_l, v_c], axis=1), lam))
    o_ctx = finish(diff_sweep(q_c, k_c, v_c, lam)) if with_ctx_out else None
    return o_lat, o_ctx


def hier_moe(h, w_group, b_group, w_expert, b_expert, w1, w3, w2):
    t, d = h.shape
    pg = jax.nn.softmax((h @ w_group).astype(jnp.float32) + b_group.astype(jnp.float32), axis=-1)
    g_prob, g_idx = lax.top_k(pg, 1)
    le = ((h @ w_expert).astype(jnp.float32) + b_expert.astype(jnp.float32)).reshape(t, N_GROUPS, EXPERTS_PER_GROUP)
    le = jnp.take_along_axis(le, g_idx[:, :, None], axis=1)[:, 0]
    e_prob, e_idx = lax.top_k(jax.nn.softmax(le, axis=-1), TOP_K)
    weights = g_prob * e_prob / jnp.sum(e_prob, axis=-1, keepdims=True)
    expert_id = g_idx * EXPERTS_PER_GROUP + e_idx
    flat_e = expert_id.reshape(-1)
    flat_tok = jnp.repeat(jnp.arange(t), TOP_K)
    flat_w = weights.reshape(-1)
    order = jnp.argsort(flat_e)
    se, stok, sw = flat_e[order], flat_tok[order], flat_w[order]
    counts = jnp.bincount(flat_e, length=N_EXPERTS)
    padded = (counts + BLK - 1) // BLK * BLK
    start = jnp.cumsum(counts) - counts
    pend = jnp.cumsum(padded)
    dest = (pend - padded)[se] + jnp.arange(flat_e.shape[0]) - start[se]
    n_rows = (t * TOP_K + BLK - 1) // BLK * BLK + N_EXPERTS * BLK
    n_blk = n_rows // BLK
    buf = jnp.zeros((n_rows, d), h.dtype).at[dest].set(h[stok])
    blk_e = jnp.minimum(jnp.searchsorted(pend, jnp.arange(n_blk) * BLK, side='right'), N_EXPERTS - 1)

    def expert_block(args):
        xb, e = args
        return (jax.nn.silu(xb @ w1[e]) * (xb @ w3[e])) @ w2[e]

    yb = lax.map(expert_block, (buf.reshape(n_blk, BLK, d), blk_e))
    y = yb.reshape(n_rows, d)[dest] * sw[:, None].astype(h.dtype)
    return jnp.zeros_like(h).at[stok].add(y)


def setup_inputs(seed: int = 0) -> dict:
    key = jax.random.key(seed)
    ks = iter(jax.random.split(key, 40))

    def nrm(shape, scale):
        return jax.random.normal(next(ks), shape, jnp.float32) * scale

    D = D_MODEL
    return {
        'x': nrm((BATCH, SEQ, D), 1.0),
        'c': nrm((BATCH, D), 1.0),
        'ctx': nrm((BATCH, CTX_LEN, D), 1.0),
        'c_ctx': nrm((D,), 1.0),
        'w_mod': nrm((DEPTH, D, 6 * D), 0.5 * D ** -0.5),
        'b_mod': nrm((DEPTH, 6 * D), 0.01),
        'norm_mix': 1.0 + nrm((DEPTH, D), 0.05),
        'norm_ffn': 1.0 + nrm((DEPTH, D), 0.05),
        'w_in_ab': nrm((N_EVEN, D, IN_AB), D ** -0.5),
        'w_out_ab': nrm((N_EVEN, MIX_AB, D), MIX_AB ** -0.5),
        'qn_a': 1.0 + nrm((N_EVEN, HEAD_DIM), 0.05),
        'kn_a': 1.0 + nrm((N_EVEN, HEAD_DIM), 0.05),
        'sink_a': nrm((N_EVEN, N_HEADS_A), 0.5),
        'qn_b': 1.0 + nrm((N_EVEN, HEAD_DIM), 0.05),
        'kn_b': 1.0 + nrm((N_EVEN, HEAD_DIM), 0.05),
        'w_in_c': nrm((N_ODD, D, IN_C), D ** -0.5),
        'w_out_c': nrm((N_ODD, MIX_C, D), MIX_C ** -0.5),
        'qn_c': 1.0 + nrm((N_ODD, HEAD_DIM), 0.05),
        'kn_c': 1.0 + nrm((N_ODD, HEAD_DIM), 0.05),
        'lam_c': nrm((N_ODD, 4, HEAD_DIM), 0.1),
        'subln_c': 1.0 + nrm((N_ODD, DV_C), 0.05),
        'w_group': nrm((DEPTH, D, N_GROUPS), D ** -0.5),
        'b_group': nrm((DEPTH, N_GROUPS), 0.01),
        'w_expert': nrm((DEPTH, D, N_EXPERTS), D ** -0.5),
        'b_expert': nrm((DEPTH, N_EXPERTS), 0.01),
        'w1': nrm((DEPTH, N_EXPERTS, D, D_EXPERT), D ** -0.5),
        'w3': nrm((DEPTH, N_EXPERTS, D, D_EXPERT), D ** -0.5),
        'w2': nrm((DEPTH, N_EXPERTS, D_EXPERT, D), D_EXPERT ** -0.5),
    }


def reference(x, c, ctx, c_ctx, w_mod, b_mod, norm_mix, norm_ffn, w_in_ab, w_out_ab, qn_a, kn_a, sink_a,
              qn_b, kn_b, w_in_c, w_out_c, qn_c, kn_c, lam_c, subln_c, w_group, b_group, w_expert, b_expert,
              w1, w3, w2):
    b, s_lat, d = x.shape
    c_len = ctx.shape[1]
    rows_n = s_lat // GRID_W
    cos, sin = axial_rope_tables(rows_n)
    for l in range(DEPTH):
        last = l == DEPTH - 1
        i = l // 2
        mod = jax.nn.silu(c) @ w_mod[l] + b_mod[l]
        mod_c = jax.nn.silu(c_ctx) @ w_mod[l] + b_mod[l]
        sh1, sc1, gt1, sh2, sc2, gt2 = jnp.split(mod[:, None, :], 6, axis=-1)
        csh1, csc1, cgt1, csh2, csc2, cgt2 = jnp.split(mod_c, 6, axis=-1)
        h_lat = modulate(x, norm_mix[l], sh1, sc1)
        h_ctx = modulate(ctx, norm_mix[l], csh1, csc1)
        if l % 2 == 0:
            o_lat, o_ctx = mixer_ab(h_lat, h_ctx, cos, sin, w_in_ab[i], w_out_ab[i], qn_a[i], kn_a[i], sink_a[i],
                                    qn_b[i], kn_b[i], not last)
        else:
            lam_init = 0.8 - 0.6 * math.exp(-0.3 * l)
            o_lat, o_ctx = mixer_c(h_lat, h_ctx, cos, sin, w_in_c[i], w_out_c[i], qn_c[i], kn_c[i], lam_c[i],
                                   subln_c[i], lam_init, not last)
        x = x + gt1 * o_lat
        if not last:
            ctx = ctx + cgt1 * o_ctx
            tokens = jnp.concatenate([modulate(ctx, norm_ffn[l], csh2, csc2),
                                      modulate(x, norm_ffn[l], sh2, sc2)], axis=1).reshape(-1, d)
            f = hier_moe(tokens, w_group[l], b_group[l], w_expert[l], b_expert[l], w1[l], w3[l], w2[l])
            f = f.reshape(b, c_len + s_lat, d)
            ctx = ctx + cgt2 * f[:, :c_len]
            x = x + gt2 * f[:, c_len:]
        else:
            tokens = modulate(x, norm_ffn[l], sh2, sc2).reshape(-1, d)
            f = hier_moe(tokens, w_group[l], b_group[l], w_expert[l], b_expert[l], w1[l], w3[l], w2[l])
            x = x + gt2 * f.reshape(b, s_lat, d)
    return x
```

```cpp
#include <hip/hip_runtime.h>
#include <cstdio>
#include <cstdint>
namespace pg8 {
#define PG8_LAS __attribute__((address_space(3)))
typedef unsigned short bf16_t;
typedef short bf16x8 __attribute__((ext_vector_type(8)));
typedef float f32x4 __attribute__((ext_vector_type(4)));
typedef unsigned u32x4 __attribute__((ext_vector_type(4)));
constexpr int BM = 256, BK = 64, HALF = 128, HTB = HALF * BK * 2  , STAGE_BYTES = 8 * HTB, NXCD = 8, WGM = 8;

__host__ __device__ __forceinline__ int lds_byte(int r, int c) { const int st = (r >> 4) * 2 + (c >> 5), rr = r & 15, cc = c & 31, ob = rr * 64 + cc * 2; return st * 1024 + (ob ^ (((ob >> 9) & 1) << 5)); }
__host__ __device__ __forceinline__ void stage_rc(int b, int& R, int& C) { const int st = b / 1024, sb = b % 1024, swz = sb ^ (((sb >> 9) & 1) << 5); R = (st >> 1) * 16 + swz / 64; C = (st & 1) * 32 + (swz % 64) / 2; }
__host__ __device__ __forceinline__ int perm32(int rho) { const int n = rho >> 4, i = rho & 15; return 8 * (i >> 2) + 4 * n + (i & 3); }

struct Unit { int pm, pn; };
struct Gemm { const bf16_t* A; const bf16_t* Bt; int M, N, K; };

struct StaticOrder {
    int nM, nN, nwg, G, c;
    __host__ __device__ void init(int M, int N, int G_, int c_) { nM = M / BM; nN = N / BM; nwg = nM * nN; G = G_; c = c_; }
    __host__ __device__ bool next(int i, Unit& u) const {
        const long L = (long)i * G + c; if (L >= nwg) return false;
        int wgid = (int)L; { const int q = nwg / NXCD, r = nwg % NXCD, xcd = wgid % NXCD, off = wgid / NXCD; wgid = (xcd < r ? xcd * (q + 1) : r * (q + 1) + (xcd - r) * q) + off; }
        const int nig = WGM * nN, gid = wgid / nig, fm = gid * WGM, gsz = (nM - fm) < WGM ? (nM - fm) : WGM;
        u.pm = fm + ((wgid % nig) % gsz); u.pn = (wgid % nig) / gsz; return true;
    }
    __device__ __forceinline__ void a_ready(const Unit&) const {}
    __device__ __forceinline__ void done(const Unit&) const {}
};

__device__ __forceinline__ unsigned cvt_pk_bf16(float lo, float hi) { unsigned r; asm volatile("v_cvt_pk_bf16_f32 %0, %1, %2" : "=v"(r) : "v"(lo), "v"(hi)); return r; }
typedef float f32x2v __attribute__((ext_vector_type(2)));
typedef __bf16 bf16x2v __attribute__((ext_vector_type(2)));
__device__ __forceinline__ unsigned pkbf(float lo, float hi) { f32x2v v = {lo, hi}; bf16x2v b = __builtin_convertvector(v, bf16x2v); return __builtin_bit_cast(unsigned, b); }
__device__ __forceinline__ float swap_sum16(float x) { return x + __shfl_xor(x, 16); }
__device__ __forceinline__ float swap_sum32(float x) { return x + __shfl_xor(x, 32); }
constexpr int E_SEQ = 16384, E_MT = 16640;
constexpr size_t E_SLOT = (size_t)E_MT * 64;
constexpr float E_C2 = 0.125f * 1.4426950408889634f;

struct EpiQKV {
    static constexpr bool PERM = true, AFTER_DRAIN = false;
    bf16_t* qkv; const float *gq0, *gk0, *gq1, *gk1; const float* rope; int isC;
    __device__ __forceinline__ void operator()(const f32x4 (&acc)[2][2][4][2], const Unit& u, int wr, int wc, int fr, int fq) const {
        const int gi = u.pn * 4 + wc;
        int type; const float* gain = gq0; bf16_t* out; int pitch = 64;
        if (!isC) {
            if (gi < 8) { type = 0; gain = gq0; } else if (gi < 10) { type = 1; gain = gk0; } else if (gi < 12) { type = 2; }
            else if (gi < 20) { type = 0; gain = gq1; } else if (gi < 22) { type = 1; gain = gk1; } else { type = 2; }
            out = qkv + (size_t)gi * E_SLOT;
        } else {
            if (gi < 16) { type = 0; gain = gq0; out = qkv + (size_t)gi * E_SLOT; }
            else if (gi < 32) { type = 1; gain = gk0; out = qkv + (size_t)gi * E_SLOT; }
            else { type = 2; const int vg = gi - 32; out = qkv + (size_t)(32 + 2 * (vg >> 1)) * E_SLOT + (vg & 1) * 64; pitch = 128; }
        }
        const int rowbase = u.pm * BM + wr * 64 + fr;
        if (type < 2) {
            f32x4 g[2][2];
#pragma unroll
            for (int bj = 0; bj < 2; ++bj)
#pragma unroll
                for (int n = 0; n < 2; ++n) g[bj][n] = *(const f32x4*)(gain + bj * 32 + 8 * fq + 4 * n);
            const float qs = (type == 0) ? E_C2 : 1.f;
#pragma unroll
            for (int ai = 0; ai < 2; ++ai)
#pragma unroll
                for (int m = 0; m < 4; ++m) {
                    const int r = rowbase + ai * HALF + m * 16;
                    f32x4 v[2][2];
#pragma unroll
                    for (int bj = 0; bj < 2; ++bj)
#pragma unroll
                        for (int n = 0; n < 2; ++n) v[bj][n] = acc[ai][bj][m][n];
                    float ss = 0.f;
#pragma unroll
                    for (int bj = 0; bj < 2; ++bj)
#pragma unroll
                        for (int n = 0; n < 2; ++n) ss += (v[bj][n][0] * v[bj][n][0] + v[bj][n][1] * v[bj][n][1]) + (v[bj][n][2] * v[bj][n][2] + v[bj][n][3] * v[bj][n][3]);
                    ss = swap_sum16(ss); ss = swap_sum32(ss);
                    const float rstd = __builtin_amdgcn_rsqf(ss * (1.f / 64.f) + 1e-6f) * qs;
#pragma unroll
                    for (int bj = 0; bj < 2; ++bj)
#pragma unroll
                        for (int n = 0; n < 2; ++n) v[bj][n] = v[bj][n] * rstd * g[bj][n];
                    const int rr = (r < E_SEQ) ? r : 0;
                    const float* tb = (fq < 2) ? (rope + (rr >> 6) * 16 + 8 * fq) : (rope + 8192 + (rr & 63) * 16 + 8 * (fq - 2));
                    const int so = (fq < 2) ? 4096 : 1024;
#pragma unroll
                    for (int n = 0; n < 2; ++n) {
                        f32x4 cs = *(const f32x4*)(tb + 4 * n), sn = *(const f32x4*)(tb + so + 4 * n);
                        if (r >= E_SEQ) { cs = (f32x4){1.f, 1.f, 1.f, 1.f}; sn = (f32x4){0.f, 0.f, 0.f, 0.f}; }
                        const f32x4 y1 = v[0][n], y2 = v[1][n];
                        v[0][n] = y1 * cs - y2 * sn; v[1][n] = y2 * cs + y1 * sn;
                    }
#pragma unroll
                    for (int bj = 0; bj < 2; ++bj) {
                        u32x4 w; w.x = pkbf(v[bj][0][0], v[bj][0][1]); w.y = pkbf(v[bj][0][2], v[bj][0][3]); w.z = pkbf(v[bj][1][0], v[bj][1][1]); w.w = pkbf(v[bj][1][2], v[bj][1][3]);
                        *(u32x4*)(out + (size_t)r * 64 + bj * 32 + 8 * fq) = w;
                    }
                }
        } else {
#pragma unroll
            for (int ai = 0; ai < 2; ++ai)
#pragma unroll
                for (int m = 0; m < 4; ++m) {
                    const int r = rowbase + ai * HALF + m * 16;
#pragma unroll
                    for (int bj = 0; bj < 2; ++bj) {
                        const f32x4 v0 = acc[ai][bj][m][0], v1 = acc[ai][bj][m][1];
                        u32x4 w; w.x = pkbf(v0[0], v0[1]); w.y = pkbf(v0[2], v0[3]); w.z = pkbf(v1[0], v1[1]); w.w = pkbf(v1[2], v1[3]);
                        *(u32x4*)(out + (size_t)r * pitch + bj * 32 + 8 * fq) = w;
                    }
                }
        }
    }
};

struct EpiResid {
    static constexpr bool PERM = true, AFTER_DRAIN = false;
    float* x; const float* gate_lat; const float* gate_ctx;
    __device__ __forceinline__ void operator()(const f32x4 (&acc)[2][2][4][2], const Unit& u, int wr, int wc, int fr, int fq) const {
        const float* gate = (u.pm == 64) ? gate_ctx : gate_lat;
        const int col0 = u.pn * BM + wc * 32 + 8 * fq, rowbase = u.pm * BM + wr * 64 + fr;
        f32x4 gv[2][2];
#pragma unroll
        for (int bj = 0; bj < 2; ++bj)
#pragma unroll
            for (int n = 0; n < 2; ++n) gv[bj][n] = *(const f32x4*)(gate + col0 + bj * HALF + 4 * n);
#pragma unroll
        for (int ai = 0; ai < 2; ++ai)
#pragma unroll
            for (int m = 0; m < 4; ++m) {
                float* xr = x + (size_t)(rowbase + ai * HALF + m * 16) * 1024 + col0;
#pragma unroll
                for (int bj = 0; bj < 2; ++bj)
#pragma unroll
                    for (int n = 0; n < 2; ++n) { f32x4 xv = *(f32x4*)(xr + bj * HALF + 4 * n); xv = xv + gv[bj][n] * acc[ai][bj][m][n]; *(f32x4*)(xr + bj * HALF + 4 * n) = xv; }
            }
    }
};

struct EpiSwiGLU {
    static constexpr bool PERM = true, AFTER_DRAIN = false;
    bf16_t* H;
    __device__ __forceinline__ void operator()(const f32x4 (&acc)[2][2][4][2], const Unit& u, int wr, int wc, int fr, int fq) const {
        const int col0 = (u.pn & 3) * 128 + wc * 32 + 8 * fq, rowbase = u.pm * BM + wr * 64 + fr;
#pragma unroll
        for (int ai = 0; ai < 2; ++ai)
#pragma unroll
            for (int m = 0; m < 4; ++m) {
                float h[8];
#pragma unroll
                for (int n = 0; n < 2; ++n)
#pragma unroll
                    for (int e = 0; e < 4; ++e) { const float a = acc[ai][0][m][n][e], b = acc[ai][1][m][n][e];
                        h[4 * n + e] = a * b * __builtin_amdgcn_rcpf(1.f + __builtin_amdgcn_exp2f(-1.4426950408889634f * a)); }
                u32x4 w; w.x = pkbf(h[0], h[1]); w.y = pkbf(h[2], h[3]); w.z = pkbf(h[4], h[5]); w.w = pkbf(h[6], h[7]);
                *(u32x4*)(H + (size_t)(rowbase + ai * HALF + m * 16) * 512 + col0) = w;
            }
    }
};

struct EpiY {
    static constexpr bool PERM = true, AFTER_DRAIN = false;
    bf16_t* Y; const float* rw;
    __device__ __forceinline__ void operator()(const f32x4 (&acc)[2][2][4][2], const Unit& u, int wr, int wc, int fr, int fq) const {
        const int col0 = (u.pn & 3) * BM + wc * 32 + 8 * fq, rowbase = u.pm * BM + wr * 64 + fr;
#pragma unroll
        for (int ai = 0; ai < 2; ++ai)
#pragma unroll
            for (int m = 0; m < 4; ++m) {
                const int r = rowbase + ai * HALF + m * 16; const float w8 = rw[r];
#pragma unroll
                for (int bj = 0; bj < 2; ++bj) { const f32x4 v0 = acc[ai][bj][m][0] * w8, v1 = acc[ai][bj][m][1] * w8;
                    u32x4 w; w.x = pkbf(v0[0], v0[1]); w.y = pkbf(v0[2], v0[3]); w.z = pkbf(v1[0], v1[1]); w.w = pkbf(v1[2], v1[3]);
                    *(u32x4*)(Y + (size_t)r * 1024 + col0 + bj * HALF) = w; }
            }
    }
};

struct MoeOrder {
    const PG8_LAS int* tile_e; int nunits, G, c;
    __device__ __forceinline__ bool next(int i, Unit& u) const {
        const int L = i * G + c; if (L >= nunits) return false;
        const int pm = L >> 2; const int e = tile_e[pm];
        u.pm = __builtin_amdgcn_readfirstlane(pm); u.pn = __builtin_amdgcn_readfirstlane(e * 4 + (L & 3)); return true;
    }
    __device__ __forceinline__ void a_ready(const Unit&) const {}
    __device__ __forceinline__ void done(const Unit&) const {}
};

template <class Epi, class Sched, bool ALIGN_EPI = false, bool SP2 = false>
__device__ __forceinline__ void gemm_phase(PG8_LAS unsigned char* lds, const Gemm g, const Sched& S, const Epi& E) {
    int tid_ = threadIdx.x;
    const int tid = tid_, wid = __builtin_amdgcn_readfirstlane(tid >> 6), lane = tid & 63, wr = wid >> 2, wc = wid & 3, fr = lane & 15, fq = lane >> 4;
    const int K = g.K, nt = K / BK;
    unsigned voffA[2], voffB[2];
#pragma unroll
    for (int i = 0; i < 2; ++i) { int R, C; stage_rc(tid * 16 + i * 8192, R, C); const int Rb = Epi::PERM ? ((R & ~31) + perm32(R & 31)) : R;
        voffA[i] = (unsigned)(R * K + C) * 2u; voffB[i] = (unsigned)(Rb * K + C) * 2u; }
    const size_t kstep = (size_t)(BK * 2);
    const size_t hstep = (size_t)HALF * K * 2;
    const size_t tstep = 2 * hstep;
    const unsigned ldsw = (unsigned)wid * 1024u;
    const int aoff = lds_byte(wr * 64 + fr, fq * 8), boff = lds_byte(wc * 32 + fr, fq * 8);
#define PG8_SA(b, h) (((b) * 2 + (h)) * HTB)
#define PG8_SB(b, h) ((4 + (b) * 2 + (h)) * HTB)
#define PG8_STAGE(bufoff, gbase, voff) do { _Pragma("unroll") for (int _i = 0; _i < 2; ++_i) \
        __builtin_amdgcn_global_load_lds((const unsigned*)((const char*)(gbase) + (voff)[_i]), (PG8_LAS unsigned*)(lds + (bufoff) + ldsw + _i * 8192), 16, 0, 0); } while (0)
#define PG8_LDA(dst, b, h) do { _Pragma("unroll") for (int m = 0; m < 4; ++m) _Pragma("unroll") for (int k = 0; k < 2; ++k) dst[m][k] = *(const PG8_LAS bf16x8*)(lds + PG8_SA(b, h) + aoff + m * 2048 + k * 1024); } while (0)
#define PG8_LDB(dst, b, h) do { _Pragma("unroll") for (int n = 0; n < 2; ++n) _Pragma("unroll") for (int k = 0; k < 2; ++k) dst[n][k] = *(const PG8_LAS bf16x8*)(lds + PG8_SB(b, h) + boff + n * 2048 + k * 1024); } while (0)
#define PG8_MMA(ai, bj, At, Bt) do { __builtin_amdgcn_s_setprio(1); _Pragma("unroll") for (int m = 0; m < 4; ++m) _Pragma("unroll") for (int n = 0; n < 2; ++n) _Pragma("unroll") for (int k = 0; k < 2; ++k) \
        acc[ai][bj][m][n] = __builtin_amdgcn_mfma_f32_16x16x32_bf16(Bt[n][k], At[m][k], acc[ai][bj][m][n], 0, 0, 0); __builtin_amdgcn_s_setprio(0); } while (0)
#define PG8_WAIT_V(n) asm volatile("s_waitcnt vmcnt(" #n ")" ::: "memory")
#define PG8_WAIT_L(n) asm volatile("s_waitcnt lgkmcnt(" #n ")" ::: "memory")
#define PG8_BAR __builtin_amdgcn_s_barrier()
#define PG8_SCHED __builtin_amdgcn_sched_barrier(0)
    Unit cur, nxt; int ui = 0;
    if (!S.next(0, cur)) return;
    f32x4 acc[2][2][4][2];
#pragma unroll
    for (int a = 0; a < 2; ++a)
#pragma unroll
        for (int b = 0; b < 2; ++b)
#pragma unroll
            for (int m = 0; m < 4; ++m)
#pragma unroll
                for (int n = 0; n < 2; ++n) acc[a][b][m][n] = (f32x4){0.f, 0.f, 0.f, 0.f};
    bf16x8 At[4][2], B0[2][2], B1[2][2];
    const char* cA = (const char*)g.A + (size_t)cur.pm * tstep; const char* cB = (const char*)g.Bt + (size_t)cur.pn * tstep;
    S.a_ready(cur);
    if constexpr (SP2) {
        PG8_STAGE(PG8_SB(0, 0), cB, voffB); PG8_STAGE(PG8_SB(0, 1), cB + hstep, voffB); PG8_STAGE(PG8_SA(0, 0), cA, voffA); PG8_STAGE(PG8_SA(0, 1), cA + hstep, voffA);
        if (wr == 1) PG8_BAR;
        PG8_WAIT_V(2); PG8_BAR;
        PG8_STAGE(PG8_SB(1, 0), cB + kstep, voffB); PG8_STAGE(PG8_SA(1, 0), cA + kstep, voffA); PG8_STAGE(PG8_SB(1, 1), cB + hstep + kstep, voffB);
        PG8_WAIT_V(6); PG8_BAR;
    } else {
        PG8_STAGE(PG8_SB(0, 0), cB, voffB); PG8_STAGE(PG8_SA(0, 0), cA, voffA); PG8_STAGE(PG8_SB(0, 1), cB + hstep, voffB); PG8_STAGE(PG8_SA(0, 1), cA + hstep, voffA);
        if (wr == 1) PG8_BAR;
        PG8_WAIT_V(4); PG8_BAR;
        PG8_STAGE(PG8_SB(1, 0), cB + kstep, voffB); PG8_STAGE(PG8_SA(1, 0), cA + kstep, voffA); PG8_STAGE(PG8_SB(1, 1), cB + hstep + kstep, voffB);
        PG8_WAIT_V(6); PG8_BAR;
    }
    for (;;) {
        const bool has_next = S.next(ui + 1, nxt);
        const char* nA = has_next ? (const char*)g.A + (size_t)nxt.pm * tstep : cA; const char* nB = has_next ? (const char*)g.Bt + (size_t)nxt.pn * tstep : cB;
        for (int t = 0; t < nt; t += 2) {
            const bool last = (t == nt - 2);
            const char* a1 = cA + (size_t)(t + 1) * kstep;
            const char* a2 = last ? nA : cA + (size_t)(t + 2) * kstep; const char* b2 = last ? nB : cB + (size_t)(t + 2) * kstep;
            const char* a3 = a2 + kstep; const char* b3 = b2 + kstep;
            if (last && has_next) S.a_ready(nxt);
            if constexpr (SP2) {
            PG8_LDB(B0, 0, 0); PG8_LDB(B1, 0, 1); PG8_SCHED; PG8_LDA(At, 0, 0); PG8_STAGE(PG8_SA(1, 1), a1 + hstep, voffA);
            PG8_WAIT_V(8); PG8_WAIT_L(0); PG8_BAR; PG8_MMA(0, 0, At, B0); PG8_MMA(0, 1, At, B1); PG8_BAR; PG8_SCHED;
            PG8_LDA(At, 0, 1); PG8_STAGE(PG8_SB(0, 0), b2, voffB); PG8_STAGE(PG8_SB(0, 1), b2 + hstep, voffB); PG8_STAGE(PG8_SA(0, 0), a2, voffA);
            PG8_WAIT_V(8); PG8_WAIT_L(0); PG8_BAR; PG8_MMA(1, 0, At, B0); PG8_MMA(1, 1, At, B1); PG8_BAR; PG8_SCHED;
            PG8_LDB(B0, 1, 0); PG8_LDB(B1, 1, 1); PG8_SCHED; PG8_LDA(At, 1, 0); PG8_STAGE(PG8_SA(0, 1), a2 + hstep, voffA);
            PG8_WAIT_V(8); PG8_WAIT_L(0); PG8_BAR; PG8_MMA(0, 0, At, B0); PG8_MMA(0, 1, At, B1); PG8_BAR; PG8_SCHED;
            PG8_LDA(At, 1, 1); PG8_STAGE(PG8_SB(1, 0), b3, voffB); PG8_STAGE(PG8_SB(1, 1), b3 + hstep, voffB); PG8_STAGE(PG8_SA(1, 0), a3, voffA);
            PG8_WAIT_V(8); PG8_WAIT_L(0); PG8_BAR; PG8_MMA(1, 0, At, B0); PG8_MMA(1, 1, At, B1); PG8_BAR; PG8_SCHED;
            } else {
            PG8_LDB(B0, 0, 0); PG8_SCHED; PG8_LDA(At, 0, 0); PG8_STAGE(PG8_SA(1, 1), a1 + hstep, voffA);
            PG8_WAIT_L(8); PG8_BAR; PG8_WAIT_L(0); PG8_MMA(0, 0, At, B0); PG8_BAR; PG8_SCHED;
            PG8_LDB(B1, 0, 1); PG8_STAGE(PG8_SB(0, 0), b2, voffB);
            PG8_BAR; PG8_WAIT_L(0); PG8_MMA(0, 1, At, B1); PG8_BAR;
            PG8_LDA(At, 0, 1); PG8_STAGE(PG8_SA(0, 0), a2, voffA);
            PG8_BAR; PG8_WAIT_L(0); PG8_MMA(1, 0, At, B0); PG8_BAR; PG8_SCHED;
            PG8_STAGE(PG8_SB(0, 1), b2 + hstep, voffB);
            PG8_WAIT_V(6); PG8_BAR; PG8_MMA(1, 1, At, B1); PG8_BAR;
            PG8_LDB(B0, 1, 0); PG8_SCHED; PG8_LDA(At, 1, 0); PG8_STAGE(PG8_SA(0, 1), a2 + hstep, voffA);
            PG8_WAIT_L(8); PG8_BAR; PG8_WAIT_L(0); PG8_MMA(0, 0, At, B0); PG8_BAR; PG8_SCHED;
            PG8_LDB(B1, 1, 1); PG8_STAGE(PG8_SB(1, 0), b3, voffB);
            PG8_BAR; PG8_WAIT_L(0); PG8_MMA(0, 1, At, B1); PG8_BAR;
            PG8_LDA(At, 1, 1); PG8_STAGE(PG8_SA(1, 0), a3, voffA);
            PG8_BAR; PG8_WAIT_L(0); PG8_MMA(1, 0, At, B0); PG8_BAR; PG8_SCHED;
            PG8_STAGE(PG8_SB(1, 1), b3 + hstep, voffB);
            PG8_WAIT_V(6); PG8_BAR; PG8_MMA(1, 1, At, B1); PG8_BAR;
            }
        }
        if constexpr (ALIGN_EPI) { if (wr == 0) PG8_BAR; }
        if constexpr (!Epi::AFTER_DRAIN) { E(acc, cur, wr, wc, fr, fq); S.done(cur); }
        if (!has_next) break;
#pragma unroll
        for (int a = 0; a < 2; ++a)
#pragma unroll
            for (int b = 0; b < 2; ++b)
#pragma unroll
                for (int m = 0; m < 4; ++m)
#pragma unroll
                    for (int n = 0; n < 2; ++n) acc[a][b][m][n] = (f32x4){0.f, 0.f, 0.f, 0.f};
        cur = nxt; cA = nA; cB = nB; ++ui;
        if constexpr (ALIGN_EPI) { if (wr == 1) PG8_BAR; }
    }
    PG8_WAIT_V(0);
    if constexpr (!ALIGN_EPI) { if (wr == 0) PG8_BAR; }
    PG8_BAR;
    if constexpr (Epi::AFTER_DRAIN) { E.fused(acc, cur, wr, wc, fr, fq, lds, wid, lane); S.done(cur); }
#undef PG8_SA
#undef PG8_SB
#undef PG8_STAGE
#undef PG8_LDA
#undef PG8_LDB
#undef PG8_MMA
#undef PG8_WAIT_V
#undef PG8_WAIT_L
#undef PG8_BAR
#undef PG8_SCHED
}
}
#define LAS __attribute__((address_space(3)))
#define XB_TMO      128
#define XB_XCNT(j)  (256  + 64 * (j))
#define XB_XSUB(j)  (1280 + 64 * (j))
#define XB_XGEN(j)  (2304 + 64 * (j))
#define XB_TOP      3328
#define XB_TOPGEN   3392
#define XCD_BAR_WORDS 3456
#define XB_SPIN_CAP (1u << 18)

__device__ __forceinline__ unsigned xb_ld(unsigned* p)              { return __hip_atomic_load(p, __ATOMIC_RELAXED, __HIP_MEMORY_SCOPE_AGENT); }
__device__ __forceinline__ unsigned xb_add(unsigned* p, unsigned v) { return __hip_atomic_fetch_add(p, v, __ATOMIC_RELAXED, __HIP_MEMORY_SCOPE_AGENT); }
__device__ __forceinline__ unsigned xb_xcc_id() { return (unsigned)__builtin_amdgcn_s_getreg((3 << 11) | 20) & 0xFu; }
#define XB_SPIN(cond, bar) do { unsigned _sp = 0; while (cond) { __builtin_amdgcn_s_sleep(1); \
    if ((++_sp & 255u) == 0u) { if (xb_ld(&(bar)[XB_TMO])) break; if (_sp > XB_SPIN_CAP) { atomicAdd(&(bar)[XB_TMO], 1u); break; } } } } while (0)

struct XcdBarrier {
    unsigned* bar; unsigned x;
    volatile LAS unsigned* st;
};

__device__ __forceinline__ XcdBarrier xcd_barrier_post(unsigned* bar, volatile LAS unsigned* st) {
    XcdBarrier b; b.bar = bar; b.x = xb_xcc_id(); b.st = st;
    if (threadIdx.x == 0) (void)xb_add(&bar[XB_XCNT(b.x)], 1u);
    return b;
}
__device__ __forceinline__ void xcd_barrier_complete(unsigned* bar, unsigned x, unsigned& nloc, unsigned& nx) {
    const unsigned G = gridDim.x * gridDim.y * gridDim.z;
    unsigned sum, cnt, mine, sp = 0u;
    for (;;) {
        sum = 0u; cnt = 0u; mine = 0u;
#pragma unroll
        for (unsigned j = 0; j < 16; ++j) { const unsigned c = xb_ld(&bar[XB_XCNT(j)]); sum += c; cnt += (c > 0u) ? 1u : 0u; mine = (j == x) ? c : mine; }
        if (sum == G) break;
        __builtin_amdgcn_s_sleep(1);
        if ((++sp & 255u) == 0u) { if (xb_ld(&bar[XB_TMO])) break; if (sp > XB_SPIN_CAP) { atomicAdd(&bar[XB_TMO], 1u); break; } }
    }
    nloc = mine > 0u ? mine : 1u; nx = cnt > 0u ? cnt : 1u;
}

__device__ __forceinline__ void xcd_barrier(const XcdBarrier& b) {
    asm volatile("s_waitcnt vmcnt(0)" ::: "memory");
    __syncthreads();
    if (threadIdx.x == 0) {
        unsigned* bar = b.bar;
        __builtin_amdgcn_s_waitcnt(0);
        unsigned nloc = b.st[0], nx = b.st[1];
        if (nloc == 0u) { xcd_barrier_complete(bar, b.x, nloc, nx); b.st[0] = nloc; b.st[1] = nx; }
        const unsigned old = xb_add(&bar[XB_XSUB(b.x)], 1u);
        const unsigned gen = old / nloc;
        if (old + 1u == (gen + 1u) * nloc) {
            __builtin_amdgcn_fence(__ATOMIC_RELEASE, "agent");
            asm volatile("s_waitcnt vmcnt(0)" ::: "memory");
            const unsigned og = xb_add(&bar[XB_TOP], 1u);
            const unsigned tg = og / nx;
            if (og + 1u == (tg + 1u) * nx) xb_add(&bar[XB_TOPGEN], 1u);
            else XB_SPIN(xb_ld(&bar[XB_TOPGEN]) == tg, bar);
            __builtin_amdgcn_fence(__ATOMIC_ACQUIRE, "agent");
            xb_add(&bar[XB_XGEN(b.x)], 1u);
            asm volatile("s_waitcnt vmcnt(0)" ::: "memory");
        } else {
            XB_SPIN(xb_ld(&bar[XB_XGEN(b.x)]) == gen, bar);
            __builtin_amdgcn_fence(__ATOMIC_ACQUIRE, "agent");
            asm volatile("s_waitcnt vmcnt(0)" ::: "memory");
        }
    }
    __syncthreads();
}

#define GAS __attribute__((address_space(1)))
typedef unsigned short bf16;
typedef float f32x4 __attribute__((ext_vector_type(4)));
typedef float f32x16 __attribute__((ext_vector_type(16)));
typedef short bf16x8 __attribute__((ext_vector_type(8)));
typedef short s16x4 __attribute__((ext_vector_type(4)));
typedef short v4i16_t __attribute__((ext_vector_type(4)));
typedef unsigned u32x4 __attribute__((ext_vector_type(4)));
typedef unsigned u32x2 __attribute__((ext_vector_type(2)));
using pg8::pkbf;

constexpr int DM = 1024, SEQ = 16384, CTXL = 256, MT = SEQ + CTXL, DEPTH = 4, NEXP = 32, DEXP = 512;
constexpr int XG_ROWS = 41472;
constexpr size_t SLOT = (size_t)MT * 64;
constexpr float LOG2E = 1.4426950408889634f, RMS_EPS = 1e-6f;
constexpr int NWAVES = 8, NTHREADS = 512;

constexpr size_t MiB = 1u << 20;
constexpr size_t WS_CTL = 0, CTL_ZERO_BYTES = 1 * MiB;
constexpr size_t WS_MOD = 1 * MiB;
constexpr size_t WS_ROPE = 1 * MiB + 512 * 1024;
constexpr size_t WS_BT_INAB = 2 * MiB, WS_BT_OUTAB = 8 * MiB, WS_BT_INC = 12 * MiB, WS_BT_OUTC = 24 * MiB;
constexpr size_t WS_BT_W13 = 32 * MiB, WS_BT_W2 = 288 * MiB;
constexpr size_t WS_XCUR = 416 * MiB, WS_HB = 481 * MiB, WS_QKV = 514 * MiB, WS_OB = 612 * MiB, WS_O1S = 645 * MiB;
constexpr size_t WS_XG = 710 * MiB, WS_HG = 791 * MiB, WS_YG = 832 * MiB, WS_ROUTE = 913 * MiB, WS_END = 915 * MiB;
constexpr size_t RT_TOKE = 0, RT_TOKP = 256 * 1024, RT_TOKW = 512 * 1024, RT_DROW = 768 * 1024, RT_RW = 1024 * 1024, RT_TILE = 1280 * 1024, RT_NT = 1280 * 1024 + 4096;
static_assert(WS_BT_W13 + (size_t)DEPTH * NEXP * 1024 * 1024 * 2 <= WS_BT_W2 && WS_BT_W2 + (size_t)DEPTH * NEXP * 1024 * 512 * 2 <= WS_XCUR, "ws map");
static_assert(WS_XCUR + (size_t)MT * DM * 4 <= WS_HB && WS_HB + (size_t)MT * DM * 2 <= WS_QKV && WS_QKV + 48 * SLOT * 2 <= WS_OB && WS_OB + (size_t)MT * DM * 2 <= WS_O1S, "ws map");
static_assert(WS_O1S + (size_t)520 * 131072 <= WS_XG && WS_XG + (size_t)XG_ROWS * DM * 2 <= WS_HG && WS_HG + (size_t)XG_ROWS * DEXP * 2 <= WS_YG && WS_YG + (size_t)XG_ROWS * DM * 2 <= WS_ROUTE, "ws map");
constexpr int CW_BAR = 4096, CW_CNT = 16384, CW_DIAG = 32768;

constexpr int LDS_STAGE = 73728, LDS_WSF = 139264, LDSCTL_OFF = 140288, MISC_OFF = LDSCTL_OFF + 320, TAB_OFF = LDSCTL_OFF + 1024, LDS_BYTES = 147456;
static_assert(TAB_OFF + 1024 + 64 <= LDS_BYTES, "LDS map");

constexpr int NPH = 2 + 8 * DEPTH;

#define LDS_WAIT() asm volatile("s_waitcnt lgkmcnt(0)" ::: "memory")
__device__ __forceinline__ float wave_sum(float v) {
#pragma unroll
    for (int o = 1; o < 64; o <<= 1) v += __shfl_xor(v, o);
    return v;
}
__device__ __forceinline__ float bf2f(unsigned short u) { return __builtin_bit_cast(float, (unsigned)u << 16); }
__device__ __forceinline__ float bflo(unsigned u) { return __builtin_bit_cast(float, u << 16); }
__device__ __forceinline__ float bfhi(unsigned u) { return __builtin_bit_cast(float, u & 0xffff0000u); }

__device__ __forceinline__ void transpose_item(const float* W, int ldw, int srccol0, bf16* WT, int K, int dstrow0, int k0, LAS float* scr, int lane) {
#pragma unroll 8
    for (int i = 0; i < 32; ++i) { const int kk = 2 * i + (lane >> 5); scr[kk * 33 + (lane & 31)] = W[(size_t)(k0 + kk) * ldw + srccol0 + (lane & 31)]; }
    LDS_WAIT(); asm volatile("" ::: "memory");
    const int c = lane & 7;
#pragma unroll
    for (int j = 0; j < 4; ++j) { const int n = (lane >> 3) + 8 * j; const LAS float* s = scr + (8 * c) * 33 + n;
        u32x4 o; o.x = pkbf(s[0 * 33], s[1 * 33]); o.y = pkbf(s[2 * 33], s[3 * 33]); o.z = pkbf(s[4 * 33], s[5 * 33]); o.w = pkbf(s[6 * 33], s[7 * 33]);
        *(GAS u32x4*)(WT + (size_t)(dstrow0 + n) * K + k0 + 8 * c) = o; }
    LDS_WAIT(); asm volatile("" ::: "memory");
}

namespace att {
typedef __attribute__((address_space(3))) const char* lds_cptr;
__device__ __forceinline__ int crow(int r, int hi) { return (r & 3) + 8 * (r >> 2) + 4 * hi; }
__device__ __forceinline__ void glds16(const void* gsrc, unsigned lds_dst) { unsigned keep;
    asm volatile("s_mov_b32 %0, m0\n\ts_mov_b32 m0, %2\n\ts_nop 0\n\tglobal_load_lds_dwordx4 %1, off\n\ts_mov_b32 m0, %0" : "=&s"(keep) : "v"(gsrc), "s"(lds_dst) : "memory"); }
__device__ __forceinline__ s16x4 vtr(lds_cptr p) { return __builtin_bit_cast(s16x4, __builtin_amdgcn_ds_read_tr16_b64_v4i16((LAS v4i16_t*)p)); }
#define ATT_WAITBAR(N) asm volatile("s_waitcnt vmcnt(" #N ") lgkmcnt(0)\n\ts_barrier" ::: "memory")

template <int DV>
__device__ __forceinline__ void attn_pass(f32x16 (&o)[DV / 32], float& lsum, const bf16* Qw, const bf16* Kb, const bf16* Vb, int vpitch,
                                          int t0, int n1, int masked, int qpos, LAS unsigned char* lds, int wid, int lane) {
    constexpr int NV = DV / 64, KSLOT = 8192, VSLOT = DV * 128, LV = 3 * KSLOT;
    const int r32 = lane & 31, hi = lane >> 5, n = n1 + 4;
    const unsigned lds0 = (unsigned)(unsigned long)lds;
    bf16x8 qr[4];
#pragma unroll
    for (int d0 = 0; d0 < 4; ++d0) qr[d0] = *(const bf16x8*)(Qw + (size_t)r32 * 64 + d0 * 16 + hi * 8);
    const bf16* ksrc = Kb + (size_t)lane * 64 + wid * 8;
    const bf16* vsrc[NV];
#pragma unroll
    for (int j = 0; j < NV; ++j) { const int pi = wid + 8 * j, db = pi >> 2, kg = pi & 3; vsrc[j] = Vb + (size_t)(16 * kg + (lane >> 2)) * vpitch + db * 32 + (lane & 3) * 8; }
#define ATT_TILE(i_) ((i_) < n1 ? t0 + (i_) : 256 + (i_) - n1)
#define ATT_DMA(tl_, sl_) do { const int tl__ = (tl_); const int sl__ = (sl_); \
        glds16(ksrc + (size_t)tl__ * 4096, (unsigned)__builtin_amdgcn_readfirstlane(lds0 + sl__ * KSLOT + wid * 1024)); \
        _Pragma("unroll") for (int j_ = 0; j_ < NV; ++j_) glds16(vsrc[j_] + (size_t)tl__ * 64 * vpitch, (unsigned)__builtin_amdgcn_readfirstlane(lds0 + LV + sl__ * VSLOT + (wid + 8 * j_) * 1024)); } while (0)
    ATT_DMA(ATT_TILE(0), 0);
    if (n > 1) ATT_DMA(ATT_TILE(1), 1);
    int sl = 0, sl2 = 2;
    for (int i = 0; i < n; ++i) {
        if (i + 1 < n) { if (NV == 1) ATT_WAITBAR(2); else ATT_WAITBAR(3); } else ATT_WAITBAR(0);
        if (i + 2 < n) ATT_DMA(ATT_TILE(i + 2), sl2);
        const int tl = ATT_TILE(i);
        const lds_cptr kp = (lds_cptr)lds + sl * KSLOT + hi * 1024 + r32 * 16;
        bf16x8 kf[8];
#pragma unroll
        for (int d0 = 0; d0 < 4; ++d0) { kf[2 * d0] = *(const LAS bf16x8*)(kp + d0 * 2048); kf[2 * d0 + 1] = *(const LAS bf16x8*)(kp + d0 * 2048 + 512); }
        f32x16 p0 = {}, p1 = {};
#pragma unroll
        for (int d0 = 0; d0 < 4; ++d0) { p0 = __builtin_amdgcn_mfma_f32_32x32x16_bf16(kf[2 * d0], qr[d0], p0, 0, 0, 0); p1 = __builtin_amdgcn_mfma_f32_32x32x16_bf16(kf[2 * d0 + 1], qr[d0], p1, 0, 0, 0); }
#pragma unroll
        for (int r = 0; r < 16; ++r) { p0[r] = __builtin_amdgcn_exp2f(p0[r]); p1[r] = __builtin_amdgcn_exp2f(p1[r]); }
        if (masked && tl < 256) {
            const int kb = 64 * tl + 4 * hi - (qpos + r32) + 128;
#pragma unroll
            for (int r = 0; r < 16; ++r) { const int kv = kb + (r & 3) + 8 * (r >> 2); if ((unsigned)kv > 256u) p0[r] = 0.f; if ((unsigned)(kv + 32) > 256u) p1[r] = 0.f; }
        }
        float s0 = 0.f, s1 = 0.f;
#pragma unroll
        for (int r = 0; r < 16; ++r) { s0 += p0[r]; s1 += p1[r]; }
        lsum += s0 + s1;
        u32x4 pw[4];
#pragma unroll
        for (int k = 0; k < 2; ++k) {
            pw[k]     = (u32x4){pkbf(p0[8 * k], p0[8 * k + 1]), pkbf(p0[8 * k + 2], p0[8 * k + 3]), pkbf(p0[8 * k + 4], p0[8 * k + 5]), pkbf(p0[8 * k + 6], p0[8 * k + 7])};
            pw[2 + k] = (u32x4){pkbf(p1[8 * k], p1[8 * k + 1]), pkbf(p1[8 * k + 2], p1[8 * k + 3]), pkbf(p1[8 * k + 4], p1[8 * k + 5]), pkbf(p1[8 * k + 6], p1[8 * k + 7])};
        }
        const lds_cptr vp = (lds_cptr)lds + LV + sl * VSLOT + ((lane >> 4) & 1) * 32 + (lane & 3) * 8 + (4 * hi + ((lane & 15) >> 2)) * 64;
#pragma unroll
        for (int d0 = 0; d0 < DV / 32; ++d0) {
#pragma unroll
            for (int ks = 0; ks < 4; ++ks) {
                const s16x4 lo = vtr(vp + d0 * 4096 + ks * 1024), hh = vtr(vp + d0 * 4096 + ks * 1024 + 512);
                const bf16x8 vf = (bf16x8){lo[0], lo[1], lo[2], lo[3], hh[0], hh[1], hh[2], hh[3]};
                o[d0] = __builtin_amdgcn_mfma_f32_32x32x16_bf16(__builtin_bit_cast(bf16x8, pw[ks]), vf, o[d0], 0, 0, 0);
            }
            if (DV > 64) __builtin_amdgcn_sched_barrier(0);
        }
        sl = (sl == 2) ? 0 : sl + 1; sl2 = (sl2 == 2) ? 0 : sl2 + 1;
    }
    asm volatile("s_waitcnt lgkmcnt(0)\n\ts_barrier" ::: "memory");
#undef ATT_TILE
#undef ATT_DMA
}
__device__ __forceinline__ void row_inv(float (&rli)[16], float lsum, float extra, LAS float* wsf, int r32, int hi) {
    const float l = pg8::swap_sum32(lsum) + extra;
    LDS_WAIT();
    if (hi == 0) wsf[r32] = l;
    LDS_WAIT(); asm volatile("" ::: "memory");
#pragma unroll
    for (int r = 0; r < 16; ++r) rli[r] = __builtin_amdgcn_rcpf(wsf[crow(r, hi)]);
    LDS_WAIT(); asm volatile("" ::: "memory");
}
}

#ifndef DBG_NO_MOE
#define DBG_NO_MOE 0
#endif
#ifndef DBG_NO_MIX
#define DBG_NO_MIX 0
#endif
#ifndef DBG_AB
#define DBG_AB 0
#endif
#ifndef PH_MASK
#define PH_MASK 0x3ff
#endif
#define PH_ON(i) ((PH_MASK >> (i)) & 1)
#ifndef ATT_VARIANT
#define ATT_VARIANT 0
#endif
struct Args { const float* in[28]; float* out; unsigned char* ws; int ph_lo, ph_hi; };
enum { I_X = 0, I_C, I_CTX, I_CCTX, I_WMOD, I_BMOD, I_NMIX, I_NFFN, I_WINAB, I_WOUTAB, I_QNA, I_KNA, I_SINKA, I_QNB, I_KNB, I_WINC, I_WOUTC, I_QNC, I_KNC, I_LAMC, I_SUBLN,
       I_WGRP, I_BGRP, I_WEXP, I_BEXP, I_W1, I_W3, I_W2 };

__global__ void __launch_bounds__(NTHREADS, 2) mega(Args args) {
    extern __shared__ __attribute__((aligned(16))) unsigned char lds_[];
    LAS unsigned char* lds = (LAS unsigned char*)lds_;
    volatile LAS unsigned* MISC = (volatile LAS unsigned*)(lds + MISC_OFF);
    const int tid0 = threadIdx.x;
    const int G = gridDim.x, bx = blockIdx.x;
    const int vcu = (G % 8 == 0) ? (bx % 8) * (G / 8) + bx / 8 : bx;
    const int NGW = G * NWAVES;
#define PHASE_IDS() int tid = tid0; asm volatile("" : "+v"(tid)); const int lane = tid & 63, wave = __builtin_amdgcn_readfirstlane(tid >> 6), gw = vcu * NWAVES + wave; (void)lane; (void)wave; (void)gw
    unsigned char* ws = args.ws;
    unsigned* ctl = (unsigned*)(ws + WS_CTL);
    float* mod = (float*)(ws + WS_MOD); float* modc = mod + DEPTH * 6144;
    float* rope = (float*)(ws + WS_ROPE);
    float* xcur = (float*)(ws + WS_XCUR);
    bf16* HB = (bf16*)(ws + WS_HB); bf16* QKV = (bf16*)(ws + WS_QKV); bf16* OB = (bf16*)(ws + WS_OB); float* O1S = (float*)(ws + WS_O1S);
    bf16* XG = (bf16*)(ws + WS_XG); bf16* HG = (bf16*)(ws + WS_HG); bf16* YG = (bf16*)(ws + WS_YG);
    int* tok_e = (int*)(ws + WS_ROUTE + RT_TOKE); int* tok_p = (int*)(ws + WS_ROUTE + RT_TOKP); float* tok_w = (float*)(ws + WS_ROUTE + RT_TOKW);
    int* drow = (int*)(ws + WS_ROUTE + RT_DROW); float* rw = (float*)(ws + WS_ROUTE + RT_RW); int* tile_e = (int*)(ws + WS_ROUTE + RT_TILE); int* ntl = (int*)(ws + WS_ROUTE + RT_NT);

    for (int u = tid0; u < (LDS_BYTES - LDSCTL_OFF) / 4; u += NTHREADS) ((LAS unsigned*)(lds + LDSCTL_OFF))[u] = 0u;
    __syncthreads();
    const int ph_lo = args.ph_lo, ph_hi = args.ph_hi;
    XcdBarrier bar; bar.bar = ctl + CW_BAR; bar.x = 0; bar.st = nullptr;
    if (ph_hi - ph_lo > 1) bar = xcd_barrier_post(ctl + CW_BAR, MISC + 8);
#define IN(k) (ph_lo <= (k) && (k) < ph_hi)
#define SEAM(k) do { if (IN(k) && IN((k) + 1)) xcd_barrier(bar); } while (0)

    if (IN(0)) { if (!PH_ON(0)) __builtin_trap(); asm volatile("; MARK_PHASE p0" ::: "memory"); PHASE_IDS();
        {
            LAS float* sc = (LAS float*)lds; LAS float* scc = sc + 1024; LAS float* red = scc + 1024;
            for (int k = tid; k < 1024; k += NTHREADS) { const float a = args.in[I_C][k], b = args.in[I_CCTX][k];
                sc[k] = a / (1.f + __expf(-a)); scc[k] = b / (1.f + __expf(-b)); }
            __syncthreads();
            for (int it = bx; it < DEPTH * 96; it += G) {
                const int l = it / 96, col = (it % 96) * 64 + lane;
                const float* w = args.in[I_WMOD] + (size_t)l * 1024 * 6144 + col;
                float a0 = 0.f, a1 = 0.f;
#pragma unroll 8
                for (int kk = 0; kk < 128; ++kk) { const int k = wave * 128 + kk; const float wv = w[(size_t)k * 6144]; a0 += sc[k] * wv; a1 += scc[k] * wv; }
                red[wave * 64 + lane] = a0; red[512 + wave * 64 + lane] = a1;
                __syncthreads();
                if (wave < 2) { float s = 0.f;
#pragma unroll
                    for (int w8 = 0; w8 < 8; ++w8) s += red[wave * 512 + w8 * 64 + lane];
                    s += args.in[I_BMOD][l * 6144 + col];
                    (wave == 0 ? mod : modc)[l * 6144 + col] = s; }
                __syncthreads();
            }
        }
        for (int idx = bx * NTHREADS + tid; idx < 320 * 16; idx += G * NTHREADS) {
            const int t = idx >> 4, j = idx & 15; const float pos = (float)(t < 256 ? t : t - 256);
            const float inv = exp2f(-(float)j * (13.287712379549449f / 16.f));
            const float ang = pos * inv, rev = ang * 0.15915494309189535f, fr = rev - rintf(rev);
            const float cs = __builtin_amdgcn_cosf(fr), sn = __builtin_amdgcn_sinf(fr);
            if (t < 256) { rope[t * 16 + j] = cs; rope[4096 + t * 16 + j] = sn; } else { rope[8192 + (t - 256) * 16 + j] = cs; rope[9216 + (t - 256) * 16 + j] = sn; }
        }
        {
            LAS float* scr = (LAS float*)(lds + wave * 16384);
            constexpr int N_INAB = 2 * 16 * 48, N_INC = 2 * 16 * 96, N_OUT = 2 * 16 * 32, N_W13 = DEPTH * NEXP * 16 * 32, N_W2 = DEPTH * NEXP * 8 * 32;
            constexpr int NITEMS = N_INAB + N_INC + 2 * N_OUT + N_W13 + N_W2;
            for (int it = gw; it < NITEMS; it += NGW) {
                int r = it;
                if (r < N_INAB) { const int i = r / (16 * 48), q = r % (16 * 48), kb = q / 48, nb = q % 48, pin = (nb * 32) & 255, pn = (nb * 32) >> 8, bj = pin >> 7, wc = (pin & 127) >> 5;
                    transpose_item(args.in[I_WINAB] + (size_t)i * 1024 * 1536, 1536, (4 * pn + wc) * 64 + bj * 32, (bf16*)(ws + WS_BT_INAB) + (size_t)i * 1536 * 1024, 1024, nb * 32, kb * 64, scr, lane); continue; }
                r -= N_INAB;
                if (r < N_INC) { const int i = r / (16 * 96), q = r % (16 * 96), kb = q / 96, nb = q % 96, pin = (nb * 32) & 255, pn = (nb * 32) >> 8, bj = pin >> 7, wc = (pin & 127) >> 5;
                    transpose_item(args.in[I_WINC] + (size_t)i * 1024 * 3072, 3072, (4 * pn + wc) * 64 + bj * 32, (bf16*)(ws + WS_BT_INC) + (size_t)i * 3072 * 1024, 1024, nb * 32, kb * 64, scr, lane); continue; }
                r -= N_INC;
                if (r < N_OUT) { const int i = r / (16 * 32), q = r % (16 * 32), kb = q / 32, nb = q % 32;
                    transpose_item(args.in[I_WOUTAB] + (size_t)i * 1024 * 1024, 1024, nb * 32, (bf16*)(ws + WS_BT_OUTAB) + (size_t)i * 1024 * 1024, 1024, nb * 32, kb * 64, scr, lane); continue; }
                r -= N_OUT;
                if (r < N_OUT) { const int i = r / (16 * 32), q = r % (16 * 32), kb = q / 32, nb = q % 32;
                    transpose_item(args.in[I_WOUTC] + (size_t)i * 1024 * 1024, 1024, nb * 32, (bf16*)(ws + WS_BT_OUTC) + (size_t)i * 1024 * 1024, 1024, nb * 32, kb * 64, scr, lane); continue; }
                r -= N_OUT;
                if (r < N_W13) { const int le = r / (16 * 32), q = r % (16 * 32), kb = q / 32, nb = q % 32, pin = (nb * 32) & 255, pn = (nb * 32) >> 8, bj = pin >> 7, wc = (pin & 127) >> 5;
                    transpose_item(args.in[bj ? I_W3 : I_W1] + (size_t)le * 1024 * 512, 512, pn * 128 + wc * 32, (bf16*)(ws + WS_BT_W13) + (size_t)le * 1024 * 1024, 1024, nb * 32, kb * 64, scr, lane); continue; }
                r -= N_W13;
                { const int le = r / (8 * 32), q = r % (8 * 32), kb = q / 32, nb = q % 32;
                    transpose_item(args.in[I_W2] + (size_t)le * 512 * 1024, 1024, nb * 32, (bf16*)(ws + WS_BT_W2) + (size_t)le * 1024 * 512, 512, nb * 32, kb * 64, scr, lane); }
            }
        }
        __syncthreads();
    }
    SEAM(0);

    for (int l = 0; l < DEPTH; ++l) {
        const int pb = 1 + 8 * l, li = l >> 1;
        const bool isC = (l & 1) != 0, last = (l == DEPTH - 1);
        const float* modl = mod + l * 6144; const float* modcl = modc + l * 6144;
        const int mrows = last ? SEQ : MT;

        if (IN(pb + 0)) { if (!PH_ON(1)) __builtin_trap(); asm volatile("; MARK_PHASE pb+0" ::: "memory"); PHASE_IDS();
            const float* gmix = args.in[I_NMIX] + l * 1024;
            for (int m = gw; m < MT; m += NGW) {
                const bool isctx = m >= SEQ;
                const float* src = (l == 0) ? (isctx ? args.in[I_CTX] + (size_t)(m - SEQ) * 1024 : args.in[I_X] + (size_t)m * 1024) : xcur + (size_t)m * 1024;
                f32x4 v[4];
#pragma unroll
                for (int j = 0; j < 4; ++j) v[j] = *(const f32x4*)(src + 4 * lane + 256 * j);
                if (l > 0 && !((DBG_NO_MOE >> (l - 1)) & 1)) {
                    const int d0 = drow[2 * m], d1 = drow[2 * m + 1];
                    const float* gate = (isctx ? modc : mod) + (l - 1) * 6144 + 5 * 1024;
#pragma unroll
                    for (int j = 0; j < 4; ++j) { const u32x2 y0 = *(const u32x2*)(YG + (size_t)d0 * 1024 + 4 * lane + 256 * j), y1 = *(const u32x2*)(YG + (size_t)d1 * 1024 + 4 * lane + 256 * j);
                        const f32x4 gt = *(const f32x4*)(gate + 4 * lane + 256 * j);
                        v[j] = v[j] + gt * (f32x4){bflo(y0.x) + bflo(y1.x), bfhi(y0.x) + bfhi(y1.x), bflo(y0.y) + bflo(y1.y), bfhi(y0.y) + bfhi(y1.y)}; }
                }
#pragma unroll
                for (int j = 0; j < 4; ++j) *(f32x4*)(xcur + (size_t)m * 1024 + 4 * lane + 256 * j) = v[j];
                float ss = 0.f;
#pragma unroll
                for (int j = 0; j < 4; ++j) ss += (v[j][0] * v[j][0] + v[j][1] * v[j][1]) + (v[j][2] * v[j][2] + v[j][3] * v[j][3]);
                const float rstd = __builtin_amdgcn_rsqf(wave_sum(ss) * (1.f / 1024.f) + RMS_EPS);
                const float* mm = isctx ? modcl : modl;
#pragma unroll
                for (int j = 0; j < 4; ++j) { const int c0 = 4 * lane + 256 * j; const f32x4 gn = *(const f32x4*)(gmix + c0), sh = *(const f32x4*)(mm + c0), scl = *(const f32x4*)(mm + 1024 + c0);
                    const f32x4 h = v[j] * rstd * gn * (scl + 1.f) + sh;
                    *(u32x2*)(HB + (size_t)m * 1024 + c0) = (u32x2){pkbf(h[0], h[1]), pkbf(h[2], h[3])}; }
            }
        }
        SEAM(pb + 0);

        if (IN(pb + 1)) { if (!PH_ON(2)) __builtin_trap(); asm volatile("; MARK_PHASE pb+1" ::: "memory"); PHASE_IDS();
            const int N = isC ? 3072 : 1536;
            pg8::Gemm g{HB, isC ? (const bf16*)(ws + WS_BT_INC) + (size_t)li * 3072 * 1024 : (const bf16*)(ws + WS_BT_INAB) + (size_t)li * 1536 * 1024, MT, N, 1024};
            pg8::StaticOrder S; S.init(MT, N, G, bx);
            pg8::EpiQKV E{QKV, isC ? args.in[I_QNC] + li * 64 : args.in[I_QNA] + li * 64, isC ? args.in[I_KNC] + li * 64 : args.in[I_KNA] + li * 64,
                          args.in[I_QNB] + li * 64, args.in[I_KNB] + li * 64, rope, isC ? 1 : 0};
            pg8::gemm_phase<pg8::EpiQKV, pg8::StaticOrder, true, true>(lds, g, S, E);
        }
        SEAM(pb + 1);

        if (IN(pb + 2)) { if (!PH_ON(3)) __builtin_trap(); asm volatile("; MARK_PHASE pb+2" ::: "memory"); PHASE_IDS();
            const int r32 = lane & 31, hi = lane >> 5;
            LAS float* wsf = (LAS float*)(lds + LDS_WSF) + wave * 32;
            if (!isC && ATT_VARIANT != 2) {
                LAS bf16* stg = (LAS bf16*)(lds + LDS_STAGE) + wave * 2048;
                for (int u = vcu; u < 1040; u += G) {
                    int head16, qt, t0, n1, masked, has_sink, kvslot, vslot, qslot;
                    if (u < 512) { const int h = u >> 6; qt = u & 63; head16 = 8 + h; t0 = 0; n1 = 256; masked = 0; has_sink = 0; qslot = 12 + h; kvslot = 20 + (h >> 2); vslot = 22 + (h >> 2); }
                    else if (u < 1024) { const int h = (u - 512) >> 6; qt = u & 63; head16 = h; t0 = (4 * qt - 2 > 0) ? 4 * qt - 2 : 0; const int t1 = (4 * qt + 6 < 256) ? 4 * qt + 6 : 256; n1 = t1 - t0;
                        masked = 1; has_sink = 1; qslot = h; kvslot = 8 + (h >> 2); vslot = 10 + (h >> 2); }
                    else { const int h16 = u - 1024; qt = 64; head16 = h16; t0 = 0; n1 = 0; masked = 0;
                        if (h16 < 8) { has_sink = 1; qslot = h16; kvslot = 8 + (h16 >> 2); vslot = 10 + (h16 >> 2); } else { const int h = h16 - 8; has_sink = 0; qslot = 12 + h; kvslot = 20 + (h >> 2); vslot = 22 + (h >> 2); } }
                    const int row0 = qt * 256 + wave * 32;
                    f32x16 o[2]; o[0] = f32x16{}; o[1] = f32x16{}; float lsum = 0.f;
                    att::attn_pass<64>(o, lsum, QKV + (size_t)qslot * SLOT + (size_t)row0 * 64, QKV + (size_t)kvslot * SLOT, QKV + (size_t)vslot * SLOT, 64, t0, n1, masked, row0, lds, wave, lane);
                    const float extra = has_sink ? __builtin_amdgcn_exp2f(args.in[I_SINKA][li * 8 + (head16 & 7)] * LOG2E) : 0.f;
                    int ln = lane; asm volatile("" : "+v"(ln));
                    const int r32e = ln & 31, hie = ln >> 5;
                    float rli[16]; att::row_inv(rli, lsum, extra, wsf, r32e, hie);
#pragma unroll
                    for (int r = 0; r < 16; ++r) { const int orow = att::crow(r, hie);
#pragma unroll
                        for (int d0 = 0; d0 < 2; ++d0) stg[orow * 64 + d0 * 32 + r32e] = ((DBG_AB == 1 && head16 < 8) || (DBG_AB == 2 && head16 >= 8) || (DBG_AB == 3 && u >= 1024)) ? (bf16)0 : (bf16)(pkbf(o[d0][r] * rli[r], 0.f) & 0xffffu); }
                    LDS_WAIT(); asm volatile("" ::: "memory");
                    bf16* Ow = OB + (size_t)row0 * 1024 + head16 * 64;
#pragma unroll
                    for (int i = 0; i < 4; ++i) { const int row = i * 8 + (ln >> 3), ch = ln & 7; const u32x4 vv = *(const LAS u32x4*)(stg + row * 64 + ch * 8); *(u32x4*)(Ow + (size_t)row * 1024 + ch * 8) = vv; }
                    LDS_WAIT(); asm volatile("" ::: "memory");
                }
            } else if (ATT_VARIANT != 1) {
                LAS bf16* stg = (LAS bf16*)(lds + LDS_STAGE) + wave * 4096;
                const float lam_init = 0.8f - 0.6f * __expf(-0.3f * (float)l);
                const float* lp = args.in[I_LAMC] + li * 256;
                const float lam = __expf(wave_sum(lp[lane] * lp[64 + lane])) - __expf(wave_sum(lp[128 + lane] * lp[192 + lane])) + lam_init;
                const float* subln = args.in[I_SUBLN] + li * 128;
                const int nunits = last ? 512 : 520;
                for (int u = vcu; u < nunits; u += G) {
                    int h, qt, n1;
                    if (u < 512) { h = u >> 6; qt = u & 63; n1 = 256; } else { h = u - 512; qt = 64; n1 = 0; }
                    const int row0 = qt * 256 + wave * 32;
                    float* o1b = O1S + ((size_t)u * 8 + wave) * 4096;
                    f32x16 o[4]; float rli[16];
                    for (int comp = 0; comp < 2; ++comp) {
#pragma unroll
                        for (int d0 = 0; d0 < 4; ++d0) o[d0] = f32x16{};
                        float lsum = 0.f;
                        att::attn_pass<128>(o, lsum, QKV + (size_t)(2 * h + comp) * SLOT + (size_t)row0 * 64, QKV + (size_t)(16 + 2 * h + comp) * SLOT, QKV + (size_t)(32 + 2 * h) * SLOT, 128, 0, n1, 0, 0, lds, wave, lane);
                        { int l1 = lane; asm volatile("" : "+v"(l1)); att::row_inv(rli, lsum, 0.f, wsf, l1 & 31, l1 >> 5); }
                        if (comp == 0) {
                            int l0 = lane; asm volatile("" : "+v"(l0)); float* o1p = o1b + l0;
#pragma unroll
                            for (int d0 = 0; d0 < 4; ++d0) {
#pragma unroll
                                for (int r = 0; r < 16; ++r) o1p[(d0 * 16 + r) * 64] = o[d0][r] * rli[r];
                                asm volatile("" ::: "memory"); }
                        }
                    }
                    int ln = lane; asm volatile("" : "+v"(ln));
                    const int r32e = ln & 31, hie = ln >> 5;
                    float ssr[16];
#pragma unroll
                    for (int r = 0; r < 16; ++r) ssr[r] = 0.f;
                    const float* o1p = o1b + ln;
#pragma unroll
                    for (int d0 = 0; d0 < 4; ++d0) {
#pragma unroll
                        for (int r = 0; r < 16; ++r) { const float vv = o1p[(d0 * 16 + r) * 64] - lam * (o[d0][r] * rli[r]); o[d0][r] = vv; ssr[r] += vv * vv; }
                        asm volatile("" ::: "memory"); }
#pragma unroll
                    for (int r = 0; r < 16; ++r) { float s = ssr[r];
#pragma unroll
                        for (int x = 1; x < 32; x <<= 1) s += __shfl_xor(s, x);
                        ssr[r] = __builtin_amdgcn_rsqf(s * (1.f / 128.f) + RMS_EPS) * (1.f - lam_init); }
#pragma unroll
                    for (int d0 = 0; d0 < 4; ++d0) { const float sg = subln[d0 * 32 + r32e];
#pragma unroll
                        for (int r = 0; r < 16; ++r) stg[att::crow(r, hie) * 128 + d0 * 32 + r32e] = (bf16)(pkbf(o[d0][r] * ssr[r] * sg, 0.f) & 0xffffu); }
                    LDS_WAIT(); asm volatile("" ::: "memory");
                    bf16* Ow = OB + (size_t)row0 * 1024 + h * 128;
#pragma unroll
                    for (int i = 0; i < 8; ++i) { const int row = i * 4 + (ln >> 4), ch = ln & 15; const u32x4 vv = *(const LAS u32x4*)(stg + row * 128 + ch * 8); *(u32x4*)(Ow + (size_t)row * 1024 + ch * 8) = vv; }
                    LDS_WAIT(); asm volatile("" ::: "memory");
                }
            }
            __syncthreads();
        }
        SEAM(pb + 2);

        if (IN(pb + 3) && !((DBG_NO_MIX >> l) & 1)) { if (!PH_ON(4)) __builtin_trap(); asm volatile("; MARK_PHASE pb+3" ::: "memory"); PHASE_IDS();
            pg8::Gemm g{OB, isC ? (const bf16*)(ws + WS_BT_OUTC) + (size_t)li * 1024 * 1024 : (const bf16*)(ws + WS_BT_OUTAB) + (size_t)li * 1024 * 1024, mrows, 1024, 1024};
            pg8::StaticOrder S; S.init(mrows, 1024, G, bx);
            pg8::EpiResid E{xcur, modl + 2 * 1024, modcl + 2 * 1024};
            pg8::gemm_phase<pg8::EpiResid, pg8::StaticOrder, true, true>(lds, g, S, E);
        }
        SEAM(pb + 3);

        if (IN(pb + 4)) { if (!PH_ON(5)) __builtin_trap(); asm volatile("; MARK_PHASE pb+4" ::: "memory"); PHASE_IDS();
            const float* gffn = args.in[I_NFFN] + l * 1024;
            const float* wg = args.in[I_WGRP] + (size_t)l * 1024 * 4; const float* we = args.in[I_WEXP] + (size_t)l * 1024 * 32;
            const float* bg = args.in[I_BGRP] + l * 4; const float* be = args.in[I_BEXP] + l * 32;
            for (int m = gw; m < mrows; m += NGW) {
                const bool isctx = m >= SEQ; const float* mm = isctx ? modcl : modl;
                f32x4 v[4];
#pragma unroll
                for (int j = 0; j < 4; ++j) v[j] = *(const f32x4*)(xcur + (size_t)m * 1024 + 4 * lane + 256 * j);
                float ss = 0.f;
#pragma unroll
                for (int j = 0; j < 4; ++j) ss += (v[j][0] * v[j][0] + v[j][1] * v[j][1]) + (v[j][2] * v[j][2] + v[j][3] * v[j][3]);
                const float rstd = __builtin_amdgcn_rsqf(wave_sum(ss) * (1.f / 1024.f) + RMS_EPS);
                float acc[36];
#pragma unroll
                for (int q = 0; q < 36; ++q) acc[q] = 0.f;
#pragma unroll
                for (int j = 0; j < 4; ++j) { const int c0 = 4 * lane + 256 * j; const f32x4 gn = *(const f32x4*)(gffn + c0), sh = *(const f32x4*)(mm + 3 * 1024 + c0), scl = *(const f32x4*)(mm + 4 * 1024 + c0);
                    const f32x4 t = v[j] * rstd * gn * (scl + 1.f) + sh;
                    *(u32x2*)(HB + (size_t)m * 1024 + c0) = (u32x2){pkbf(t[0], t[1]), pkbf(t[2], t[3])};
#pragma unroll
                    for (int e = 0; e < 4; ++e) { const float tv = t[e]; const f32x4 w4 = *(const f32x4*)(wg + (size_t)(c0 + e) * 4);
                        acc[0] += tv * w4[0]; acc[1] += tv * w4[1]; acc[2] += tv * w4[2]; acc[3] += tv * w4[3];
#pragma unroll
                        for (int q = 0; q < 8; ++q) { const f32x4 w8 = *(const f32x4*)(we + (size_t)(c0 + e) * 32 + 4 * q);
                            acc[4 + 4 * q] += tv * w8[0]; acc[5 + 4 * q] += tv * w8[1]; acc[6 + 4 * q] += tv * w8[2]; acc[7 + 4 * q] += tv * w8[3]; } }
                }
#pragma unroll
                for (int q = 0; q < 36; ++q) acc[q] = wave_sum(acc[q]);
                float lg[4]; int gidx = 0; float gmax;
#pragma unroll
                for (int q = 0; q < 4; ++q) lg[q] = acc[q] + bg[q];
                gmax = lg[0];
#pragma unroll
                for (int q = 1; q < 4; ++q) if (lg[q] > gmax) { gmax = lg[q]; gidx = q; }
                float gden = 0.f;
#pragma unroll
                for (int q = 0; q < 4; ++q) gden += __expf(lg[q] - gmax);
                const float gprob = 1.f / gden;
                float le8[8];
#pragma unroll
                for (int k = 0; k < 8; ++k) { float s = acc[4 + k] + be[k];
#pragma unroll
                    for (int q = 1; q < 4; ++q) s = (gidx == q) ? acc[4 + 8 * q + k] + be[8 * q + k] : s;
                    le8[k] = s; }
                int i1 = 0; float m1 = le8[0];
#pragma unroll
                for (int k = 1; k < 8; ++k) if (le8[k] > m1) { m1 = le8[k]; i1 = k; }
                int i2 = -1; float m2 = -3.0e38f;
#pragma unroll
                for (int k = 0; k < 8; ++k) if (k != i1 && le8[k] > m2) { m2 = le8[k]; i2 = k; }
                const float e2 = __expf(m2 - m1), inv = 1.f / (1.f + e2);
                const float w1 = gprob * inv, w2 = gprob * e2 * inv;
                if (lane == 0) {
                    const int ea = gidx * 8 + i1, eb = gidx * 8 + i2;
                    const int pa = (int)atomicAdd(ctl + CW_CNT + l * 64 + ea, 1u), pb2 = (int)atomicAdd(ctl + CW_CNT + l * 64 + eb, 1u);
                    tok_e[2 * m] = ea; tok_e[2 * m + 1] = eb; tok_p[2 * m] = pa; tok_p[2 * m + 1] = pb2; tok_w[2 * m] = w1; tok_w[2 * m + 1] = w2;
                }
            }
        }
        SEAM(pb + 4);

        if (IN(pb + 5)) { if (!PH_ON(6)) __builtin_trap(); asm volatile("; MARK_PHASE pb+5" ::: "memory"); PHASE_IDS();
            int pad = 0;
            if (lane < 32) { const unsigned c = __hip_atomic_load(ctl + CW_CNT + l * 64 + lane, __ATOMIC_RELAXED, __HIP_MEMORY_SCOPE_AGENT); pad = (int)((c + 255u) & ~255u); }
            int incl = pad;
#pragma unroll
            for (int o = 1; o < 32; o <<= 1) { const int t = __shfl_up(incl, o); if (lane >= o) incl += t; }
            const int base = incl - pad;
            for (int m = gw; m < mrows; m += NGW) {
#pragma unroll
                for (int k = 0; k < 2; ++k) {
                    const int e = tok_e[2 * m + k], pos = tok_p[2 * m + k];
                    const int row = __shfl(base, e) + pos;
                    const bf16* src = HB + (size_t)m * 1024; bf16* dst = XG + (size_t)row * 1024;
#pragma unroll
                    for (int j = 0; j < 2; ++j) *(u32x4*)(dst + 8 * lane + 512 * j) = *(const u32x4*)(src + 8 * lane + 512 * j);
                    if (lane == 0) { drow[2 * m + k] = row; rw[row] = tok_w[2 * m + k]; }
                }
            }
            if (bx == 0 && wave == 0) {
                if (lane < 32) for (int t = base >> 8; t < (base + pad) >> 8; ++t) tile_e[t] = lane;
                if (lane == 31) ntl[0] = (base + pad) >> 8;
            }
        }
        SEAM(pb + 5);

        if (IN(pb + 6)) { if (!PH_ON(7)) __builtin_trap(); asm volatile("; MARK_PHASE pb+6" ::: "memory"); PHASE_IDS();
            LAS int* tab = (LAS int*)(lds + TAB_OFF);
            if (tid < 256) tab[tid] = tile_e[tid];
            if (tid == 0) tab[256] = ntl[0];
            __syncthreads();
            const int nt = tab[256];
            pg8::Gemm g{XG, (const bf16*)(ws + WS_BT_W13) + (size_t)l * NEXP * 1024 * 1024, XG_ROWS, 1024, 1024};
            pg8::MoeOrder S{tab, nt * 4, G, bx};
            pg8::EpiSwiGLU E{HG};
            pg8::gemm_phase<pg8::EpiSwiGLU, pg8::MoeOrder, true, true>(lds, g, S, E);
        }
        SEAM(pb + 6);

        if (IN(pb + 7)) { if (!PH_ON(8)) __builtin_trap(); asm volatile("; MARK_PHASE pb+7" ::: "memory"); PHASE_IDS();
            LAS int* tab = (LAS int*)(lds + TAB_OFF);
            if (tid < 256) tab[tid] = tile_e[tid];
            if (tid == 0) tab[256] = ntl[0];
            __syncthreads();
            const int nt = tab[256];
            pg8::Gemm g{HG, (const bf16*)(ws + WS_BT_W2) + (size_t)l * NEXP * 1024 * 512, XG_ROWS, 1024, 512};
            pg8::MoeOrder S{tab, nt * 4, G, bx};
            pg8::EpiY E{YG, rw};
            pg8::gemm_phase<pg8::EpiY, pg8::MoeOrder, true, true>(lds, g, S, E);
        }
        SEAM(pb + 7);
    }

    if (IN(NPH - 1)) { if (!PH_ON(9)) __builtin_trap(); asm volatile("; MARK_PHASE final" ::: "memory"); PHASE_IDS();
        const float* gate = mod + (DEPTH - 1) * 6144 + 5 * 1024;
        for (int m = gw; m < SEQ; m += NGW) {
            const int d0 = drow[2 * m], d1 = drow[2 * m + 1];
#pragma unroll
            for (int j = 0; j < 4; ++j) { const int c0 = 4 * lane + 256 * j;
                f32x4 v = *(const f32x4*)(xcur + (size_t)m * 1024 + c0);
                const u32x2 y0 = *(const u32x2*)(YG + (size_t)d0 * 1024 + c0), y1 = *(const u32x2*)(YG + (size_t)d1 * 1024 + c0);
                const f32x4 gt = *(const f32x4*)(gate + c0);
                if (!((DBG_NO_MOE >> 3) & 1)) v = v + gt * (f32x4){bflo(y0.x) + bflo(y1.x), bfhi(y0.x) + bfhi(y1.x), bflo(y0.y) + bflo(y1.y), bfhi(y0.y) + bfhi(y1.y)};
                *(f32x4*)(args.out + (size_t)m * 1024 + c0) = v; }
        }
    }
#undef IN
#undef SEAM
}

#ifndef MK_PER_PHASE
#define MK_PER_PHASE 1
#endif
extern "C" void kernel_launch(void* const* d_in, const int* in_sizes, int n_in, void* d_out, int out_size, void* d_ws, size_t ws_size, hipStream_t stream) {
    static int grid = 0;
    if (grid == 0) {
        if (n_in != 28 || out_size != SEQ * DM || ws_size < WS_END) { fprintf(stderr, "kernel_launch: unexpected shapes (n_in %d, out %d, ws %zu)\n", n_in, out_size, ws_size); grid = -1; return; }
        int dev = 0, cus = 0;
        if (hipGetDevice(&dev) != hipSuccess || hipDeviceGetAttribute(&cus, hipDeviceAttributeMultiprocessorCount, dev) != hipSuccess) { grid = -1; return; }
        if (hipFuncSetAttribute((const void*)mega, hipFuncAttributeMaxDynamicSharedMemorySize, LDS_BYTES) != hipSuccess) { fprintf(stderr, "kernel_launch: hipFuncSetAttribute failed\n"); grid = -1; return; }
        (void)hipGetLastError();
        grid = cus;
    }
    if (grid < 0) return;
    (void)hipMemsetAsync((char*)d_ws + WS_CTL, 0, CTL_ZERO_BYTES, stream);
    Args a{};
    for (int i = 0; i < 28; ++i) a.in[i] = (const float*)d_in[i];
    a.out = (float*)d_out; a.ws = (unsigned char*)d_ws;
#if MK_PER_PHASE
    for (int p = 0; p < NPH; ++p) { a.ph_lo = p; a.ph_hi = p + 1; hipLaunchKernelGGL(mega, dim3(grid), dim3(NTHREADS), LDS_BYTES, stream, a); }
#else
    a.ph_lo = 0; a.ph_hi = NPH; hipLaunchKernelGGL(mega, dim3(grid), dim3(NTHREADS), LDS_BYTES, stream, a);
#endif
}
```

```cpp
#include <hip/hip_runtime.h>
#include <cstdio>
#include <cstdint>
namespace pg8 {
#define PG8_LAS __attribute__((address_space(3)))
typedef unsigned short bf16_t;
typedef short bf16x8 __attribute__((ext_vector_type(8)));
typedef float f32x4 __attribute__((ext_vector_type(4)));
typedef unsigned u32x4 __attribute__((ext_vector_type(4)));
constexpr int BM = 256, BK = 64, HALF = 128, HTB = HALF * BK * 2  , STAGE_BYTES = 8 * HTB, NXCD = 8, WGM = 8;

__host__ __device__ __forceinline__ int lds_byte(int r, int c) { const int st = (r >> 4) * 2 + (c >> 5), rr = r & 15, cc = c & 31, ob = rr * 64 + cc * 2; return st * 1024 + (ob ^ (((ob >> 9) & 1) << 5)); }
__host__ __device__ __forceinline__ void stage_rc(int b, int& R, int& C) { const int st = b / 1024, sb = b % 1024, swz = sb ^ (((sb >> 9) & 1) << 5); R = (st >> 1) * 16 + swz / 64; C = (st & 1) * 32 + (swz % 64) / 2; }
__host__ __device__ __forceinline__ int perm32(int rho) { const int n = rho >> 4, i = rho & 15; return 8 * (i >> 2) + 4 * n + (i & 3); }

struct Unit { int pm, pn; };
struct Gemm { const bf16_t* A; const bf16_t* Bt; int M, N, K; };

struct StaticOrder {
    int nM, nN, nwg, G, c;
    __host__ __device__ void init(int M, int N, int G_, int c_) { nM = M / BM; nN = N / BM; nwg = nM * nN; G = G_; c = c_; }
    __host__ __device__ bool next(int i, Unit& u) const {
        const long L = (long)i * G + c; if (L >= nwg) return false;
        int wgid = (int)L; { const int q = nwg / NXCD, r = nwg % NXCD, xcd = wgid % NXCD, off = wgid / NXCD; wgid = (xcd < r ? xcd * (q + 1) : r * (q + 1) + (xcd - r) * q) + off; }
        const int nig = WGM * nN, gid = wgid / nig, fm = gid * WGM, gsz = (nM - fm) < WGM ? (nM - fm) : WGM;
        u.pm = fm + ((wgid % nig) % gsz); u.pn = (wgid % nig) / gsz; return true;
    }
    __device__ __forceinline__ void a_ready(const Unit&) const {}
    __device__ __forceinline__ void done(const Unit&) const {}
};

__device__ __forceinline__ unsigned cvt_pk_bf16(float lo, float hi) { unsigned r; asm volatile("v_cvt_pk_bf16_f32 %0, %1, %2" : "=v"(r) : "v"(lo), "v"(hi)); return r; }
typedef float f32x2v __attribute__((ext_vector_type(2)));
typedef __bf16 bf16x2v __attribute__((ext_vector_type(2)));
__device__ __forceinline__ unsigned pkbf(float lo, float hi) { f32x2v v = {lo, hi}; bf16x2v b = __builtin_convertvector(v, bf16x2v); return __builtin_bit_cast(unsigned, b); }
__device__ __forceinline__ float swap_sum16(float x) { return x + __shfl_xor(x, 16); }
__device__ __forceinline__ float swap_sum32(float x) { return x + __shfl_xor(x, 32); }
constexpr int E_SEQ = 16384, E_MT = 16640;
constexpr size_t E_SLOT = (size_t)E_MT * 64;
constexpr float E_C2 = 0.125f * 1.4426950408889634f;

struct EpiQKV {
    static constexpr bool PERM = true, AFTER_DRAIN = false;
    bf16_t* qkv; const float *gq0, *gk0, *gq1, *gk1; const float* rope; int isC;
    __device__ __forceinline__ void operator()(const f32x4 (&acc)[2][2][4][2], const Unit& u, int wr, int wc, int fr, int fq) const {
        const int gi = u.pn * 4 + wc;
        int type; const float* gain = gq0; bf16_t* out; int pitch = 64;
        if (!isC) {
            if (gi < 8) { type = 0; gain = gq0; } else if (gi < 10) { type = 1; gain = gk0; } else if (gi < 12) { type = 2; }
            else if (gi < 20) { type = 0; gain = gq1; } else if (gi < 22) { type = 1; gain = gk1; } else { type = 2; }
            out = qkv + (size_t)gi * E_SLOT;
        } else {
            if (gi < 16) { type = 0; gain = gq0; out = qkv + (size_t)gi * E_SLOT; }
            else if (gi < 32) { type = 1; gain = gk0; out = qkv + (size_t)gi * E_SLOT; }
            else { type = 2; const int vg = gi - 32; out = qkv + (size_t)(32 + 2 * (vg >> 1)) * E_SLOT + (vg & 1) * 64; pitch = 128; }
        }
        const int rowbase = u.pm * BM + wr * 64 + fr;
        if (type < 2) {
            f32x4 g[2][2];
#pragma unroll
            for (int bj = 0; bj < 2; ++bj)
#pragma unroll
                for (int n = 0; n < 2; ++n) g[bj][n] = *(const f32x4*)(gain + bj * 32 + 8 * fq + 4 * n);
            const float qs = (type == 0) ? E_C2 : 1.f;
#pragma unroll
            for (int ai = 0; ai < 2; ++ai)
#pragma unroll
                for (int m = 0; m < 4; ++m) {
                    const int r = rowbase + ai * HALF + m * 16;
                    f32x4 v[2][2];
#pragma unroll
                    for (int bj = 0; bj < 2; ++bj)
#pragma unroll
                        for (int n = 0; n < 2; ++n) v[bj][n] = acc[ai][bj][m][n];
                    float ss = 0.f;
#pragma unroll
                    for (int bj = 0; bj < 2; ++bj)
#pragma unroll
                        for (int n = 0; n < 2; ++n) ss += (v[bj][n][0] * v[bj][n][0] + v[bj][n][1] * v[bj][n][1]) + (v[bj][n][2] * v[bj][n][2] + v[bj][n][3] * v[bj][n][3]);
                    ss = swap_sum16(ss); ss = swap_sum32(ss);
                    const float rstd = __builtin_amdgcn_rsqf(ss * (1.f / 64.f) + 1e-6f) * qs;
#pragma unroll
                    for (int bj = 0; bj < 2; ++bj)
#pragma unroll
                        for (int n = 0; n < 2; ++n) v[bj][n] = v[bj][n] * rstd * g[bj][n];
                    const int rr = (r < E_SEQ) ? r : 0;
                    const float* tb = (fq < 2) ? (rope + (rr >> 6) * 16 + 8 * fq) : (rope + 8192 + (rr & 63) * 16 + 8 * (fq - 2));
                    const int so = (fq < 2) ? 4096 : 1024;
#pragma unroll
                    for (int n = 0; n < 2; ++n) {
                        f32x4 cs = *(const f32x4*)(tb + 4 * n), sn = *(const f32x4*)(tb + so + 4 * n);
                        if (r >= E_SEQ) { cs = (f32x4){1.f, 1.f, 1.f, 1.f}; sn = (f32x4){0.f, 0.f, 0.f, 0.f}; }
                        const f32x4 y1 = v[0][n], y2 = v[1][n];
                        v[0][n] = y1 * cs - y2 * sn; v[1][n] = y2 * cs + y1 * sn;
                    }
#pragma unroll
                    for (int bj = 0; bj < 2; ++bj) {
                        u32x4 w; w.x = pkbf(v[bj][0][0], v[bj][0][1]); w.y = pkbf(v[bj][0][2], v[bj][0][3]); w.z = pkbf(v[bj][1][0], v[bj][1][1]); w.w = pkbf(v[bj][1][2], v[bj][1][3]);
                        *(u32x4*)(out + (size_t)r * 64 + bj * 32 + 8 * fq) = w;
                    }
                }
        } else {
#pragma unroll
            for (int ai = 0; ai < 2; ++ai)
#pragma unroll
                for (int m = 0; m < 4; ++m) {
                    const int r = rowbase + ai * HALF + m * 16;
#pragma unroll
                    for (int bj = 0; bj < 2; ++bj) {
                        const f32x4 v0 = acc[ai][bj][m][0], v1 = acc[ai][bj][m][1];
                        u32x4 w; w.x = pkbf(v0[0], v0[1]); w.y = pkbf(v0[2], v0[3]); w.z = pkbf(v1[0], v1[1]); w.w = pkbf(v1[2], v1[3]);
                        *(u32x4*)(out + (size_t)r * pitch + bj * 32 + 8 * fq) = w;
                    }
                }
        }
    }
};

struct EpiResid {
    static constexpr bool PERM = true, AFTER_DRAIN = false;
    float* x; const float* gate_lat; const float* gate_ctx;
    __device__ __forceinline__ void operator()(const f32x4 (&acc)[2][2][4][2], const Unit& u, int wr, int wc, int fr, int fq) const {
        const float* gate = (u.pm == 64) ? gate_ctx : gate_lat;
        const int col0 = u.pn * BM + wc * 32 + 8 * fq, rowbase = u.pm * BM + wr * 64 + fr;
        f32x4 gv[2][2];
#pragma unroll
        for (int bj = 0; bj < 2; ++bj)
#pragma unroll
            for (int n = 0; n < 2; ++n) gv[bj][n] = *(const f32x4*)(gate + col0 + bj * HALF + 4 * n);
#pragma unroll
        for (int ai = 0; ai < 2; ++ai)
#pragma unroll
            for (int m = 0; m < 4; ++m) {
                float* xr = x + (size_t)(rowbase + ai * HALF + m * 16) * 1024 + col0;
#pragma unroll
                for (int bj = 0; bj < 2; ++bj)
#pragma unroll
                    for (int n = 0; n < 2; ++n) { f32x4 xv = *(f32x4*)(xr + bj * HALF + 4 * n); xv = xv + gv[bj][n] * acc[ai][bj][m][n]; *(f32x4*)(xr + bj * HALF + 4 * n) = xv; }
            }
    }
};

struct EpiSwiGLU {
    static constexpr bool PERM = true, AFTER_DRAIN = false;
    bf16_t* H;
    __device__ __forceinline__ void operator()(const f32x4 (&acc)[2][2][4][2], const Unit& u, int wr, int wc, int fr, int fq) const {
        const int col0 = (u.pn & 3) * 128 + wc * 32 + 8 * fq, rowbase = u.pm * BM + wr * 64 + fr;
#pragma unroll
        for (int ai = 0; ai < 2; ++ai)
#pragma unroll
            for (int m = 0; m < 4; ++m) {
                float h[8];
#pragma unroll
                for (int n = 0; n < 2; ++n)
#pragma unroll
                    for (int e = 0; e < 4; ++e) { const float a = acc[ai][0][m][n][e], b = acc[ai][1][m][n][e];
                        h[4 * n + e] = a * b * __builtin_amdgcn_rcpf(1.f + __builtin_amdgcn_exp2f(-1.4426950408889634f * a)); }
                u32x4 w; w.x = pkbf(h[0], h[1]); w.y = pkbf(h[2], h[3]); w.z = pkbf(h[4], h[5]); w.w = pkbf(h[6], h[7]);
                *(u32x4*)(H + (size_t)(rowbase + ai * HALF + m * 16) * 512 + col0) = w;
            }
    }
};

struct EpiY {
    static constexpr bool PERM = true, AFTER_DRAIN = false;
    bf16_t* Y; const float* rw;
    __device__ __forceinline__ void operator()(const f32x4 (&acc)[2][2][4][2], const Unit& u, int wr, int wc, int fr, int fq) const {
        const int col0 = (u.pn & 3) * BM + wc * 32 + 8 * fq, rowbase = u.pm * BM + wr * 64 + fr;
#pragma unroll
        for (int ai = 0; ai < 2; ++ai)
#pragma unroll
            for (int m = 0; m < 4; ++m) {
                const int r = rowbase + ai * HALF + m * 16; const float w8 = rw[r];
#pragma unroll
                for (int bj = 0; bj < 2; ++bj) { const f32x4 v0 = acc[ai][bj][m][0] * w8, v1 = acc[ai][bj][m][1] * w8;
                    u32x4 w; w.x = pkbf(v0[0], v0[1]); w.y = pkbf(v0[2], v0[3]); w.z = pkbf(v1[0], v1[1]); w.w = pkbf(v1[2], v1[3]);
                    *(u32x4*)(Y + (size_t)r * 1024 + col0 + bj * HALF) = w; }
            }
    }
};

struct MoeOrder {
    const PG8_LAS int* tile_e; int nunits, G, c;
    __device__ __forceinline__ bool next(int i, Unit& u) const {
        const int L = i * G + c; if (L >= nunits) return false;
        const int pm = L >> 2; const int e = tile_e[pm];
        u.pm = __builtin_amdgcn_readfirstlane(pm); u.pn = __builtin_amdgcn_readfirstlane(e * 4 + (L & 3)); return true;
    }
    __device__ __forceinline__ void a_ready(const Unit&) const {}
    __device__ __forceinline__ void done(const Unit&) const {}
};

template <class Epi, class Sched, bool ALIGN_EPI = false, bool SP2 = false>
__device__ __forceinline__ void gemm_phase(PG8_LAS unsigned char* lds, const Gemm g, const Sched& S, const Epi& E) {
    int tid_ = threadIdx.x;
    const int tid = tid_, wid = __builtin_amdgcn_readfirstlane(tid >> 6), lane = tid & 63, wr = wid >> 2, wc = wid & 3, fr = lane & 15, fq = lane >> 4;
    const int K = g.K, nt = K / BK;
    unsigned voffA[2], voffB[2];
#pragma unroll
    for (int i = 0; i < 2; ++i) { int R, C; stage_rc(tid * 16 + i * 8192, R, C); const int Rb = Epi::PERM ? ((R & ~31) + perm32(R & 31)) : R;
        voffA[i] = (unsigned)(R * K + C) * 2u; voffB[i] = (unsigned)(Rb * K + C) * 2u; }
    const size_t kstep = (size_t)(BK * 2);
    const size_t hstep = (size_t)HALF * K * 2;
    const size_t tstep = 2 * hstep;
    const unsigned ldsw = (unsigned)wid * 1024u;
    const int aoff = lds_byte(wr * 64 + fr, fq * 8), boff = lds_byte(wc * 32 + fr, fq * 8);
#define PG8_SA(b, h) (((b) * 2 + (h)) * HTB)
#define PG8_SB(b, h) ((4 + (b) * 2 + (h)) * HTB)
#define PG8_STAGE(bufoff, gbase, voff) do { _Pragma("unroll") for (int _i = 0; _i < 2; ++_i) \
        __builtin_amdgcn_global_load_lds((const unsigned*)((const char*)(gbase) + (voff)[_i]), (PG8_LAS unsigned*)(lds + (bufoff) + ldsw + _i * 8192), 16, 0, 0); } while (0)
#define PG8_LDA(dst, b, h) do { _Pragma("unroll") for (int m = 0; m < 4; ++m) _Pragma("unroll") for (int k = 0; k < 2; ++k) dst[m][k] = *(const PG8_LAS bf16x8*)(lds + PG8_SA(b, h) + aoff + m * 2048 + k * 1024); } while (0)
#define PG8_LDB(dst, b, h) do { _Pragma("unroll") for (int n = 0; n < 2; ++n) _Pragma("unroll") for (int k = 0; k < 2; ++k) dst[n][k] = *(const PG8_LAS bf16x8*)(lds + PG8_SB(b, h) + boff + n * 2048 + k * 1024); } while (0)
#define PG8_MMA(ai, bj, At, Bt) do { __builtin_amdgcn_s_setprio(1); _Pragma("unroll") for (int m = 0; m < 4; ++m) _Pragma("unroll") for (int n = 0; n < 2; ++n) _Pragma("unroll") for (int k = 0; k < 2; ++k) \
        acc[ai][bj][m][n] = __builtin_amdgcn_mfma_f32_16x16x32_bf16(Bt[n][k], At[m][k], acc[ai][bj][m][n], 0, 0, 0); __builtin_amdgcn_s_setprio(0); } while (0)
#define PG8_WAIT_V(n) asm volatile("s_waitcnt vmcnt(" #n ")" ::: "memory")
#define PG8_WAIT_L(n) asm volatile("s_waitcnt lgkmcnt(" #n ")" ::: "memory")
#define PG8_BAR __builtin_amdgcn_s_barrier()
#define PG8_SCHED __builtin_amdgcn_sched_barrier(0)
    Unit cur, nxt; int ui = 0;
    if (!S.next(0, cur)) return;
    f32x4 acc[2][2][4][2];
#pragma unroll
    for (int a = 0; a < 2; ++a)
#pragma unroll
        for (int b = 0; b < 2; ++b)
#pragma unroll
            for (int m = 0; m < 4; ++m)
#pragma unroll
                for (int n = 0; n < 2; ++n) acc[a][b][m][n] = (f32x4){0.f, 0.f, 0.f, 0.f};
    bf16x8 At[4][2], B0[2][2], B1[2][2];
    const char* cA = (const char*)g.A + (size_t)cur.pm * tstep; const char* cB = (const char*)g.Bt + (size_t)cur.pn * tstep;
    S.a_ready(cur);
    if constexpr (SP2) {
        PG8_STAGE(PG8_SB(0, 0), cB, voffB); PG8_STAGE(PG8_SB(0, 1), cB + hstep, voffB); PG8_STAGE(PG8_SA(0, 0), cA, voffA); PG8_STAGE(PG8_SA(0, 1), cA + hstep, voffA);
        if (wr == 1) PG8_BAR;
        PG8_WAIT_V(2); PG8_BAR;
        PG8_STAGE(PG8_SB(1, 0), cB + kstep, voffB); PG8_STAGE(PG8_SA(1, 0), cA + kstep, voffA); PG8_STAGE(PG8_SB(1, 1), cB + hstep + kstep, voffB);
        PG8_WAIT_V(6); PG8_BAR;
    } else {
        PG8_STAGE(PG8_SB(0, 0), cB, voffB); PG8_STAGE(PG8_SA(0, 0), cA, voffA); PG8_STAGE(PG8_SB(0, 1), cB + hstep, voffB); PG8_STAGE(PG8_SA(0, 1), cA + hstep, voffA);
        if (wr == 1) PG8_BAR;
        PG8_WAIT_V(4); PG8_BAR;
        PG8_STAGE(PG8_SB(1, 0), cB + kstep, voffB); PG8_STAGE(PG8_SA(1, 0), cA + kstep, voffA); PG8_STAGE(PG8_SB(1, 1), cB + hstep + kstep, voffB);
        PG8_WAIT_V(6); PG8_BAR;
    }
    for (;;) {
        const bool has_next = S.next(ui + 1, nxt);
        const char* nA = has_next ? (const char*)g.A + (size_t)nxt.pm * tstep : cA; const char* nB = has_next ? (const char*)g.Bt + (size_t)nxt.pn * tstep : cB;
        for (int t = 0; t < nt; t += 2) {
            const bool last = (t == nt - 2);
            const char* a1 = cA + (size_t)(t + 1) * kstep;
            const char* a2 = last ? nA : cA + (size_t)(t + 2) * kstep; const char* b2 = last ? nB : cB + (size_t)(t + 2) * kstep;
            const char* a3 = a2 + kstep; const char* b3 = b2 + kstep;
            if (last && has_next) S.a_ready(nxt);
            if constexpr (SP2) {
            PG8_LDB(B0, 0, 0); PG8_LDB(B1, 0, 1); PG8_SCHED; PG8_LDA(At, 0, 0); PG8_STAGE(PG8_SA(1, 1), a1 + hstep, voffA);
            PG8_WAIT_V(8); PG8_WAIT_L(0); PG8_BAR; PG8_MMA(0, 0, At, B0); PG8_MMA(0, 1, At, B1); PG8_BAR; PG8_SCHED;
            PG8_LDA(At, 0, 1); PG8_STAGE(PG8_SB(0, 0), b2, voffB); PG8_STAGE(PG8_SB(0, 1), b2 + hstep, voffB); PG8_STAGE(PG8_SA(0, 0), a2, voffA);
            PG8_WAIT_V(8); PG8_WAIT_L(0); PG8_BAR; PG8_MMA(1, 0, At, B0); PG8_MMA(1, 1, At, B1); PG8_BAR; PG8_SCHED;
            PG8_LDB(B0, 1, 0); PG8_LDB(B1, 1, 1); PG8_SCHED; PG8_LDA(At, 1, 0); PG8_STAGE(PG8_SA(0, 1), a2 + hstep, voffA);
            PG8_WAIT_V(8); PG8_WAIT_L(0); PG8_BAR; PG8_MMA(0, 0, At, B0); PG8_MMA(0, 1, At, B1); PG8_BAR; PG8_SCHED;
            PG8_LDA(At, 1, 1); PG8_STAGE(PG8_SB(1, 0), b3, voffB); PG8_STAGE(PG8_SB(1, 1), b3 + hstep, voffB); PG8_STAGE(PG8_SA(1, 0), a3, voffA);
            PG8_WAIT_V(8); PG8_WAIT_L(0); PG8_BAR; PG8_MMA(1, 0, At, B0); PG8_MMA(1, 1, At, B1); PG8_BAR; PG8_SCHED;
            } else {
            PG8_LDB(B0, 0, 0); PG8_SCHED; PG8_LDA(At, 0, 0); PG8_STAGE(PG8_SA(1, 1), a1 + hstep, voffA);
            PG8_WAIT_L(8); PG8_BAR; PG8_WAIT_L(0); PG8_MMA(0, 0, At, B0); PG8_BAR; PG8_SCHED;
            PG8_LDB(B1, 0, 1); PG8_STAGE(PG8_SB(0, 0), b2, voffB);
            PG8_BAR; PG8_WAIT_L(0); PG8_MMA(0, 1, At, B1); PG8_BAR;
            PG8_LDA(At, 0, 1); PG8_STAGE(PG8_SA(0, 0), a2, voffA);
            PG8_BAR; PG8_WAIT_L(0); PG8_MMA(1, 0, At, B0); PG8_BAR; PG8_SCHED;
            PG8_STAGE(PG8_SB(0, 1), b2 + hstep, voffB);
            PG8_WAIT_V(6); PG8_BAR; PG8_MMA(1, 1, At, B1); PG8_BAR;
            PG8_LDB(B0, 1, 0); PG8_SCHED; PG8_LDA(At, 1, 0); PG8_STAGE(PG8_SA(0, 1), a2 + hstep, voffA);
            PG8_WAIT_L(8); PG8_BAR; PG8_WAIT_L(0); PG8_MMA(0, 0, At, B0); PG8_BAR; PG8_SCHED;
            PG8_LDB(B1, 1, 1); PG8_STAGE(PG8_SB(1, 0), b3, voffB);
            PG8_BAR; PG8_WAIT_L(0); PG8_MMA(0, 1, At, B1); PG8_BAR;
            PG8_LDA(At, 1, 1); PG8_STAGE(PG8_SA(1, 0), a3, voffA);
            PG8_BAR; PG8_WAIT_L(0); PG8_MMA(1, 0, At, B0); PG8_BAR; PG8_SCHED;
            PG8_STAGE(PG8_SB(1, 1), b3 + hstep, voffB);
            PG8_WAIT_V(6); PG8_BAR; PG8_MMA(1, 1, At, B1); PG8_BAR;
            }
        }
        if constexpr (ALIGN_EPI) { if (wr == 0) PG8_BAR; }
        if constexpr (!Epi::AFTER_DRAIN) { E(acc, cur, wr, wc, fr, fq); S.done(cur); }
        if (!has_next) break;
#pragma unroll
        for (int a = 0; a < 2; ++a)
#pragma unroll
            for (int b = 0; b < 2; ++b)
#pragma unroll
                for (int m = 0; m < 4; ++m)
#pragma unroll
                    for (int n = 0; n < 2; ++n) acc[a][b][m][n] = (f32x4){0.f, 0.f, 0.f, 0.f};
        cur = nxt; cA = nA; cB = nB; ++ui;
        if constexpr (ALIGN_EPI) { if (wr == 1) PG8_BAR; }
    }
    PG8_WAIT_V(0);
    if constexpr (!ALIGN_EPI) { if (wr == 0) PG8_BAR; }
    PG8_BAR;
    if constexpr (Epi::AFTER_DRAIN) { E.fused(acc, cur, wr, wc, fr, fq, lds, wid, lane); S.done(cur); }
#undef PG8_SA
#undef PG8_SB
#undef PG8_STAGE
#undef PG8_LDA
#undef PG8_LDB
#undef PG8_MMA
#undef PG8_WAIT_V
#undef PG8_WAIT_L
#undef PG8_BAR
#undef PG8_SCHED
}
}
#define LAS __attribute__((address_space(3)))
#define XB_TMO      128
#define XB_XCNT(j)  (256  + 64 * (j))
#define XB_XSUB(j)  (1280 + 64 * (j))
#define XB_XGEN(j)  (2304 + 64 * (j))
#define XB_TOP      3328
#define XB_TOPGEN   3392
#define XCD_BAR_WORDS 3456
#define XB_SPIN_CAP (1u << 18)

__device__ __forceinline__ unsigned xb_ld(unsigned* p)              { return __hip_atomic_load(p, __ATOMIC_RELAXED, __HIP_MEMORY_SCOPE_AGENT); }
__device__ __forceinline__ unsigned xb_add(unsigned* p, unsigned v) { return __hip_atomic_fetch_add(p, v, __ATOMIC_RELAXED, __HIP_MEMORY_SCOPE_AGENT); }
__device__ __forceinline__ unsigned xb_xcc_id() { return (unsigned)__builtin_amdgcn_s_getreg((3 << 11) | 20) & 0xFu; }
#define XB_SPIN(cond, bar) do { unsigned _sp = 0; while (cond) { __builtin_amdgcn_s_sleep(1); \
    if ((++_sp & 255u) == 0u) { if (xb_ld(&(bar)[XB_TMO])) break; if (_sp > XB_SPIN_CAP) { atomicAdd(&(bar)[XB_TMO], 1u); break; } } } } while (0)

struct XcdBarrier {
    unsigned* bar; unsigned x;
    volatile LAS unsigned* st;
};

__device__ __forceinline__ XcdBarrier xcd_barrier_post(unsigned* bar, volatile LAS unsigned* st) {
    XcdBarrier b; b.bar = bar; b.x = xb_xcc_id(); b.st = st;
    if (threadIdx.x == 0) (void)xb_add(&bar[XB_XCNT(b.x)], 1u);
    return b;
}
__device__ __forceinline__ void xcd_barrier_complete(unsigned* bar, unsigned x, unsigned& nloc, unsigned& nx) {
    const unsigned G = gridDim.x * gridDim.y * gridDim.z;
    unsigned sum, cnt, mine, sp = 0u;
    for (;;) {
        sum = 0u; cnt = 0u; mine = 0u;
#pragma unroll
        for (unsigned j = 0; j < 16; ++j) { const unsigned c = xb_ld(&bar[XB_XCNT(j)]); sum += c; cnt += (c > 0u) ? 1u : 0u; mine = (j == x) ? c : mine; }
        if (sum == G) break;
        __builtin_amdgcn_s_sleep(1);
        if ((++sp & 255u) == 0u) { if (xb_ld(&bar[XB_TMO])) break; if (sp > XB_SPIN_CAP) { atomicAdd(&bar[XB_TMO], 1u); break; } }
    }
    nloc = mine > 0u ? mine : 1u; nx = cnt > 0u ? cnt : 1u;
}

__device__ __forceinline__ void xcd_barrier(const XcdBarrier& b) {
    asm volatile("s_waitcnt vmcnt(0)" ::: "memory");
    __syncthreads();
    if (threadIdx.x == 0) {
        unsigned* bar = b.bar;
        __builtin_amdgcn_s_waitcnt(0);
        unsigned nloc = b.st[0], nx = b.st[1];
        if (nloc == 0u) { xcd_barrier_complete(bar, b.x, nloc, nx); b.st[0] = nloc; b.st[1] = nx; }
        const unsigned old = xb_add(&bar[XB_XSUB(b.x)], 1u);
        const unsigned gen = old / nloc;
        if (old + 1u == (gen + 1u) * nloc) {
            __builtin_amdgcn_fence(__ATOMIC_RELEASE, "agent");
            asm volatile("s_waitcnt vmcnt(0)" ::: "memory");
            const unsigned og = xb_add(&bar[XB_TOP], 1u);
            const unsigned tg = og / nx;
            if (og + 1u == (tg + 1u) * nx) xb_add(&bar[XB_TOPGEN], 1u);
            else XB_SPIN(xb_ld(&bar[XB_TOPGEN]) == tg, bar);
            __builtin_amdgcn_fence(__ATOMIC_ACQUIRE, "agent");
            xb_add(&bar[XB_XGEN(b.x)], 1u);
            asm volatile("s_waitcnt vmcnt(0)" ::: "memory");
        } else {
            XB_SPIN(xb_ld(&bar[XB_XGEN(b.x)]) == gen, bar);
            __builtin_amdgcn_fence(__ATOMIC_ACQUIRE, "agent");
            asm volatile("s_waitcnt vmcnt(0)" ::: "memory");
        }
    }
    __syncthreads();
}

#define GAS __attribute__((address_space(1)))
typedef unsigned short bf16;
typedef float f32x4 __attribute__((ext_vector_type(4)));
typedef float f32x16 __attribute__((ext_vector_type(16)));
typedef short bf16x8 __attribute__((ext_vector_type(8)));
typedef short s16x4 __attribute__((ext_vector_type(4)));
typedef short v4i16_t __attribute__((ext_vector_type(4)));
typedef unsigned u32x4 __attribute__((ext_vector_type(4)));
typedef unsigned u32x2 __attribute__((ext_vector_type(2)));
using pg8::pkbf;

constexpr int DM = 1024, SEQ = 16384, CTXL = 256, MT = SEQ + CTXL, DEPTH = 4, NEXP = 32, DEXP = 512;
constexpr int XG_ROWS = 41472;
constexpr size_t SLOT = (size_t)MT * 64;
constexpr float LOG2E = 1.4426950408889634f, RMS_EPS = 1e-6f;
constexpr int NWAVES = 8, NTHREADS = 512;

constexpr size_t MiB = 1u << 20;
constexpr size_t WS_CTL = 0, CTL_ZERO_BYTES = 1 * MiB;
constexpr size_t WS_MOD = 1 * MiB;
constexpr size_t WS_ROPE = 1 * MiB + 512 * 1024;
constexpr size_t WS_BT_INAB = 2 * MiB, WS_BT_OUTAB = 8 * MiB, WS_BT_INC = 12 * MiB, WS_BT_OUTC = 24 * MiB;
constexpr size_t WS_BT_W13 = 32 * MiB, WS_BT_W2 = 288 * MiB;
constexpr size_t WS_XCUR = 416 * MiB, WS_HB = 481 * MiB, WS_QKV = 514 * MiB, WS_OB = 612 * MiB, WS_O1S = 645 * MiB;
constexpr size_t WS_XG = 710 * MiB, WS_HG = 791 * MiB, WS_YG = 832 * MiB, WS_ROUTE = 913 * MiB, WS_END = 915 * MiB;
constexpr size_t RT_TOKE = 0, RT_TOKP = 256 * 1024, RT_TOKW = 512 * 1024, RT_DROW = 768 * 1024, RT_RW = 1024 * 1024, RT_TILE = 1280 * 1024, RT_NT = 1280 * 1024 + 4096;
static_assert(WS_BT_W13 + (size_t)DEPTH * NEXP * 1024 * 1024 * 2 <= WS_BT_W2 && WS_BT_W2 + (size_t)DEPTH * NEXP * 1024 * 512 * 2 <= WS_XCUR, "ws map");
static_assert(WS_XCUR + (size_t)MT * DM * 4 <= WS_HB && WS_HB + (size_t)MT * DM * 2 <= WS_QKV && WS_QKV + 48 * SLOT * 2 <= WS_OB && WS_OB + (size_t)MT * DM * 2 <= WS_O1S, "ws map");
static_assert(WS_O1S + (size_t)520 * 131072 <= WS_XG && WS_XG + (size_t)XG_ROWS * DM * 2 <= WS_HG && WS_HG + (size_t)XG_ROWS * DEXP * 2 <= WS_YG && WS_YG + (size_t)XG_ROWS * DM * 2 <= WS_ROUTE, "ws map");
constexpr int CW_BAR = 4096, CW_CNT = 16384, CW_DIAG = 32768;

constexpr int LDS_STAGE = 73728, LDS_WSF = 139264, LDSCTL_OFF = 140288, MISC_OFF = LDSCTL_OFF + 320, TAB_OFF = LDSCTL_OFF + 1024, LDS_BYTES = 147456;
static_assert(TAB_OFF + 1024 + 64 <= LDS_BYTES, "LDS map");

constexpr int NPH = 2 + 8 * DEPTH;

#define LDS_WAIT() asm volatile("s_waitcnt lgkmcnt(0)" ::: "memory")
__device__ __forceinline__ float wave_sum(float v) {
#pragma unroll
    for (int o = 1; o < 64; o <<= 1) v += __shfl_xor(v, o);
    return v;
}
__device__ __forceinline__ float bf2f(unsigned short u) { return __builtin_bit_cast(float, (unsigned)u << 16); }
__device__ __forceinline__ float bflo(unsigned u) { return __builtin_bit_cast(float, u << 16); }
__device__ __forceinline__ float bfhi(unsigned u) { return __builtin_bit_cast(float, u & 0xffff0000u); }

__device__ __forceinline__ void transpose_item(const float* W, int ldw, int srccol0, bf16* WT, int K, int dstrow0, int k0, LAS float* scr, int lane) {
#pragma unroll 8
    for (int i = 0; i < 32; ++i) { const int kk = 2 * i + (lane >> 5); scr[kk * 33 + (lane & 31)] = W[(size_t)(k0 + kk) * ldw + srccol0 + (lane & 31)]; }
    LDS_WAIT(); asm volatile("" ::: "memory");
    const int c = lane & 7;
#pragma unroll
    for (int j = 0; j < 4; ++j) { const int n = (lane >> 3) + 8 * j; const LAS float* s = scr + (8 * c) * 33 + n;
        u32x4 o; o.x = pkbf(s[0 * 33], s[1 * 33]); o.y = pkbf(s[2 * 33], s[3 * 33]); o.z = pkbf(s[4 * 33], s[5 * 33]); o.w = pkbf(s[6 * 33], s[7 * 33]);
        *(GAS u32x4*)(WT + (size_t)(dstrow0 + n) * K + k0 + 8 * c) = o; }
    LDS_WAIT(); asm volatile("" ::: "memory");
}

namespace att {
typedef __attribute__((address_space(3))) const char* lds_cptr;
__device__ __forceinline__ int crow(int r, int hi) { return (r & 3) + 8 * (r >> 2) + 4 * hi; }
__device__ __forceinline__ void glds16(const void* gsrc, unsigned lds_dst) { unsigned keep;
    asm volatile("s_mov_b32 %0, m0\n\ts_mov_b32 m0, %2\n\ts_nop 0\n\tglobal_load_lds_dwordx4 %1, off\n\ts_mov_b32 m0, %0" : "=&s"(keep) : "v"(gsrc), "s"(lds_dst) : "memory"); }
__device__ __forceinline__ s16x4 vtr(lds_cptr p) { return __builtin_bit_cast(s16x4, __builtin_amdgcn_ds_read_tr16_b64_v4i16((LAS v4i16_t*)p)); }
#define ATT_WAITBAR(N) asm volatile("s_waitcnt vmcnt(" #N ") lgkmcnt(0)\n\ts_barrier" ::: "memory")

template <int DV>
__device__ __forceinline__ void attn_pass(f32x16 (&o)[DV / 32], float& lsum, const bf16* Qw, const bf16* Kb, const bf16* Vb, int vpitch,
                                          int t0, int n1, int masked, int qpos, LAS unsigned char* lds, int wid, int lane) {
    constexpr int NV = DV / 64, KSLOT = 8192, VSLOT = DV * 128, LV = 3 * KSLOT;
    const int r32 = lane & 31, hi = lane >> 5, n = n1 + 4;
    const unsigned lds0 = (unsigned)(unsigned long)lds;
    bf16x8 qr[4];
#pragma unroll
    for (int d0 = 0; d0 < 4; ++d0) qr[d0] = *(const bf16x8*)(Qw + (size_t)r32 * 64 + d0 * 16 + hi * 8);
    const bf16* ksrc = Kb + (size_t)lane * 64 + wid * 8;
    const bf16* vsrc[NV];
#pragma unroll
    for (int j = 0; j < NV; ++j) { const int pi = wid + 8 * j, db = pi >> 2, kg = pi & 3; vsrc[j] = Vb + (size_t)(16 * kg + (lane >> 2)) * vpitch + db * 32 + (lane & 3) * 8; }
#define ATT_TILE(i_) ((i_) < n1 ? t0 + (i_) : 256 + (i_) - n1)
#define ATT_DMA(tl_, sl_) do { const int tl__ = (tl_); const int sl__ = (sl_); \
        glds16(ksrc + (size_t)tl__ * 4096, (unsigned)__builtin_amdgcn_readfirstlane(lds0 + sl__ * KSLOT + wid * 1024)); \
        _Pragma("unroll") for (int j_ = 0; j_ < NV; ++j_) glds16(vsrc[j_] + (size_t)tl__ * 64 * vpitch, (unsigned)__builtin_amdgcn_readfirstlane(lds0 + LV + sl__ * VSLOT + (wid + 8 * j_) * 1024)); } while (0)
    ATT_DMA(ATT_TILE(0), 0);
    if (n > 1) ATT_DMA(ATT_TILE(1), 1);
    int sl = 0, sl2 = 2;
    for (int i = 0; i < n; ++i) {
        if (i + 1 < n) { if (NV == 1) ATT_WAITBAR(2); else ATT_WAITBAR(3); } else ATT_WAITBAR(0);
        if (i + 2 < n) ATT_DMA(ATT_TILE(i + 2), sl2);
        const int tl = ATT_TILE(i);
        const lds_cptr kp = (lds_cptr)lds + sl * KSLOT + hi * 1024 + r32 * 16;
        bf16x8 kf[8];
#pragma unroll
        for (int d0 = 0; d0 < 4; ++d0) { kf[2 * d0] = *(const LAS bf16x8*)(kp + d0 * 2048); kf[2 * d0 + 1] = *(const LAS bf16x8*)(kp + d0 * 2048 + 512); }
        f32x16 p0 = {}, p1 = {};
#pragma unroll
        for (int d0 = 0; d0 < 4; ++d0) { p0 = __builtin_amdgcn_mfma_f32_32x32x16_bf16(kf[2 * d0], qr[d0], p0, 0, 0, 0); p1 = __builtin_amdgcn_mfma_f32_32x32x16_bf16(kf[2 * d0 + 1], qr[d0], p1, 0, 0, 0); }
#pragma unroll
        for (int r = 0; r < 16; ++r) { p0[r] = __builtin_amdgcn_exp2f(p0[r]); p1[r] = __builtin_amdgcn_exp2f(p1[r]); }
        if (masked && tl < 256) {
            const int kb = 64 * tl + 4 * hi - (qpos + r32) + 128;
#pragma unroll
            for (int r = 0; r < 16; ++r) { const int kv = kb + (r & 3) + 8 * (r >> 2); if ((unsigned)kv > 256u) p0[r] = 0.f; if ((unsigned)(kv + 32) > 256u) p1[r] = 0.f; }
        }
        float s0 = 0.f, s1 = 0.f;
#pragma unroll
        for (int r = 0; r < 16; ++r) { s0 += p0[r]; s1 += p1[r]; }
        lsum += s0 + s1;
        u32x4 pw[4];
#pragma unroll
        for (int k = 0; k < 2; ++k) {
            pw[k]     = (u32x4){pkbf(p0[8 * k], p0[8 * k + 1]), pkbf(p0[8 * k + 2], p0[8 * k + 3]), pkbf(p0[8 * k + 4], p0[8 * k + 5]), pkbf(p0[8 * k + 6], p0[8 * k + 7])};
            pw[2 + k] = (u32x4){pkbf(p1[8 * k], p1[8 * k + 1]), pkbf(p1[8 * k + 2], p1[8 * k + 3]), pkbf(p1[8 * k + 4], p1[8 * k + 5]), pkbf(p1[8 * k + 6], p1[8 * k + 7])};
        }
        const lds_cptr vp = (lds_cptr)lds + LV + sl * VSLOT + ((lane >> 4) & 1) * 32 + (lane & 3) * 8 + (4 * hi + ((lane & 15) >> 2)) * 64;
#pragma unroll
        for (int d0 = 0; d0 < DV / 32; ++d0) {
#pragma unroll
            for (int ks = 0; ks < 4; ++ks) {
                const s16x4 lo = vtr(vp + d0 * 4096 + ks * 1024), hh = vtr(vp + d0 * 4096 + ks * 1024 + 512);
                const bf16x8 vf = (bf16x8){lo[0], lo[1], lo[2], lo[3], hh[0], hh[1], hh[2], hh[3]};
                o[d0] = __builtin_amdgcn_mfma_f32_32x32x16_bf16(__builtin_bit_cast(bf16x8, pw[ks]), vf, o[d0], 0, 0, 0);
            }
            if (DV > 64) __builtin_amdgcn_sched_barrier(0);
        }
        sl = (sl == 2) ? 0 : sl + 1; sl2 = (sl2 == 2) ? 0 : sl2 + 1;
    }
    asm volatile("s_waitcnt lgkmcnt(0)\n\ts_barrier" ::: "memory");
#undef ATT_TILE
#undef ATT_DMA
}
__device__ __forceinline__ void row_inv(float (&rli)[16], float lsum, float extra, LAS float* wsf, int r32, int hi) {
    const float l = pg8::swap_sum32(lsum) + extra;
    LDS_WAIT();
    if (hi == 0) wsf[r32] = l;
    LDS_WAIT(); asm volatile("" ::: "memory");
#pragma unroll
    for (int r = 0; r < 16; ++r) rli[r] = __builtin_amdgcn_rcpf(wsf[crow(r, hi)]);
    LDS_WAIT(); asm volatile("" ::: "memory");
}
}

#ifndef DBG_NO_MOE
#define DBG_NO_MOE 0
#endif
#ifndef DBG_NO_MIX
#define DBG_NO_MIX 0
#endif
#ifndef DBG_AB
#define DBG_AB 0
#endif
#ifndef PH_MASK
#define PH_MASK 0x3ff
#endif
#define PH_ON(i) ((PH_MASK >> (i)) & 1)
#ifndef ATT_VARIANT
#define ATT_VARIANT 0
#endif
struct Args { const float* in[28]; float* out; unsigned char* ws; int ph_lo, ph_hi; };
enum { I_X = 0, I_C, I_CTX, I_CCTX, I_WMOD, I_BMOD, I_NMIX, I_NFFN, I_WINAB, I_WOUTAB, I_QNA, I_KNA, I_SINKA, I_QNB, I_KNB, I_WINC, I_WOUTC, I_QNC, I_KNC, I_LAMC, I_SUBLN,
       I_WGRP, I_BGRP, I_WEXP, I_BEXP, I_W1, I_W3, I_W2 };

__global__ void __launch_bounds__(NTHREADS, 2) mega(Args args) {
    extern __shared__ __attribute__((aligned(16))) unsigned char lds_[];
    LAS unsigned char* lds = (LAS unsigned char*)lds_;
    volatile LAS unsigned* MISC = (volatile LAS unsigned*)(lds + MISC_OFF);
    const int tid0 = threadIdx.x;
    const int G = gridDim.x, bx = blockIdx.x;
    const int vcu = (G % 8 == 0) ? (bx % 8) * (G / 8) + bx / 8 : bx;
    const int NGW = G * NWAVES;
#define PHASE_IDS() int tid = tid0; asm volatile("" : "+v"(tid)); const int lane = tid & 63, wave = __builtin_amdgcn_readfirstlane(tid >> 6), gw = vcu * NWAVES + wave; (void)lane; (void)wave; (void)gw
    unsigned char* ws = args.ws;
    unsigned* ctl = (unsigned*)(ws + WS_CTL);
    float* mod = (float*)(ws + WS_MOD); float* modc = mod + DEPTH * 6144;
    float* rope = (float*)(ws + WS_ROPE);
    float* xcur = (float*)(ws + WS_XCUR);
    bf16* HB = (bf16*)(ws + WS_HB); bf16* QKV = (bf16*)(ws + WS_QKV); bf16* OB = (bf16*)(ws + WS_OB); float* O1S = (float*)(ws + WS_O1S);
    bf16* XG = (bf16*)(ws + WS_XG); bf16* HG = (bf16*)(ws + WS_HG); bf16* YG = (bf16*)(ws + WS_YG);
    int* tok_e = (int*)(ws + WS_ROUTE + RT_TOKE); int* tok_p = (int*)(ws + WS_ROUTE + RT_TOKP); float* tok_w = (float*)(ws + WS_ROUTE + RT_TOKW);
    int* drow = (int*)(ws + WS_ROUTE + RT_DROW); float* rw = (float*)(ws + WS_ROUTE + RT_RW); int* tile_e = (int*)(ws + WS_ROUTE + RT_TILE); int* ntl = (int*)(ws + WS_ROUTE + RT_NT);

    for (int u = tid0; u < (LDS_BYTES - LDSCTL_OFF) / 4; u += NTHREADS) ((LAS unsigned*)(lds + LDSCTL_OFF))[u] = 0u;
    __syncthreads();
    const int ph_lo = args.ph_lo, ph_hi = args.ph_hi;
    XcdBarrier bar; bar.bar = ctl + CW_BAR; bar.x = 0; bar.st = nullptr;
    if (ph_hi - ph_lo > 1) bar = xcd_barrier_post(ctl + CW_BAR, MISC + 8);
#define IN(k) (ph_lo <= (k) && (k) < ph_hi)
#define SEAM(k) do { if (IN(k) && IN((k) + 1)) xcd_barrier(bar); } while (0)

    if (IN(0)) { if (!PH_ON(0)) __builtin_trap(); asm volatile("; MARK_PHASE p0" ::: "memory"); PHASE_IDS();
        {
            LAS float* sc = (LAS float*)lds; LAS float* scc = sc + 1024; LAS float* red = scc + 1024;
            for (int k = tid; k < 1024; k += NTHREADS) { const float a = args.in[I_C][k], b = args.in[I_CCTX][k];
                sc[k] = a / (1.f + __expf(-a)); scc[k] = b / (1.f + __expf(-b)); }
            __syncthreads();
            for (int it = bx; it < DEPTH * 96; it += G) {
                const int l = it / 96, col = (it % 96) * 64 + lane;
                const float* w = args.in[I_WMOD] + (size_t)l * 1024 * 6144 + col;
                float a0 = 0.f, a1 = 0.f;
#pragma unroll 8
                for (int kk = 0; kk < 128; ++kk) { const int k = wave * 128 + kk; const float wv = w[(size_t)k * 6144]; a0 += sc[k] * wv; a1 += scc[k] * wv; }
                red[wave * 64 + lane] = a0; red[512 + wave * 64 + lane] = a1;
                __syncthreads();
                if (wave < 2) { float s = 0.f;
#pragma unroll
                    for (int w8 = 0; w8 < 8; ++w8) s += red[wave * 512 + w8 * 64 + lane];
                    s += args.in[I_BMOD][l * 6144 + col];
                    (wave == 0 ? mod : modc)[l * 6144 + col] = s; }
                __syncthreads();
            }
        }
        for (int idx = bx * NTHREADS + tid; idx < 320 * 16; idx += G * NTHREADS) {
            const int t = idx >> 4, j = idx & 15; const float pos = (float)(t < 256 ? t : t - 256);
            const float inv = exp2f(-(float)j * (13.287712379549449f / 16.f));
            const float ang = pos * inv, rev = ang * 0.15915494309189535f, fr = rev - rintf(rev);
            const float cs = __builtin_amdgcn_cosf(fr), sn = __builtin_amdgcn_sinf(fr);
            if (t < 256) { rope[t * 16 + j] = cs; rope[4096 + t * 16 + j] = sn; } else { rope[8192 + (t - 256) * 16 + j] = cs; rope[9216 + (t - 256) * 16 + j] = sn; }
        }
        {
            LAS float* scr = (LAS float*)(lds + wave * 16384);
            constexpr int N_INAB = 2 * 16 * 48, N_INC = 2 * 16 * 96, N_OUT = 2 * 16 * 32, N_W13 = DEPTH * NEXP * 16 * 32, N_W2 = DEPTH * NEXP * 8 * 32;
            constexpr int NITEMS = N_INAB + N_INC + 2 * N_OUT + N_W13 + N_W2;
            for (int it = gw; it < NITEMS; it += NGW) {
                int r = it;
                if (r < N_INAB) { const int i = r / (16 * 48), q = r % (16 * 48), kb = q / 48, nb = q % 48, pin = (nb * 32) & 255, pn = (nb * 32) >> 8, bj = pin >> 7, wc = (pin & 127) >> 5;
                    transpose_item(args.in[I_WINAB] + (size_t)i * 1024 * 1536, 1536, (4 * pn + wc) * 64 + bj * 32, (bf16*)(ws + WS_BT_INAB) + (size_t)i * 1536 * 1024, 1024, nb * 32, kb * 64, scr, lane); continue; }
                r -= N_INAB;
                if (r < N_INC) { const int i = r / (16 * 96), q = r % (16 * 96), kb = q / 96, nb = q % 96, pin = (nb * 32) & 255, pn = (nb * 32) >> 8, bj = pin >> 7, wc = (pin & 127) >> 5;
                    transpose_item(args.in[I_WINC] + (size_t)i * 1024 * 3072, 3072, (4 * pn + wc) * 64 + bj * 32, (bf16*)(ws + WS_BT_INC) + (size_t)i * 3072 * 1024, 1024, nb * 32, kb * 64, scr, lane); continue; }
                r -= N_INC;
                if (r < N_OUT) { const int i = r / (16 * 32), q = r % (16 * 32), kb = q / 32, nb = q % 32;
                    transpose_item(args.in[I_WOUTAB] + (size_t)i * 1024 * 1024, 1024, nb * 32, (bf16*)(ws + WS_BT_OUTAB) + (size_t)i * 1024 * 1024, 1024, nb * 32, kb * 64, scr, lane); continue; }
                r -= N_OUT;
                if (r < N_OUT) { const int i = r / (16 * 32), q = r % (16 * 32), kb = q / 32, nb = q % 32;
                    transpose_item(args.in[I_WOUTC] + (size_t)i * 1024 * 1024, 1024, nb * 32, (bf16*)(ws + WS_BT_OUTC) + (size_t)i * 1024 * 1024, 1024, nb * 32, kb * 64, scr, lane); continue; }
                r -= N_OUT;
                if (r < N_W13) { const int le = r / (16 * 32), q = r % (16 * 32), kb = q / 32, nb = q % 32, pin = (nb * 32) & 255, pn = (nb * 32) >> 8, bj = pin >> 7, wc = (pin & 127) >> 5;
                    transpose_item(args.in[bj ? I_W3 : I_W1] + (size_t)le * 1024 * 512, 512, pn * 128 + wc * 32, (bf16*)(ws + WS_BT_W13) + (size_t)le * 1024 * 1024, 1024, nb * 32, kb * 64, scr, lane); continue; }
                r -= N_W13;
                { const int le = r / (8 * 32), q = r % (8 * 32), kb = q / 32, nb = q % 32;
                    transpose_item(args.in[I_W2] + (size_t)le * 512 * 1024, 1024, nb * 32, (bf16*)(ws + WS_BT_W2) + (size_t)le * 1024 * 512, 512, nb * 32, kb * 64, scr, lane); }
            }
        }
        __syncthreads();
    }
    SEAM(0);

    for (int l = 0; l < DEPTH; ++l) {
        const int pb = 1 + 8 * l, li = l >> 1;
        const bool isC = (l & 1) != 0, last = (l == DEPTH - 1);
        const float* modl = mod + l * 6144; const float* modcl = modc + l * 6144;
        const int mrows = last ? SEQ : MT;

        if (IN(pb + 0)) { if (!PH_ON(1)) __builtin_trap(); asm volatile("; MARK_PHASE pb+0" ::: "memory"); PHASE_IDS();
            const float* gmix = args.in[I_NMIX] + l * 1024;
            for (int m = gw; m < MT; m += NGW) {
                const bool isctx = m >= SEQ;
                const float* src = (l == 0) ? (isctx ? args.in[I_CTX] + (size_t)(m - SEQ) * 1024 : args.in[I_X] + (size_t)m * 1024) : xcur + (size_t)m * 1024;
                f32x4 v[4];
#pragma unroll
                for (int j = 0; j < 4; ++j) v[j] = *(const f32x4*)(src + 4 * lane + 256 * j);
                if (l > 0 && !((DBG_NO_MOE >> (l - 1)) & 1)) {
                    const int d0 = drow[2 * m], d1 = drow[2 * m + 1];
                    const float* gate = (isctx ? modc : mod) + (l - 1) * 6144 + 5 * 1024;
#pragma unroll
                    for (int j = 0; j < 4; ++j) { const u32x2 y0 = *(const u32x2*)(YG + (size_t)d0 * 1024 + 4 * lane + 256 * j), y1 = *(const u32x2*)(YG + (size_t)d1 * 1024 + 4 * lane + 256 * j);
                        const f32x4 gt = *(const f32x4*)(gate + 4 * lane + 256 * j);
                        v[j] = v[j] + gt * (f32x4){bflo(y0.x) + bflo(y1.x), bfhi(y0.x) + bfhi(y1.x), bflo(y0.y) + bflo(y1.y), bfhi(y0.y) + bfhi(y1.y)}; }
                }
#pragma unroll
                for (int j = 0; j < 4; ++j) *(f32x4*)(xcur + (size_t)m * 1024 + 4 * lane + 256 * j) = v[j];
                float ss = 0.f;
#pragma unroll
                for (int j = 0; j < 4; ++j) ss += (v[j][0] * v[j][0] + v[j][1] * v[j][1]) + (v[j][2] * v[j][2] + v[j][3] * v[j][3]);
                const float rstd = __builtin_amdgcn_rsqf(wave_sum(ss) * (1.f / 1024.f) + RMS_EPS);
                const float* mm = isctx ? modcl : modl;
#pragma unroll
                for (int j = 0; j < 4; ++j) { const int c0 = 4 * lane + 256 * j; const f32x4 gn = *(const f32x4*)(gmix + c0), sh = *(const f32x4*)(mm + c0), scl = *(const f32x4*)(mm + 1024 + c0);
                    const f32x4 h = v[j] * rstd * gn * (scl + 1.f) + sh;
                    *(u32x2*)(HB + (size_t)m * 1024 + c0) = (u32x2){pkbf(h[0], h[1]), pkbf(h[2], h[3])}; }
            }
        }
        SEAM(pb + 0);

        if (IN(pb + 1)) { if (!PH_ON(2)) __builtin_trap(); asm volatile("; MARK_PHASE pb+1" ::: "memory"); PHASE_IDS();
            const int N = isC ? 3072 : 1536;
            pg8::Gemm g{HB, isC ? (const bf16*)(ws + WS_BT_INC) + (size_t)li * 3072 * 1024 : (const bf16*)(ws + WS_BT_INAB) + (size_t)li * 1536 * 1024, MT, N, 1024};
            pg8::StaticOrder S; S.init(MT, N, G, bx);
            pg8::EpiQKV E{QKV, isC ? args.in[I_QNC] + li * 64 : args.in[I_QNA] + li * 64, isC ? args.in[I_KNC] + li * 64 : args.in[I_KNA] + li * 64,
                          args.in[I_QNB] + li * 64, args.in[I_KNB] + li * 64, rope, isC ? 1 : 0};
            pg8::gemm_phase<pg8::EpiQKV, pg8::StaticOrder, true, true>(lds, g, S, E);
        }
        SEAM(pb + 1);

        if (IN(pb + 2)) { if (!PH_ON(3)) __builtin_trap(); asm volatile("; MARK_PHASE pb+2" ::: "memory"); PHASE_IDS();
            const int r32 = lane & 31, hi = lane >> 5;
            LAS float* wsf = (LAS float*)(lds + LDS_WSF) + wave * 32;
            if (!isC && ATT_VARIANT != 2) {
                LAS bf16* stg = (LAS bf16*)(lds + LDS_STAGE) + wave * 2048;
                for (int u = vcu; u < 1040; u += G) {
                    int head16, qt, t0, n1, masked, has_sink, kvslot, vslot, qslot;
                    if (u < 512) { const int h = u >> 6; qt = u & 63; head16 = 8 + h; t0 = 0; n1 = 256; masked = 0; has_sink = 0; qslot = 12 + h; kvslot = 20 + (h >> 2); vslot = 22 + (h >> 2); }
                    else if (u < 1024) { const int h = (u - 512) >> 6; qt = u & 63; head16 = h; t0 = (4 * qt - 2 > 0) ? 4 * qt - 2 : 0; const int t1 = (4 * qt + 6 < 256) ? 4 * qt + 6 : 256; n1 = t1 - t0;
                        masked = 1; has_sink = 1; qslot = h; kvslot = 8 + (h >> 2); vslot = 10 + (h >> 2); }
                    else { const int h16 = u - 1024; qt = 64; head16 = h16; t0 = 0; n1 = 0; masked = 0;
                        if (h16 < 8) { has_sink = 1; qslot = h16; kvslot = 8 + (h16 >> 2); vslot = 10 + (h16 >> 2); } else { const int h = h16 - 8; has_sink = 0; qslot = 12 + h; kvslot = 20 + (h >> 2); vslot = 22 + (h >> 2); } }
                    const int row0 = qt * 256 + wave * 32;
                    f32x16 o[2]; o[0] = f32x16{}; o[1] = f32x16{}; float lsum = 0.f;
                    att::attn_pass<64>(o, lsum, QKV + (size_t)qslot * SLOT + (size_t)row0 * 64, QKV + (size_t)kvslot * SLOT, QKV + (size_t)vslot * SLOT, 64, t0, n1, masked, row0, lds, wave, lane);
                    const float extra = has_sink ? __builtin_amdgcn_exp2f(args.in[I_SINKA][li * 8 + (head16 & 7)] * LOG2E) : 0.f;
                    int ln = lane; asm volatile("" : "+v"(ln));
                    const int r32e = ln & 31, hie = ln >> 5;
                    float rli[16]; att::row_inv(rli, lsum, extra, wsf, r32e, hie);
#pragma unroll
                    for (int r = 0; r < 16; ++r) { const int orow = att::crow(r, hie);
#pragma unroll
                        for (int d0 = 0; d0 < 2; ++d0) stg[orow * 64 + d0 * 32 + r32e] = ((DBG_AB == 1 && head16 < 8) || (DBG_AB == 2 && head16 >= 8) || (DBG_AB == 3 && u >= 1024)) ? (bf16)0 : (bf16)(pkbf(o[d0][r] * rli[r], 0.f) & 0xffffu); }
                    LDS_WAIT(); asm volatile("" ::: "memory");
                    bf16* Ow = OB + (size_t)row0 * 1024 + head16 * 64;
#pragma unroll
                    for (int i = 0; i < 4; ++i) { const int row = i * 8 + (ln >> 3), ch = ln & 7; const u32x4 vv = *(const LAS u32x4*)(stg + row * 64 + ch * 8); *(u32x4*)(Ow + (size_t)row * 1024 + ch * 8) = vv; }
                    LDS_WAIT(); asm volatile("" ::: "memory");
                }
            } else if (ATT_VARIANT != 1) {
                LAS bf16* stg = (LAS bf16*)(lds + LDS_STAGE) + wave * 4096;
                const float lam_init = 0.8f - 0.6f * __expf(-0.3f * (float)l);
                const float* lp = args.in[I_LAMC] + li * 256;
                const float lam = __expf(wave_sum(lp[lane] * lp[64 + lane])) - __expf(wave_sum(lp[128 + lane] * lp[192 + lane])) + lam_init;
                const float* subln = args.in[I_SUBLN] + li * 128;
                const int nunits = last ? 512 : 520;
                for (int u = vcu; u < nunits; u += G) {
                    int h, qt, n1;
                    if (u < 512) { h = u >> 6; qt = u & 63; n1 = 256; } else { h = u - 512; qt = 64; n1 = 0; }
                    const int row0 = qt * 256 + wave * 32;
                    float* o1b = O1S + ((size_t)u * 8 + wave) * 4096;
                    f32x16 o[4]; float rli[16];
                    for (int comp = 0; comp < 2; ++comp) {
#pragma unroll
                        for (int d0 = 0; d0 < 4; ++d0) o[d0] = f32x16{};
                        float lsum = 0.f;
                        att::attn_pass<128>(o, lsum, QKV + (size_t)(2 * h + comp) * SLOT + (size_t)row0 * 64, QKV + (size_t)(16 + 2 * h + comp) * SLOT, QKV + (size_t)(32 + 2 * h) * SLOT, 128, 0, n1, 0, 0, lds, wave, lane);
                        { int l1 = lane; asm volatile("" : "+v"(l1)); att::row_inv(rli, lsum, 0.f, wsf, l1 & 31, l1 >> 5); }
                        if (comp == 0) {
                            int l0 = lane; asm volatile("" : "+v"(l0)); float* o1p = o1b + l0;
#pragma unroll
                            for (int d0 = 0; d0 < 4; ++d0) {
#pragma unroll
                                for (int r = 0; r < 16; ++r) o1p[(d0 * 16 + r) * 64] = o[d0][r] * rli[r];
                                asm volatile("" ::: "memory"); }
                        }
                    }
                    int ln = lane; asm volatile("" : "+v"(ln));
                    const int r32e = ln & 31, hie = ln >> 5;
                    float ssr[16];
#pragma unroll
                    for (int r = 0; r < 16; ++r) ssr[r] = 0.f;
                    const float* o1p = o1b + ln;
#pragma unroll
                    for (int d0 = 0; d0 < 4; ++d0) {
#pragma unroll
                        for (int r = 0; r < 16; ++r) { const float vv = o1p[(d0 * 16 + r) * 64] - lam * (o[d0][r] * rli[r]); o[d0][r] = vv; ssr[r] += vv * vv; }
                        asm volatile("" ::: "memory"); }
#pragma unroll
                    for (int r = 0; r < 16; ++r) { float s = ssr[r];
#pragma unroll
                        for (int x = 1; x < 32; x <<= 1) s += __shfl_xor(s, x);
                        ssr[r] = __builtin_amdgcn_rsqf(s * (1.f / 128.f) + RMS_EPS) * (1.f - lam_init); }
#pragma unroll
                    for (int d0 = 0; d0 < 4; ++d0) { const float sg = subln[d0 * 32 + r32e];
#pragma unroll
                        for (int r = 0; r < 16; ++r) stg[att::crow(r, hie) * 128 + d0 * 32 + r32e] = (bf16)(pkbf(o[d0][r] * ssr[r] * sg, 0.f) & 0xffffu); }
                    LDS_WAIT(); asm volatile("" ::: "memory");
                    bf16* Ow = OB + (size_t)row0 * 1024 + h * 128;
#pragma unroll
                    for (int i = 0; i < 8; ++i) { const int row = i * 4 + (ln >> 4), ch = ln & 15; const u32x4 vv = *(const LAS u32x4*)(stg + row * 128 + ch * 8); *(u32x4*)(Ow + (size_t)row * 1024 + ch * 8) = vv; }
                    LDS_WAIT(); asm volatile("" ::: "memory");
                }
            }
            __syncthreads();
        }
        SEAM(pb + 2);

        if (IN(pb + 3) && !((DBG_NO_MIX >> l) & 1)) { if (!PH_ON(4)) __builtin_trap(); asm volatile("; MARK_PHASE pb+3" ::: "memory"); PHASE_IDS();
            pg8::Gemm g{OB, isC ? (const bf16*)(ws + WS_BT_OUTC) + (size_t)li * 1024 * 1024 : (const bf16*)(ws + WS_BT_OUTAB) + (size_t)li * 1024 * 1024, mrows, 1024, 1024};
            pg8::StaticOrder S; S.init(mrows, 1024, G, bx);
            pg8::EpiResid E{xcur, modl + 2 * 1024, modcl + 2 * 1024};
            pg8::gemm_phase<pg8::EpiResid, pg8::StaticOrder, true, true>(lds, g, S, E);
        }
        SEAM(pb + 3);

        if (IN(pb + 4)) { if (!PH_ON(5)) __builtin_trap(); asm volatile("; MARK_PHASE pb+4" ::: "memory"); PHASE_IDS();
            const float* gffn = args.in[I_NFFN] + l * 1024;
            const float* wg = args.in[I_WGRP] + (size_t)l * 1024 * 4; const float* we = args.in[I_WEXP] + (size_t)l * 1024 * 32;
            const float* bg = args.in[I_BGRP] + l * 4; const float* be = args.in[I_BEXP] + l * 32;
            for (int m = gw; m < mrows; m += NGW) {
                const bool isctx = m >= SEQ; const float* mm = isctx ? modcl : modl;
                f32x4 v[4];
#pragma unroll
                for (int j = 0; j < 4; ++j) v[j] = *(const f32x4*)(xcur + (size_t)m * 1024 + 4 * lane + 256 * j);
                float ss = 0.f;
#pragma unroll
                for (int j = 0; j < 4; ++j) ss += (v[j][0] * v[j][0] + v[j][1] * v[j][1]) + (v[j][2] * v[j][2] + v[j][3] * v[j][3]);
                const float rstd = __builtin_amdgcn_rsqf(wave_sum(ss) * (1.f / 1024.f) + RMS_EPS);
                float acc[36];
#pragma unroll
                for (int q = 0; q < 36; ++q) acc[q] = 0.f;
#pragma unroll
                for (int j = 0; j < 4; ++j) { const int c0 = 4 * lane + 256 * j; const f32x4 gn = *(const f32x4*)(gffn + c0), sh = *(const f32x4*)(mm + 3 * 1024 + c0), scl = *(const f32x4*)(mm + 4 * 1024 + c0);
                    const f32x4 t = v[j] * rstd * gn * (scl + 1.f) + sh;
                    *(u32x2*)(HB + (size_t)m * 1024 + c0) = (u32x2){pkbf(t[0], t[1]), pkbf(t[2], t[3])};
#pragma unroll
                    for (int e = 0; e < 4; ++e) { const float tv = t[e]; const f32x4 w4 = *(const f32x4*)(wg + (size_t)(c0 + e) * 4);
                        acc[0] += tv * w4[0]; acc[1] += tv * w4[1]; acc[2] += tv * w4[2]; acc[3] += tv * w4[3];
#pragma unroll
                        for (int q = 0; q < 8; ++q) { const f32x4 w8 = *(const f32x4*)(we + (size_t)(c0 + e) * 32 + 4 * q);
                            acc[4 + 4 * q] += tv * w8[0]; acc[5 + 4 * q] += tv * w8[1]; acc[6 + 4 * q] += tv * w8[2]; acc[7 + 4 * q] += tv * w8[3]; } }
                }
#pragma unroll
                for (int q = 0; q < 36; ++q) acc[q] = wave_sum(acc[q]);
                float lg[4]; int gidx = 0; float gmax;
#pragma unroll
                for (int q = 0; q < 4; ++q) lg[q] = acc[q] + bg[q];
                gmax = lg[0];
#pragma unroll
                for (int q = 1; q < 4; ++q) if (lg[q] > gmax) { gmax = lg[q]; gidx = q; }
                float gden = 0.f;
#pragma unroll
                for (int q = 0; q < 4; ++q) gden += __expf(lg[q] - gmax);
                const float gprob = 1.f / gden;
                float le8[8];
#pragma unroll
                for (int k = 0; k < 8; ++k) { float s = acc[4 + k] + be[k];
#pragma unroll
                    for (int q = 1; q < 4; ++q) s = (gidx == q) ? acc[4 + 8 * q + k] + be[8 * q + k] : s;
                    le8[k] = s; }
                int i1 = 0; float m1 = le8[0];
#pragma unroll
                for (int k = 1; k < 8; ++k) if (le8[k] > m1) { m1 = le8[k]; i1 = k; }
                int i2 = -1; float m2 = -3.0e38f;
#pragma unroll
                for (int k = 0; k < 8; ++k) if (k != i1 && le8[k] > m2) { m2 = le8[k]; i2 = k; }
                const float e2 = __expf(m2 - m1), inv = 1.f / (1.f + e2);
                const float w1 = gprob * inv, w2 = gprob * e2 * inv;
                if (lane == 0) {
                    const int ea = gidx * 8 + i1, eb = gidx * 8 + i2;
                    const int pa = (int)atomicAdd(ctl + CW_CNT + l * 64 + ea, 1u), pb2 = (int)atomicAdd(ctl + CW_CNT + l * 64 + eb, 1u);
                    tok_e[2 * m] = ea; tok_e[2 * m + 1] = eb; tok_p[2 * m] = pa; tok_p[2 * m + 1] = pb2; tok_w[2 * m] = w1; tok_w[2 * m + 1] = w2;
                }
            }
        }
        SEAM(pb + 4);

        if (IN(pb + 5)) { if (!PH_ON(6)) __builtin_trap(); asm volatile("; MARK_PHASE pb+5" ::: "memory"); PHASE_IDS();
            int pad = 0;
            if (lane < 32) { const unsigned c = __hip_atomic_load(ctl + CW_CNT + l * 64 + lane, __ATOMIC_RELAXED, __HIP_MEMORY_SCOPE_AGENT); pad = (int)((c + 255u) & ~255u); }
            int incl = pad;
#pragma unroll
            for (int o = 1; o < 32; o <<= 1) { const int t = __shfl_up(incl, o); if (lane >= o) incl += t; }
            const int base = incl - pad;
            for (int m = gw; m < mrows; m += NGW) {
#pragma unroll
                for (int k = 0; k < 2; ++k) {
                    const int e = tok_e[2 * m + k], pos = tok_p[2 * m + k];
                    const int row = __shfl(base, e) + pos;
                    const bf16* src = HB + (size_t)m * 1024; bf16* dst = XG + (size_t)row * 1024;
#pragma unroll
                    for (int j = 0; j < 2; ++j) *(u32x4*)(dst + 8 * lane + 512 * j) = *(const u32x4*)(src + 8 * lane + 512 * j);
                    if (lane == 0) { drow[2 * m + k] = row; rw[row] = tok_w[2 * m + k]; }
                }
            }
            if (bx == 0 && wave == 0) {
                if (lane < 32) for (int t = base >> 8; t < (base + pad) >> 8; ++t) tile_e[t] = lane;
                if (lane == 31) ntl[0] = (base + pad) >> 8;
            }
        }
        SEAM(pb + 5);

        if (IN(pb + 6)) { if (!PH_ON(7)) __builtin_trap(); asm volatile("; MARK_PHASE pb+6" ::: "memory"); PHASE_IDS();
            LAS int* tab = (LAS int*)(lds + TAB_OFF);
            if (tid < 256) tab[tid] = tile_e[tid];
            if (tid == 0) tab[256] = ntl[0];
            __syncthreads();
            const int nt = tab[256];
            pg8::Gemm g{XG, (const bf16*)(ws + WS_BT_W13) + (size_t)l * NEXP * 1024 * 1024, XG_ROWS, 1024, 1024};
            pg8::MoeOrder S{tab, nt * 4, G, bx};
            pg8::EpiSwiGLU E{HG};
            pg8::gemm_phase<pg8::EpiSwiGLU, pg8::MoeOrder, true, true>(lds, g, S, E);
        }
        SEAM(pb + 6);

        if (IN(pb + 7)) { if (!PH_ON(8)) __builtin_trap(); asm volatile("; MARK_PHASE pb+7" ::: "memory"); PHASE_IDS();
            LAS int* tab = (LAS int*)(lds + TAB_OFF);
            if (tid < 256) tab[tid] = tile_e[tid];
            if (tid == 0) tab[256] = ntl[0];
            __syncthreads();
            const int nt = tab[256];
            pg8::Gemm g{HG, (const bf16*)(ws + WS_BT_W2) + (size_t)l * NEXP * 1024 * 512, XG_ROWS, 1024, 512};
            pg8::MoeOrder S{tab, nt * 4, G, bx};
            pg8::EpiY E{YG, rw};
            pg8::gemm_phase<pg8::EpiY, pg8::MoeOrder, true, true>(lds, g, S, E);
        }
        SEAM(pb + 7);
    }

    if (IN(NPH - 1)) { if (!PH_ON(9)) __builtin_trap(); asm volatile("; MARK_PHASE final" ::: "memory"); PHASE_IDS();
        const float* gate = mod + (DEPTH - 1) * 6144 + 5 * 1024;
        for (int m = gw; m < SEQ; m += NGW) {
            const int d0 = drow[2 * m], d1 = drow[2 * m + 1];
#pragma unroll
            for (int j = 0; j < 4; ++j) { const int c0 = 4 * lane + 256 * j;
                f32x4 v = *(const f32x4*)(xcur + (size_t)m * 1024 + c0);
                const u32x2 y0 = *(const u32x2*)(YG + (size_t)d0 * 1024 + c0), y1 = *(const u32x2*)(YG + (size_t)d1 * 1024 + c0);
                const f32x4 gt = *(const f32x4*)(gate + c0);
                if (!((DBG_NO_MOE >> 3) & 1)) v = v + gt * (f32x4){bflo(y0.x) + bflo(y1.x), bfhi(y0.x) + bfhi(y1.x), bflo(y0.y) + bflo(y1.y), bfhi(y0.y) + bfhi(y1.y)};
                *(f32x4*)(args.out + (size_t)m * 1024 + c0) = v; }
        }
    }
#undef IN
#undef SEAM
}

#ifndef MK_PER_PHASE
#define MK_PER_PHASE 0
#endif
extern "C" void kernel_launch(void* const* d_in, const int* in_sizes, int n_in, void* d_out, int out_size, void* d_ws, size_t ws_size, hipStream_t stream) {
    static int grid = 0;
    if (grid == 0) {
        if (n_in != 28 || out_size != SEQ * DM || ws_size < WS_END) { fprintf(stderr, "kernel_launch: unexpected shapes (n_in %d, out %d, ws %zu)\n", n_in, out_size, ws_size); grid = -1; return; }
        int dev = 0, cus = 0;
        if (hipGetDevice(&dev) != hipSuccess || hipDeviceGetAttribute(&cus, hipDeviceAttributeMultiprocessorCount, dev) != hipSuccess) { grid = -1; return; }
        if (hipFuncSetAttribute((const void*)mega, hipFuncAttributeMaxDynamicSharedMemorySize, LDS_BYTES) != hipSuccess) { fprintf(stderr, "kernel_launch: hipFuncSetAttribute failed\n"); grid = -1; return; }
        (void)hipGetLastError();
        grid = cus;
    }
    if (grid < 0) return;
    (void)hipMemsetAsync((char*)d_ws + WS_CTL, 0, CTL_ZERO_BYTES, stream);
    Args a{};
    for (int i = 0; i < 28; ++i) a.in[i] = (const float*)d_in[i];
    a.out = (float*)d_out; a.ws = (unsigned char*)d_ws;
#if MK_PER_PHASE
    for (int p = 0; p < NPH; ++p) { a.ph_lo = p; a.ph_hi = p + 1; hipLaunchKernelGGL(mega, dim3(grid), dim3(NTHREADS), LDS_BYTES, stream, a); }
#else
    a.ph_lo = 0; a.ph_hi = NPH; hipLaunchKernelGGL(mega, dim3(grid), dim3(NTHREADS), LDS_BYTES, stream, a);
#endif
}
```

```cpp
#include <hip/hip_runtime.h>
#include <cstdio>
#include <cstdint>
namespace pg8 {
#define PG8_LAS __attribute__((address_space(3)))
typedef unsigned short bf16_t;
typedef short bf16x8 __attribute__((ext_vector_type(8)));
typedef float f32x4 __attribute__((ext_vector_type(4)));
typedef unsigned u32x4 __attribute__((ext_vector_type(4)));
constexpr int BM = 256, BK = 64, HALF = 128, HTB = HALF * BK * 2  , STAGE_BYTES = 8 * HTB, NXCD = 8, WGM = 8;

__host__ __device__ __forceinline__ int lds_byte(int r, int c) { const int st = (r >> 4) * 2 + (c >> 5), rr = r & 15, cc = c & 31, ob = rr * 64 + cc * 2; return st * 1024 + (ob ^ (((ob >> 9) & 1) << 5)); }
__host__ __device__ __forceinline__ void stage_rc(int b, int& R, int& C) { const int st = b / 1024, sb = b % 1024, swz = sb ^ (((sb >> 9) & 1) << 5); R = (st >> 1) * 16 + swz / 64; C = (st & 1) * 32 + (swz % 64) / 2; }
__host__ __device__ __forceinline__ int perm32(int rho) { const int n = rho >> 4, i = rho & 15; return 8 * (i >> 2) + 4 * n + (i & 3); }

struct Unit { int pm, pn; };
struct Gemm { const bf16_t* A; const bf16_t* Bt; int M, N, K; };

struct StaticOrder {
    int nM, nN, nwg, G, c;
    __host__ __device__ void init(int M, int N, int G_, int c_) { nM = M / BM; nN = N / BM; nwg = nM * nN; G = G_; c = c_; }
    __host__ __device__ bool next(int i, Unit& u) const {
        const long L = (long)i * G + c; if (L >= nwg) return false;
        int wgid = (int)L; { const int q = nwg / NXCD, r = nwg % NXCD, xcd = wgid % NXCD, off = wgid / NXCD; wgid = (xcd < r ? xcd * (q + 1) : r * (q + 1) + (xcd - r) * q) + off; }
        const int nig = WGM * nN, gid = wgid / nig, fm = gid * WGM, gsz = (nM - fm) < WGM ? (nM - fm) : WGM;
        u.pm = fm + ((wgid % nig) % gsz); u.pn = (wgid % nig) / gsz; return true;
    }
    __device__ __forceinline__ void a_ready(const Unit&) const {}
    __device__ __forceinline__ void done(const Unit&) const {}
};

__device__ __forceinline__ unsigned cvt_pk_bf16(float lo, float hi) { unsigned r; asm volatile("v_cvt_pk_bf16_f32 %0, %1, %2" : "=v"(r) : "v"(lo), "v"(hi)); return r; }
typedef float f32x2v __attribute__((ext_vector_type(2)));
typedef unsigned u32x2v __attribute__((ext_vector_type(2)));
typedef __bf16 bf16x2v __attribute__((ext_vector_type(2)));
__device__ __forceinline__ unsigned pkbf(float lo, float hi) { f32x2v v = {lo, hi}; bf16x2v b = __builtin_convertvector(v, bf16x2v); return __builtin_bit_cast(unsigned, b); }
__device__ __forceinline__ float swap_sum16(float x) { return x + __shfl_xor(x, 16); }
__device__ __forceinline__ float swap_sum32(float x) { return x + __shfl_xor(x, 32); }
constexpr int E_SEQ = 16384, E_MT = 16640;
constexpr size_t E_SLOT = (size_t)E_MT * 64;
constexpr float E_C2 = 0.125f * 1.4426950408889634f;

struct EpiQKV {
    static constexpr bool PERM = true, AFTER_DRAIN = false;
    bf16_t* qkv; const float *gq0, *gk0, *gq1, *gk1; const float* rope; int isC;
    __device__ __forceinline__ void operator()(const f32x4 (&acc)[2][2][4][2], const Unit& u, int wr, int wc, int fr, int fq) const {
        const int gi = u.pn * 4 + wc;
        int type; const float* gain = gq0; bf16_t* out; int pitch = 64;
        if (!isC) {
            if (gi < 8) { type = 0; gain = gq0; } else if (gi < 10) { type = 1; gain = gk0; } else if (gi < 12) { type = 2; }
            else if (gi < 20) { type = 0; gain = gq1; } else if (gi < 22) { type = 1; gain = gk1; } else { type = 2; }
            out = qkv + (size_t)gi * E_SLOT;
        } else {
            if (gi < 16) { type = 0; gain = gq0; out = qkv + (size_t)gi * E_SLOT; }
            else if (gi < 32) { type = 1; gain = gk0; out = qkv + (size_t)gi * E_SLOT; }
            else { type = 2; const int vg = gi - 32; out = qkv + (size_t)(32 + 2 * (vg >> 1)) * E_SLOT + (vg & 1) * 64; pitch = 128; }
        }
        const int rowbase = u.pm * BM + wr * 64 + fr;
        if (type < 2) {
            f32x4 g[2][2];
#pragma unroll
            for (int bj = 0; bj < 2; ++bj)
#pragma unroll
                for (int n = 0; n < 2; ++n) g[bj][n] = *(const f32x4*)(gain + bj * 32 + 8 * fq + 4 * n);
            const float qs = (type == 0) ? E_C2 : 1.f;
#pragma unroll
            for (int ai = 0; ai < 2; ++ai)
#pragma unroll
                for (int m = 0; m < 4; ++m) {
                    const int r = rowbase + ai * HALF + m * 16;
                    f32x4 v[2][2];
#pragma unroll
                    for (int bj = 0; bj < 2; ++bj)
#pragma unroll
                        for (int n = 0; n < 2; ++n) v[bj][n] = acc[ai][bj][m][n];
                    float ss = 0.f;
#pragma unroll
                    for (int bj = 0; bj < 2; ++bj)
#pragma unroll
                        for (int n = 0; n < 2; ++n) ss += (v[bj][n][0] * v[bj][n][0] + v[bj][n][1] * v[bj][n][1]) + (v[bj][n][2] * v[bj][n][2] + v[bj][n][3] * v[bj][n][3]);
                    ss = swap_sum16(ss); ss = swap_sum32(ss);
                    const float rstd = __builtin_amdgcn_rsqf(ss * (1.f / 64.f) + 1e-6f) * qs;
#pragma unroll
                    for (int bj = 0; bj < 2; ++bj)
#pragma unroll
                        for (int n = 0; n < 2; ++n) v[bj][n] = v[bj][n] * rstd * g[bj][n];
                    const int rr = (r < E_SEQ) ? r : 0;
                    const float* tb = (fq < 2) ? (rope + (rr >> 6) * 16 + 8 * fq) : (rope + 8192 + (rr & 63) * 16 + 8 * (fq - 2));
                    const int so = (fq < 2) ? 4096 : 1024;
#pragma unroll
                    for (int n = 0; n < 2; ++n) {
                        f32x4 cs = *(const f32x4*)(tb + 4 * n), sn = *(const f32x4*)(tb + so + 4 * n);
                        if (r >= E_SEQ) { cs = (f32x4){1.f, 1.f, 1.f, 1.f}; sn = (f32x4){0.f, 0.f, 0.f, 0.f}; }
                        const f32x4 y1 = v[0][n], y2 = v[1][n];
                        v[0][n] = y1 * cs - y2 * sn; v[1][n] = y2 * cs + y1 * sn;
                    }
#pragma unroll
                    for (int bj = 0; bj < 2; ++bj) {
                        u32x4 w; w.x = pkbf(v[bj][0][0], v[bj][0][1]); w.y = pkbf(v[bj][0][2], v[bj][0][3]); w.z = pkbf(v[bj][1][0], v[bj][1][1]); w.w = pkbf(v[bj][1][2], v[bj][1][3]);
                        *(u32x4*)(out + (size_t)r * 64 + bj * 32 + 8 * fq) = w;
                    }
                }
        } else {
#pragma unroll
            for (int ai = 0; ai < 2; ++ai)
#pragma unroll
                for (int m = 0; m < 4; ++m) {
                    const int r = rowbase + ai * HALF + m * 16;
#pragma unroll
                    for (int bj = 0; bj < 2; ++bj) {
                        const f32x4 v0 = acc[ai][bj][m][0], v1 = acc[ai][bj][m][1];
                        u32x4 w; w.x = pkbf(v0[0], v0[1]); w.y = pkbf(v0[2], v0[3]); w.z = pkbf(v1[0], v1[1]); w.w = pkbf(v1[2], v1[3]);
                        *(u32x4*)(out + (size_t)r * pitch + bj * 32 + 8 * fq) = w;
                    }
                }
        }
    }
};

constexpr size_t E_SL8 = (size_t)E_MT * 64;
constexpr size_t E_VT_AB = (size_t)260 * 64 * 64, E_VT_C = (size_t)260 * 128 * 64;
__device__ __forceinline__ unsigned pk4_e4m3(float a, float b, float c, float d) { int w = __builtin_amdgcn_cvt_pk_fp8_f32(a, b, 0, false); w = __builtin_amdgcn_cvt_pk_fp8_f32(c, d, w, true); return (unsigned)w; }
#ifndef QK16
#define QK16 0
#endif
typedef unsigned u32x4v __attribute__((ext_vector_type(4)));
#ifndef V_QUAD
#define V_QUAD 0
#endif
#ifndef QKV_NOV
#define QKV_NOV 0
#endif
struct EpiQKV8 {
    static constexpr bool PERM = true, AFTER_DRAIN = false;
    unsigned char* q8; const float *gq0, *gk0, *gq1, *gk1; const float* rope; int isC;
    __device__ __forceinline__ void operator()(const f32x4 (&acc)[2][2][4][2], const Unit& u, int wr, int wc, int fr, int fq) const {
        const int gi = u.pn * 4 + wc;
        int type; const float* gain = gq0; unsigned char* out = q8 + (size_t)gi * E_SL8; int dv = 64, dbase = 0;
        if (!isC) {
            if (gi < 8) { type = 0; gain = gq0; } else if (gi < 10) { type = 1; gain = gk0; } else if (gi < 12) { type = 2; out = q8 + 24 * E_SL8 + (size_t)(gi - 10) * E_VT_AB; }
            else if (gi < 20) { type = 0; gain = gq1; } else if (gi < 22) { type = 1; gain = gk1; } else { type = 2; out = q8 + 24 * E_SL8 + (size_t)(gi - 20) * E_VT_AB; }
        } else {
            if (gi < 16) { type = 0; gain = gq0; } else if (gi < 32) { type = 1; gain = gk0; }
            else { type = 2; const int vg = gi - 32; out = q8 + 32 * E_SL8 + (size_t)(vg >> 1) * E_VT_C; dv = 128; dbase = (vg & 1) * 64; }
        }
        const int rowbase = u.pm * BM + wr * 64 + fr;
        if (type < 2) {
            f32x4 g[2][2];
#pragma unroll
            for (int bj = 0; bj < 2; ++bj)
#pragma unroll
                for (int n = 0; n < 2; ++n) g[bj][n] = *(const f32x4*)(gain + bj * 32 + 8 * fq + 4 * n);
            const float qs = (type == 0) ? 4.f * E_C2 : 1.f;
#pragma unroll
            for (int ai = 0; ai < 2; ++ai)
#pragma unroll
                for (int m = 0; m < 4; ++m) {
                    const int r = rowbase + ai * HALF + m * 16;
                    f32x4 v[2][2];
#pragma unroll
                    for (int bj = 0; bj < 2; ++bj)
#pragma unroll
                        for (int n = 0; n < 2; ++n) v[bj][n] = acc[ai][bj][m][n];
                    float ss = 0.f;
#pragma unroll
                    for (int bj = 0; bj < 2; ++bj)
#pragma unroll
                        for (int n = 0; n < 2; ++n) ss += (v[bj][n][0] * v[bj][n][0] + v[bj][n][1] * v[bj][n][1]) + (v[bj][n][2] * v[bj][n][2] + v[bj][n][3] * v[bj][n][3]);
                    ss = swap_sum16(ss); ss = swap_sum32(ss);
                    const float rstd = __builtin_amdgcn_rsqf(ss * (1.f / 64.f) + 1e-6f) * qs;
#pragma unroll
                    for (int bj = 0; bj < 2; ++bj)
#pragma unroll
                        for (int n = 0; n < 2; ++n) v[bj][n] = v[bj][n] * rstd * g[bj][n];
                    const int rr = (r < E_SEQ) ? r : 0;
                    const float* tb = (fq < 2) ? (rope + (rr >> 6) * 16 + 8 * fq) : (rope + 8192 + (rr & 63) * 16 + 8 * (fq - 2));
                    const int so = (fq < 2) ? 4096 : 1024;
#pragma unroll
                    for (int n = 0; n < 2; ++n) {
                        f32x4 cs = *(const f32x4*)(tb + 4 * n), sn = *(const f32x4*)(tb + so + 4 * n);
                        if (r >= E_SEQ) { cs = (f32x4){1.f, 1.f, 1.f, 1.f}; sn = (f32x4){0.f, 0.f, 0.f, 0.f}; }
                        const f32x4 y1 = v[0][n], y2 = v[1][n];
                        v[0][n] = y1 * cs - y2 * sn; v[1][n] = y2 * cs + y1 * sn;
                    }
#if QK16
                    { u32x4v w; w.x = pk4_e4m3(v[0][0][0], v[0][0][1], v[0][0][2], v[0][0][3]); w.y = pk4_e4m3(v[0][1][0], v[0][1][1], v[0][1][2], v[0][1][3]);
                      w.z = pk4_e4m3(v[1][0][0], v[1][0][1], v[1][0][2], v[1][0][3]); w.w = pk4_e4m3(v[1][1][0], v[1][1][1], v[1][1][2], v[1][1][3]);
                      if (QKV_NOV < 2) *(u32x4v*)(out + (size_t)r * 64 + 16 * fq) = w; }
#else
#pragma unroll
                    for (int bj = 0; bj < 2; ++bj) {
                        u32x2v w; w.x = pk4_e4m3(v[bj][0][0], v[bj][0][1], v[bj][0][2], v[bj][0][3]); w.y = pk4_e4m3(v[bj][1][0], v[bj][1][1], v[bj][1][2], v[bj][1][3]);
                        if (QKV_NOV < 2) *(u32x2v*)(out + (size_t)r * 64 + bj * 32 + 8 * fq) = w;
                    }
#endif
                }
        } else {
#pragma unroll
            for (int ai = 0; ai < 2; ++ai)
#pragma unroll
                for (int m = 0; m < 4; ++m) {
                    const int r = rowbase + ai * HALF + m * 16;
                    const int pos = 32 * ((fr >> 2) & 1) + (fr & 3) + 4 * (2 * (m & 1) + (fr >> 3)) + 16 * (m >> 1);
#if V_QUAD
                    const unsigned sel1 = (fr & 1) ? 0x03070105u : 0x06020400u, sel2 = (fr & 2) ? 0x03020706u : 0x05040100u;
                    unsigned char* rq = out + ((size_t)(r >> 6) * dv + dbase + 8 * fq + (fr & 3)) * 64 + (pos & ~3);
#pragma unroll
                    for (int bj = 0; bj < 2; ++bj)
#pragma unroll
                        for (int n = 0; n < 2; ++n) { const unsigned w = pk4_e4m3(acc[ai][bj][m][n][0], acc[ai][bj][m][n][1], acc[ai][bj][m][n][2], acc[ai][bj][m][n][3]);
                            const unsigned t1 = (unsigned)__builtin_amdgcn_mov_dpp((int)w, 0xB1, 0xF, 0xF, true);
                            const unsigned x1 = __builtin_amdgcn_perm(t1, w, sel1);
                            const unsigned t2 = (unsigned)__builtin_amdgcn_mov_dpp((int)x1, 0x4E, 0xF, 0xF, true);
                            const unsigned x2 = __builtin_amdgcn_perm(t2, x1, sel2);
                            if (!QKV_NOV) *(unsigned*)(rq + (size_t)(bj * 32 + 4 * n) * 64) = x2; }
#else
                    unsigned char* rp = out + ((size_t)(r >> 6) * dv + dbase + 8 * fq) * 64 + pos;
#pragma unroll
                    for (int bj = 0; bj < 2; ++bj)
#pragma unroll
                        for (int n = 0; n < 2; ++n) { const unsigned w = pk4_e4m3(acc[ai][bj][m][n][0], acc[ai][bj][m][n][1], acc[ai][bj][m][n][2], acc[ai][bj][m][n][3]);
#pragma unroll
                            for (int e = 0; e < 4; ++e) if (!QKV_NOV) rp[(size_t)(bj * 32 + 4 * n + e) * 64] = (unsigned char)(w >> (8 * e)); }
#endif
                }
        }
    }
};

struct EpiResid {
    static constexpr bool PERM = true, AFTER_DRAIN = false;
    float* x; const float* gate_lat; const float* gate_ctx;
    __device__ __forceinline__ void operator()(const f32x4 (&acc)[2][2][4][2], const Unit& u, int wr, int wc, int fr, int fq) const {
        const float* gate = (u.pm == 64) ? gate_ctx : gate_lat;
        const int col0 = u.pn * BM + wc * 32 + 8 * fq, rowbase = u.pm * BM + wr * 64 + fr;
        f32x4 gv[2][2];
#pragma unroll
        for (int bj = 0; bj < 2; ++bj)
#pragma unroll
            for (int n = 0; n < 2; ++n) gv[bj][n] = *(const f32x4*)(gate + col0 + bj * HALF + 4 * n);
#pragma unroll
        for (int ai = 0; ai < 2; ++ai)
#pragma unroll
            for (int m = 0; m < 4; ++m) {
                float* xr = x + (size_t)(rowbase + ai * HALF + m * 16) * 1024 + col0;
#pragma unroll
                for (int bj = 0; bj < 2; ++bj)
#pragma unroll
                    for (int n = 0; n < 2; ++n) { f32x4 xv = *(f32x4*)(xr + bj * HALF + 4 * n); xv = xv + gv[bj][n] * acc[ai][bj][m][n]; *(f32x4*)(xr + bj * HALF + 4 * n) = xv; }
            }
    }
};

struct EpiSwiGLU {
    static constexpr bool PERM = true, AFTER_DRAIN = false;
    bf16_t* H; int fp8;
    __device__ __forceinline__ void operator()(const f32x4 (&acc)[2][2][4][2], const Unit& u, int wr, int wc, int fr, int fq) const {
        const int col0 = (u.pn & 3) * 128 + wc * 32 + 8 * fq, rowbase = u.pm * BM + wr * 64 + fr;
#pragma unroll
        for (int ai = 0; ai < 2; ++ai)
#pragma unroll
            for (int m = 0; m < 4; ++m) {
                float h[8];
#pragma unroll
                for (int n = 0; n < 2; ++n)
#pragma unroll
                    for (int e = 0; e < 4; ++e) { const float a = acc[ai][0][m][n][e], b = acc[ai][1][m][n][e];
                        h[4 * n + e] = a * b * __builtin_amdgcn_rcpf(1.f + __builtin_amdgcn_exp2f(-1.4426950408889634f * a)); }
                if (fp8) { u32x2v w; w.x = pk4_e4m3(h[0], h[1], h[2], h[3]); w.y = pk4_e4m3(h[4], h[5], h[6], h[7]);
                    *(u32x2v*)((unsigned char*)H + (size_t)(rowbase + ai * HALF + m * 16) * 512 + col0) = w; }
                else { u32x4 w; w.x = pkbf(h[0], h[1]); w.y = pkbf(h[2], h[3]); w.z = pkbf(h[4], h[5]); w.w = pkbf(h[6], h[7]);
                    *(u32x4*)(H + (size_t)(rowbase + ai * HALF + m * 16) * 512 + col0) = w; }
            }
    }
};

struct EpiY {
    static constexpr bool PERM = true, AFTER_DRAIN = false;
    bf16_t* Y; const float* rw;
    __device__ __forceinline__ void operator()(const f32x4 (&acc)[2][2][4][2], const Unit& u, int wr, int wc, int fr, int fq) const {
        const int col0 = (u.pn & 3) * BM + wc * 32 + 8 * fq, rowbase = u.pm * BM + wr * 64 + fr;
#pragma unroll
        for (int ai = 0; ai < 2; ++ai)
#pragma unroll
            for (int m = 0; m < 4; ++m) {
                const int r = rowbase + ai * HALF + m * 16; const float w8 = rw[r];
#pragma unroll
                for (int bj = 0; bj < 2; ++bj) { const f32x4 v0 = acc[ai][bj][m][0] * w8, v1 = acc[ai][bj][m][1] * w8;
                    u32x4 w; w.x = pkbf(v0[0], v0[1]); w.y = pkbf(v0[2], v0[3]); w.z = pkbf(v1[0], v1[1]); w.w = pkbf(v1[2], v1[3]);
                    *(u32x4*)(Y + (size_t)r * 1024 + col0 + bj * HALF) = w; }
            }
    }
};

struct MoeOrder {
    const PG8_LAS int* tile_e; int nunits, G, c;
    __device__ __forceinline__ bool next(int i, Unit& u) const {
        const int L = i * G + c; if (L >= nunits) return false;
        const int pm = L >> 2; const int e = tile_e[pm];
        u.pm = __builtin_amdgcn_readfirstlane(pm); u.pn = __builtin_amdgcn_readfirstlane(e * 4 + (L & 3)); return true;
    }
    __device__ __forceinline__ void a_ready(const Unit&) const {}
    __device__ __forceinline__ void done(const Unit&) const {}
};

typedef int v8i_t __attribute__((ext_vector_type(8)));
struct bf16x8x2 { bf16x8 a, b; };
__device__ __forceinline__ f32x4 mfma_bf16_sel(bf16x8 a, bf16x8 b, f32x4 c) { return __builtin_amdgcn_mfma_f32_16x16x32_bf16(a, b, c, 0, 0, 0); }
__device__ __forceinline__ f32x4 mfma_bf16_sel(v8i_t, v8i_t, f32x4 c) { return c; }
template <bool F8> struct FragT { typedef bf16x8 type; };
template <> struct FragT<true> { typedef v8i_t type; };
template <class Epi, class Sched, bool ALIGN_EPI = false, bool SP2 = false, bool FP8 = false>
__device__ __forceinline__ void gemm_phase(PG8_LAS unsigned char* lds, const Gemm g, const Sched& S, const Epi& E) {
    int tid_ = threadIdx.x; asm volatile("" : "+v"(tid_)); __builtin_assume(tid_ >= 0 && tid_ < 512);
    const int tid = tid_, wid = __builtin_amdgcn_readfirstlane(tid >> 6), lane = tid & 63, wr = wid >> 2, wc = wid & 3, fr = lane & 15, fq = lane >> 4;
    const int K = FP8 ? g.K / 2 : g.K, nt = K / BK;
    unsigned voffA[2], voffB[2];
#pragma unroll
    for (int i = 0; i < 2; ++i) { int R, C; stage_rc(tid * 16 + i * 8192, R, C); const int Rb = Epi::PERM ? ((R & ~31) + perm32(R & 31)) : R;
        voffA[i] = (unsigned)(R * K + C) * 2u; voffB[i] = (unsigned)(Rb * K + C) * 2u; }
    const size_t kstep = (size_t)(BK * 2);
    const size_t hstep = (size_t)HALF * K * 2;
    const size_t tstep = 2 * hstep;
    const unsigned ldsw = (unsigned)wid * 1024u;
    const int aoff = lds_byte(wr * 64 + fr, fq * (FP8 ? 16 : 8)), boff = lds_byte(wc * 32 + fr, fq * (FP8 ? 16 : 8));
    constexpr int KOFF = FP8 ? 16 : 1024;
#define PG8_SA(b, h) (((b) * 2 + (h)) * HTB)
#define PG8_SB(b, h) ((4 + (b) * 2 + (h)) * HTB)
#define PG8_STAGE(bufoff, gbase, voff) do { _Pragma("unroll") for (int _i = 0; _i < 2; ++_i) \
        __builtin_amdgcn_global_load_lds((const unsigned*)((const char*)(gbase) + (voff)[_i]), (PG8_LAS unsigned*)(lds + (bufoff) + ldsw + _i * 8192), 16, 0, 0); } while (0)
#define PG8_LDA(dst, b, h) do { _Pragma("unroll") for (int m = 0; m < 4; ++m) _Pragma("unroll") for (int k = 0; k < 2; ++k) dst[m][k] = *(const PG8_LAS bf16x8*)(lds + PG8_SA(b, h) + aoff + m * 2048 + k * KOFF); } while (0)
#define PG8_LDB(dst, b, h) do { _Pragma("unroll") for (int n = 0; n < 2; ++n) _Pragma("unroll") for (int k = 0; k < 2; ++k) dst[n][k] = *(const PG8_LAS bf16x8*)(lds + PG8_SB(b, h) + boff + n * 2048 + k * KOFF); } while (0)
#define PG8_MMA(ai, bj, At, Bt) do { __builtin_amdgcn_s_setprio(1); _Pragma("unroll") for (int m = 0; m < 4; ++m) _Pragma("unroll") for (int n = 0; n < 2; ++n) { \
        if constexpr (FP8) { asm volatile("v_mfma_scale_f32_16x16x128_f8f6f4 %0, %1, %2, %0, %3, %3 op_sel_hi:[0,0,0]" : "+v"(acc[ai][bj][m][n]) : "v"(__builtin_bit_cast(v8i_t, (bf16x8x2){Bt[n][0], Bt[n][1]})), "v"(__builtin_bit_cast(v8i_t, (bf16x8x2){At[m][0], At[m][1]})), "v"(mxsc)); } \
        else { _Pragma("unroll") for (int k = 0; k < 2; ++k) acc[ai][bj][m][n] = mfma_bf16_sel(Bt[n][k], At[m][k], acc[ai][bj][m][n]); } } __builtin_amdgcn_s_setprio(0); } while (0)
#define PG8_WAIT_V(n) asm volatile("s_waitcnt vmcnt(" #n ")" ::: "memory")
#define PG8_WAIT_L(n) asm volatile("s_waitcnt lgkmcnt(" #n ")" ::: "memory")
#define PG8_BAR __builtin_amdgcn_s_barrier()
#define PG8_SCHED __builtin_amdgcn_sched_barrier(0)
    Unit cur, nxt; int ui = 0;
    if (!S.next(0, cur)) return;
    f32x4 acc[2][2][4][2];
#pragma unroll
    for (int a = 0; a < 2; ++a)
#pragma unroll
        for (int b = 0; b < 2; ++b)
#pragma unroll
            for (int m = 0; m < 4; ++m)
#pragma unroll
                for (int n = 0; n < 2; ++n) acc[a][b][m][n] = (f32x4){0.f, 0.f, 0.f, 0.f};
    int mxsc = 0x7F7F7F7F; asm volatile("" : "+v"(mxsc));
    bf16x8 At[4][2], B0[2][2], B1[2][2];
    const char* cA = (const char*)g.A + (size_t)cur.pm * tstep; const char* cB = (const char*)g.Bt + (size_t)cur.pn * tstep;
    S.a_ready(cur);
    if constexpr (SP2) {
        PG8_STAGE(PG8_SB(0, 0), cB, voffB); PG8_STAGE(PG8_SB(0, 1), cB + hstep, voffB); PG8_STAGE(PG8_SA(0, 0), cA, voffA); PG8_STAGE(PG8_SA(0, 1), cA + hstep, voffA);
        if (wr == 1) PG8_BAR;
        PG8_WAIT_V(2); PG8_BAR;
        PG8_STAGE(PG8_SB(1, 0), cB + kstep, voffB); PG8_STAGE(PG8_SA(1, 0), cA + kstep, voffA); PG8_STAGE(PG8_SB(1, 1), cB + hstep + kstep, voffB);
        PG8_WAIT_V(6); PG8_BAR;
    } else {
        PG8_STAGE(PG8_SB(0, 0), cB, voffB); PG8_STAGE(PG8_SA(0, 0), cA, voffA); PG8_STAGE(PG8_SB(0, 1), cB + hstep, voffB); PG8_STAGE(PG8_SA(0, 1), cA + hstep, voffA);
        if (wr == 1) PG8_BAR;
        PG8_WAIT_V(4); PG8_BAR;
        PG8_STAGE(PG8_SB(1, 0), cB + kstep, voffB); PG8_STAGE(PG8_SA(1, 0), cA + kstep, voffA); PG8_STAGE(PG8_SB(1, 1), cB + hstep + kstep, voffB);
        PG8_WAIT_V(6); PG8_BAR;
    }
    for (;;) {
        const bool has_next = S.next(ui + 1, nxt);
        const char* nA = has_next ? (const char*)g.A + (size_t)nxt.pm * tstep : cA; const char* nB = has_next ? (const char*)g.Bt + (size_t)nxt.pn * tstep : cB;
#pragma nounroll
        for (int t = 0; t < nt; t += 2) {
            const bool last = (t == nt - 2);
            const char* a1 = cA + (size_t)(t + 1) * kstep;
            const char* a2 = last ? nA : cA + (size_t)(t + 2) * kstep; const char* b2 = last ? nB : cB + (size_t)(t + 2) * kstep;
            const char* a3 = a2 + kstep; const char* b3 = b2 + kstep;
            if (last && has_next) S.a_ready(nxt);
            if constexpr (SP2) {
            PG8_LDB(B0, 0, 0); PG8_LDB(B1, 0, 1); PG8_SCHED; PG8_LDA(At, 0, 0); PG8_STAGE(PG8_SA(1, 1), a1 + hstep, voffA);
            PG8_WAIT_V(8); PG8_WAIT_L(0); PG8_BAR; PG8_MMA(0, 0, At, B0); PG8_MMA(0, 1, At, B1); PG8_BAR; PG8_SCHED;
            PG8_LDA(At, 0, 1); PG8_STAGE(PG8_SB(0, 0), b2, voffB); PG8_STAGE(PG8_SB(0, 1), b2 + hstep, voffB); PG8_STAGE(PG8_SA(0, 0), a2, voffA);
            PG8_WAIT_V(8); PG8_WAIT_L(0); PG8_BAR; PG8_MMA(1, 0, At, B0); PG8_MMA(1, 1, At, B1); PG8_BAR; PG8_SCHED;
            PG8_LDB(B0, 1, 0); PG8_LDB(B1, 1, 1); PG8_SCHED; PG8_LDA(At, 1, 0); PG8_STAGE(PG8_SA(0, 1), a2 + hstep, voffA);
            PG8_WAIT_V(8); PG8_WAIT_L(0); PG8_BAR; PG8_MMA(0, 0, At, B0); PG8_MMA(0, 1, At, B1); PG8_BAR; PG8_SCHED;
            PG8_LDA(At, 1, 1); PG8_STAGE(PG8_SB(1, 0), b3, voffB); PG8_STAGE(PG8_SB(1, 1), b3 + hstep, voffB); PG8_STAGE(PG8_SA(1, 0), a3, voffA);
            PG8_WAIT_V(8); PG8_WAIT_L(0); PG8_BAR; PG8_MMA(1, 0, At, B0); PG8_MMA(1, 1, At, B1); PG8_BAR; PG8_SCHED;
            } else {
            PG8_LDB(B0, 0, 0); PG8_SCHED; PG8_LDA(At, 0, 0); PG8_STAGE(PG8_SA(1, 1), a1 + hstep, voffA);
            PG8_WAIT_L(8); PG8_BAR; PG8_WAIT_L(0); PG8_MMA(0, 0, At, B0); PG8_BAR; PG8_SCHED;
            PG8_LDB(B1, 0, 1); PG8_STAGE(PG8_SB(0, 0), b2, voffB);
            PG8_BAR; PG8_WAIT_L(0); PG8_MMA(0, 1, At, B1); PG8_BAR;
            PG8_LDA(At, 0, 1); PG8_STAGE(PG8_SA(0, 0), a2, voffA);
            PG8_BAR; PG8_WAIT_L(0); PG8_MMA(1, 0, At, B0); PG8_BAR; PG8_SCHED;
            PG8_STAGE(PG8_SB(0, 1), b2 + hstep, voffB);
            PG8_WAIT_V(6); PG8_BAR; PG8_MMA(1, 1, At, B1); PG8_BAR;
            PG8_LDB(B0, 1, 0); PG8_SCHED; PG8_LDA(At, 1, 0); PG8_STAGE(PG8_SA(0, 1), a2 + hstep, voffA);
            PG8_WAIT_L(8); PG8_BAR; PG8_WAIT_L(0); PG8_MMA(0, 0, At, B0); PG8_BAR; PG8_SCHED;
            PG8_LDB(B1, 1, 1); PG8_STAGE(PG8_SB(1, 0), b3, voffB);
            PG8_BAR; PG8_WAIT_L(0); PG8_MMA(0, 1, At, B1); PG8_BAR;
            PG8_LDA(At, 1, 1); PG8_STAGE(PG8_SA(1, 0), a3, voffA);
            PG8_BAR; PG8_WAIT_L(0); PG8_MMA(1, 0, At, B0); PG8_BAR; PG8_SCHED;
            PG8_STAGE(PG8_SB(1, 1), b3 + hstep, voffB);
            PG8_WAIT_V(6); PG8_BAR; PG8_MMA(1, 1, At, B1); PG8_BAR;
            }
        }
        if constexpr (FP8) asm volatile("s_nop 15\n\ts_nop 7" ::: "memory");
        if constexpr (ALIGN_EPI) { if (wr == 0) PG8_BAR; }
        if constexpr (!Epi::AFTER_DRAIN) { E(acc, cur, wr, wc, fr, fq); S.done(cur); }
        if (!has_next) break;
#pragma unroll
        for (int a = 0; a < 2; ++a)
#pragma unroll
            for (int b = 0; b < 2; ++b)
#pragma unroll
                for (int m = 0; m < 4; ++m)
#pragma unroll
                    for (int n = 0; n < 2; ++n) acc[a][b][m][n] = (f32x4){0.f, 0.f, 0.f, 0.f};
        cur = nxt; cA = nA; cB = nB; ++ui;
        if constexpr (ALIGN_EPI) { if (wr == 1) PG8_BAR; }
    }
    PG8_WAIT_V(0);
    if constexpr (!ALIGN_EPI) { if (wr == 0) PG8_BAR; }
    PG8_BAR;
    if constexpr (Epi::AFTER_DRAIN) { E.fused(acc, cur, wr, wc, fr, fq, lds, wid, lane); S.done(cur); }
#undef PG8_SA
#undef PG8_SB
#undef PG8_STAGE
#undef PG8_LDA
#undef PG8_LDB
#undef PG8_MMA
#undef PG8_WAIT_V
#undef PG8_WAIT_L
#undef PG8_BAR
#undef PG8_SCHED
}
}
#define LAS __attribute__((address_space(3)))
#define XB_TMO      128
#define XB_XCNT(j)  (256  + 64 * (j))
#define XB_XSUB(j)  (1280 + 64 * (j))
#define XB_XGEN(j)  (2304 + 64 * (j))
#define XB_TOP      3328
#define XB_TOPGEN   3392
#define XCD_BAR_WORDS 3456
#define XB_SPIN_CAP (1u << 18)

__device__ __forceinline__ unsigned xb_ld(unsigned* p)              { return __hip_atomic_load(p, __ATOMIC_RELAXED, __HIP_MEMORY_SCOPE_AGENT); }
__device__ __forceinline__ unsigned xb_add(unsigned* p, unsigned v) { return __hip_atomic_fetch_add(p, v, __ATOMIC_RELAXED, __HIP_MEMORY_SCOPE_AGENT); }
__device__ __forceinline__ unsigned xb_xcc_id() { return (unsigned)__builtin_amdgcn_s_getreg((3 << 11) | 20) & 0xFu; }
#define XB_SPIN(cond, bar) do { unsigned _sp = 0; while (cond) { __builtin_amdgcn_s_sleep(1); \
    if ((++_sp & 255u) == 0u) { if (xb_ld(&(bar)[XB_TMO])) break; if (_sp > XB_SPIN_CAP) { atomicAdd(&(bar)[XB_TMO], 1u); break; } } } } while (0)

struct XcdBarrier {
    unsigned* bar; unsigned x;
    volatile LAS unsigned* st;
};

__device__ __forceinline__ XcdBarrier xcd_barrier_post(unsigned* bar, volatile LAS unsigned* st) {
    XcdBarrier b; b.bar = bar; b.x = xb_xcc_id(); b.st = st;
    if (threadIdx.x == 0) (void)xb_add(&bar[XB_XCNT(b.x)], 1u);
    return b;
}
__device__ __forceinline__ void xcd_barrier_complete(unsigned* bar, unsigned x, unsigned& nloc, unsigned& nx) {
    const unsigned G = gridDim.x * gridDim.y * gridDim.z;
    unsigned sum, cnt, mine, sp = 0u;
    for (;;) {
        sum = 0u; cnt = 0u; mine = 0u;
#pragma unroll
        for (unsigned j = 0; j < 16; ++j) { const unsigned c = xb_ld(&bar[XB_XCNT(j)]); sum += c; cnt += (c > 0u) ? 1u : 0u; mine = (j == x) ? c : mine; }
        if (sum == G) break;
        __builtin_amdgcn_s_sleep(1);
        if ((++sp & 255u) == 0u) { if (xb_ld(&bar[XB_TMO])) break; if (sp > XB_SPIN_CAP) { atomicAdd(&bar[XB_TMO], 1u); break; } }
    }
    nloc = mine > 0u ? mine : 1u; nx = cnt > 0u ? cnt : 1u;
}

__device__ __forceinline__ void xcd_barrier(const XcdBarrier& b) {
    asm volatile("s_waitcnt vmcnt(0)" ::: "memory");
    __syncthreads();
    if (threadIdx.x == 0) {
        unsigned* bar = b.bar;
        __builtin_amdgcn_s_waitcnt(0);
        unsigned nloc = b.st[0], nx = b.st[1];
        if (nloc == 0u) { xcd_barrier_complete(bar, b.x, nloc, nx); b.st[0] = nloc; b.st[1] = nx; }
        const unsigned old = xb_add(&bar[XB_XSUB(b.x)], 1u);
        const unsigned gen = old / nloc;
        if (old + 1u == (gen + 1u) * nloc) {
            __builtin_amdgcn_fence(__ATOMIC_RELEASE, "agent");
            asm volatile("s_waitcnt vmcnt(0)" ::: "memory");
            const unsigned og = xb_add(&bar[XB_TOP], 1u);
            const unsigned tg = og / nx;
            if (og + 1u == (tg + 1u) * nx) xb_add(&bar[XB_TOPGEN], 1u);
            else XB_SPIN(xb_ld(&bar[XB_TOPGEN]) == tg, bar);
            __builtin_amdgcn_fence(__ATOMIC_ACQUIRE, "agent");
            xb_add(&bar[XB_XGEN(b.x)], 1u);
            asm volatile("s_waitcnt vmcnt(0)" ::: "memory");
        } else {
            XB_SPIN(xb_ld(&bar[XB_XGEN(b.x)]) == gen, bar);
            __builtin_amdgcn_fence(__ATOMIC_ACQUIRE, "agent");
            asm volatile("s_waitcnt vmcnt(0)" ::: "memory");
        }
    }
    __syncthreads();
}

#ifndef GEMM_FP8
#define GEMM_FP8 1
#endif
#ifndef FP8_B
#define FP8_B 1
#define FP8_B_UNUSED GEMM_FP8
#endif
#ifndef FP8_G
#define FP8_G GEMM_FP8
#endif
#ifndef FP8_H
#define FP8_H GEMM_FP8
#endif
#ifndef USE_FP8
#define USE_FP8 1
#endif
#ifndef ATT_TIMING
#define ATT_TIMING 0
#endif
#define GAS __attribute__((address_space(1)))
typedef unsigned short bf16;
typedef float f32x4 __attribute__((ext_vector_type(4)));
typedef float f32x16 __attribute__((ext_vector_type(16)));
typedef short bf16x8 __attribute__((ext_vector_type(8)));
typedef short s16x4 __attribute__((ext_vector_type(4)));
typedef short v4i16_t __attribute__((ext_vector_type(4)));
typedef unsigned u32x4 __attribute__((ext_vector_type(4)));
typedef unsigned u32x2 __attribute__((ext_vector_type(2)));
using pg8::pkbf;

constexpr int DM = 1024, SEQ = 16384, CTXL = 256, MT = SEQ + CTXL, DEPTH = 4, NEXP = 32, DEXP = 512;
constexpr int XG_ROWS = 41472;
constexpr size_t SLOT = (size_t)MT * 64;
constexpr float LOG2E = 1.4426950408889634f, RMS_EPS = 1e-6f;
constexpr int NWAVES = 8, NTHREADS = 512;

constexpr size_t MiB = 1u << 20;
constexpr size_t WS_CTL = 0, CTL_ZERO_BYTES = 1 * MiB;
constexpr size_t WS_MOD = 1 * MiB;
constexpr size_t WS_ROPE = 1 * MiB + 512 * 1024;
constexpr size_t WS_BT_INAB = 2 * MiB, WS_BT_OUTAB = 8 * MiB, WS_BT_INC = 12 * MiB, WS_BT_OUTC = 24 * MiB;
constexpr size_t WS_BT_W13 = 32 * MiB, WS_BT_W2 = 288 * MiB;
constexpr size_t WS_XCUR = 416 * MiB, WS_HB = 481 * MiB, WS_QKV = 514 * MiB, WS_OB = 612 * MiB, WS_O1S = 645 * MiB;
constexpr size_t WS_XG = 710 * MiB, WS_HG = 791 * MiB, WS_YG = 832 * MiB, WS_ROUTE = 913 * MiB, WS_END = 915 * MiB;
constexpr size_t RT_WTR = 1408 * 1024;
constexpr size_t RT_TOKE = 0, RT_TOKP = 256 * 1024, RT_TOKW = 512 * 1024, RT_DROW = 768 * 1024, RT_RW = 1024 * 1024, RT_TILE = 1280 * 1024, RT_NT = 1280 * 1024 + 4096;
static_assert(WS_BT_W13 + (size_t)DEPTH * NEXP * 1024 * 1024 * 2 <= WS_BT_W2 && WS_BT_W2 + (size_t)DEPTH * NEXP * 1024 * 512 * 2 <= WS_XCUR, "ws map");
static_assert(WS_XCUR + (size_t)MT * DM * 4 <= WS_HB && WS_HB + (size_t)MT * DM * 2 <= WS_QKV && WS_QKV + 48 * SLOT * 2 <= WS_OB && WS_OB + (size_t)MT * DM * 2 <= WS_O1S, "ws map");
static_assert(WS_O1S + (size_t)520 * 131072 <= WS_XG && WS_XG + (size_t)XG_ROWS * DM * 2 <= WS_HG && WS_HG + (size_t)XG_ROWS * DEXP * 2 <= WS_YG && WS_YG + (size_t)XG_ROWS * DM * 2 <= WS_ROUTE, "ws map");
constexpr int CW_BAR = 4096, CW_CNT = 150016, CW_DIAG = 32768;

constexpr int LDS_STAGE = 73728, LDS_WSF = 139264, LDS_RW = 0  , LDS_PAR = 148480  , LDSCTL_OFF = 156672, MISC_OFF = LDSCTL_OFF + 320, TAB_OFF = LDSCTL_OFF + 1024, LDS_XCH = LDSCTL_OFF + 3072  , LDS_BYTES = 160768;
static_assert(TAB_OFF + 1024 + 64 <= LDS_BYTES, "LDS map");

constexpr int NPH = 2 + 8 * DEPTH;

#define LDS_WAIT() asm volatile("s_waitcnt lgkmcnt(0)" ::: "memory")
__device__ __forceinline__ float dpp_sum16(float v);
__device__ __forceinline__ float wave_sum(float v) { v = dpp_sum16(v); v += __shfl_xor(v, 16); v += __shfl_xor(v, 32); return v; }
__device__ __forceinline__ float dpp_sum16(float v) {
    v += __builtin_bit_cast(float, __builtin_amdgcn_update_dpp(0, __builtin_bit_cast(int, v), 0xB1, 0xF, 0xF, true));
    v += __builtin_bit_cast(float, __builtin_amdgcn_update_dpp(0, __builtin_bit_cast(int, v), 0x4E, 0xF, 0xF, true));
    v += __builtin_bit_cast(float, __builtin_amdgcn_update_dpp(0, __builtin_bit_cast(int, v), 0x141, 0xF, 0xF, true));
    v += __builtin_bit_cast(float, __builtin_amdgcn_update_dpp(0, __builtin_bit_cast(int, v), 0x140, 0xF, 0xF, true));
    return v;
}
__device__ __forceinline__ float bf2f(unsigned short u) { return __builtin_bit_cast(float, (unsigned)u << 16); }
__device__ __forceinline__ float bflo(unsigned u) { return __builtin_bit_cast(float, u << 16); }
__device__ __forceinline__ float bfhi(unsigned u) { return __builtin_bit_cast(float, u & 0xffff0000u); }

__device__ __forceinline__ void transpose_item(const float* W, int ldw, int srccol0, bf16* WT, int K, int dstrow0, int k0, LAS float* scr, int lane) {
    { f32x4 v[8]; const int rr = lane >> 3, cs = lane & 7;
#pragma unroll
      for (int i = 0; i < 8; ++i) v[i] = *(const GAS f32x4*)(W + (size_t)(k0 + 8 * i + rr) * ldw + srccol0 + 4 * cs);
#pragma unroll
      for (int i = 0; i < 8; ++i) { LAS float* d = scr + (8 * i + rr) * 33 + 4 * cs; d[0] = v[i][0]; d[1] = v[i][1]; d[2] = v[i][2]; d[3] = v[i][3]; } }
    LDS_WAIT(); asm volatile("" ::: "memory");
    const int c = lane & 7;
#pragma unroll
    for (int j = 0; j < 4; ++j) { const int n = (lane >> 3) + 8 * j; const LAS float* s = scr + (8 * c) * 33 + n;
        u32x4 o; o.x = pkbf(s[0 * 33], s[1 * 33]); o.y = pkbf(s[2 * 33], s[3 * 33]); o.z = pkbf(s[4 * 33], s[5 * 33]); o.w = pkbf(s[6 * 33], s[7 * 33]);
        *(GAS u32x4*)(WT + (size_t)(dstrow0 + n) * K + k0 + 8 * c) = o; }
    LDS_WAIT(); asm volatile("" ::: "memory");
}

__device__ __forceinline__ void transpose_item8(const float* W, int ldw, int srccol0, unsigned char* WT, int K, int dstrow0, int k0, LAS float* scr, int lane) {
    { f32x4 v[8]; const int rr = lane >> 3, cs = lane & 7;
#pragma unroll
      for (int i = 0; i < 8; ++i) v[i] = *(const GAS f32x4*)(W + (size_t)(k0 + 8 * i + rr) * ldw + srccol0 + 4 * cs);
#pragma unroll
      for (int i = 0; i < 8; ++i) { LAS float* d = scr + (8 * i + rr) * 33 + 4 * cs; d[0] = v[i][0]; d[1] = v[i][1]; d[2] = v[i][2]; d[3] = v[i][3]; } }
    LDS_WAIT(); asm volatile("" ::: "memory");
    const int c = lane & 7;
#pragma unroll
    for (int j = 0; j < 4; ++j) { const int n = (lane >> 3) + 8 * j; const LAS float* s = scr + (8 * c) * 33 + n;
        u32x2 o; o.x = pg8::pk4_e4m3(s[0 * 33], s[1 * 33], s[2 * 33], s[3 * 33]); o.y = pg8::pk4_e4m3(s[4 * 33], s[5 * 33], s[6 * 33], s[7 * 33]);
        *(GAS u32x2*)(WT + (size_t)(dstrow0 + n) * K + k0 + 8 * c) = o; }
    LDS_WAIT(); asm volatile("" ::: "memory");
}

#ifndef AF_QKNOP
#define AF_QKNOP ""
#endif
#ifndef AF_PVNOP
#define AF_PVNOP ""
#define AF_PLNOP "s_nop 0\n\t"
#endif
#ifndef AF_NOPS
#define AF_NOPS "1"
#endif
namespace att {
typedef __attribute__((address_space(3))) const char* lds_cptr;
__device__ __forceinline__ int crow(int r, int hi) { return (r & 3) + 8 * (r >> 2) + 4 * hi; }
__device__ __forceinline__ void glds16(const void* gsrc, unsigned lds_dst) { unsigned keep;
    asm volatile("s_mov_b32 %0, m0\n\ts_mov_b32 m0, %2\n\ts_nop 0\n\tglobal_load_lds_dwordx4 %1, off\n\ts_mov_b32 m0, %0" : "=&s"(keep) : "v"(gsrc), "s"(lds_dst) : "memory"); }
__device__ __forceinline__ void glds16s(unsigned voff, const void* sbase, unsigned lds_dst) {
    asm volatile("s_mov_b32 m0, %2\n\ts_nop 0\n\tglobal_load_lds_dwordx4 %0, %1" :: "v"(voff), "s"(sbase), "s"(lds_dst) : "memory", "m0"); }
__device__ __forceinline__ const void* uniform_ptr(const void* p) { const unsigned long long v = (unsigned long long)p;
    return (const void*)(((unsigned long long)(unsigned)__builtin_amdgcn_readfirstlane((int)(v >> 32)) << 32) | (unsigned)__builtin_amdgcn_readfirstlane((int)(unsigned)v)); }
__device__ __forceinline__ s16x4 vtr(lds_cptr p) { return __builtin_bit_cast(s16x4, __builtin_amdgcn_ds_read_tr16_b64_v4i16((LAS v4i16_t*)p)); }
#if ATT_TIMING
#define ATT_WAITBAR(N) do { unsigned long long ta_, tb_; asm volatile("s_memtime %0\n\ts_waitcnt vmcnt(" #N ") lgkmcnt(0)\n\ts_barrier\n\ts_memtime %1\n\ts_waitcnt lgkmcnt(0)" : "=s"(ta_), "=s"(tb_) :: "memory"); att_twait += tb_ - ta_; } while (0)
#else
#define ATT_WAITBAR(N) asm volatile("s_waitcnt vmcnt(" #N ") lgkmcnt(0)\n\ts_barrier" ::: "memory")
#endif

template <int DV>
__device__ __forceinline__ void attn_pass(f32x16 (&o)[DV / 32], float& lsum, const bf16* Qw, const bf16* Kb, const bf16* Vb, int vpitch,
                                          int t0, int n1, int masked, int qpos, LAS unsigned char* lds, int wid, int lane) {
    constexpr int NV = DV / 64, KSLOT = 8192, VSLOT = DV * 128, LV = 3 * KSLOT;
    unsigned long long att_twait = 0; (void)att_twait;
    const int r32 = lane & 31, hi = lane >> 5, n = n1 + 4;
    const unsigned lds0 = (unsigned)(unsigned long)lds;
    bf16x8 qr[4];
#pragma unroll
    for (int d0 = 0; d0 < 4; ++d0) qr[d0] = *(const bf16x8*)(Qw + (size_t)r32 * 64 + d0 * 16 + hi * 8);
    const bf16* ksrc = Kb + (size_t)lane * 64 + wid * 8;
    const bf16* vsrc[NV];
#pragma unroll
    for (int j = 0; j < NV; ++j) { const int pi = wid + 8 * j, db = pi >> 2, kg = pi & 3; vsrc[j] = Vb + (size_t)(16 * kg + (lane >> 2)) * vpitch + db * 32 + (lane & 3) * 8; }
#define ATT_TILE(i_) ((i_) < n1 ? t0 + (i_) : 256 + (i_) - n1)
#define ATT_DMA(tl_, sl_) do { const int tl__ = (tl_); const int sl__ = (sl_); \
        glds16(ksrc + (size_t)tl__ * 4096, (unsigned)__builtin_amdgcn_readfirstlane(lds0 + sl__ * KSLOT + wid * 1024)); \
        _Pragma("unroll") for (int j_ = 0; j_ < NV; ++j_) glds16(vsrc[j_] + (size_t)tl__ * 64 * vpitch, (unsigned)__builtin_amdgcn_readfirstlane(lds0 + LV + sl__ * VSLOT + (wid + 8 * j_) * 1024)); } while (0)
    ATT_DMA(ATT_TILE(0), 0);
    if (n > 1) ATT_DMA(ATT_TILE(1), 1);
    int sl = 0, sl2 = 2;
    for (int i = 0; i < n; ++i) {
        if (i + 1 < n) { if (NV == 1) ATT_WAITBAR(2); else ATT_WAITBAR(3); } else ATT_WAITBAR(0);
        if (i + 2 < n) ATT_DMA(ATT_TILE(i + 2), sl2);
        const int tl = ATT_TILE(i);
        const lds_cptr kp = (lds_cptr)lds + sl * KSLOT + hi * 1024 + r32 * 16;
        bf16x8 kf[8];
#pragma unroll
        for (int d0 = 0; d0 < 4; ++d0) { kf[2 * d0] = *(const LAS bf16x8*)(kp + d0 * 2048); kf[2 * d0 + 1] = *(const LAS bf16x8*)(kp + d0 * 2048 + 512); }
        f32x16 p0 = {}, p1 = {};
#pragma unroll
        for (int d0 = 0; d0 < 4; ++d0) { p0 = __builtin_amdgcn_mfma_f32_32x32x16_bf16(kf[2 * d0], qr[d0], p0, 0, 0, 0); p1 = __builtin_amdgcn_mfma_f32_32x32x16_bf16(kf[2 * d0 + 1], qr[d0], p1, 0, 0, 0); }
#pragma unroll
        for (int r = 0; r < 16; ++r) { p0[r] = __builtin_amdgcn_exp2f(p0[r]); p1[r] = __builtin_amdgcn_exp2f(p1[r]); }
        if (masked && tl < 256) {
            const int kb = 64 * tl + 4 * hi - (qpos + r32) + 128;
#pragma unroll
            for (int r = 0; r < 16; ++r) { const int kv = kb + (r & 3) + 8 * (r >> 2); if ((unsigned)kv > 256u) p0[r] = 0.f; if ((unsigned)(kv + 32) > 256u) p1[r] = 0.f; }
        }
        float s0 = 0.f, s1 = 0.f;
#pragma unroll
        for (int r = 0; r < 16; ++r) { s0 += p0[r]; s1 += p1[r]; }
        lsum += s0 + s1;
        u32x4 pw[4];
#pragma unroll
        for (int k = 0; k < 2; ++k) {
            pw[k]     = (u32x4){pkbf(p0[8 * k], p0[8 * k + 1]), pkbf(p0[8 * k + 2], p0[8 * k + 3]), pkbf(p0[8 * k + 4], p0[8 * k + 5]), pkbf(p0[8 * k + 6], p0[8 * k + 7])};
            pw[2 + k] = (u32x4){pkbf(p1[8 * k], p1[8 * k + 1]), pkbf(p1[8 * k + 2], p1[8 * k + 3]), pkbf(p1[8 * k + 4], p1[8 * k + 5]), pkbf(p1[8 * k + 6], p1[8 * k + 7])};
        }
        const lds_cptr vp = (lds_cptr)lds + LV + sl * VSLOT + ((lane >> 4) & 1) * 32 + (lane & 3) * 8 + (4 * hi + ((lane & 15) >> 2)) * 64;
#pragma unroll
        for (int d0 = 0; d0 < DV / 32; ++d0) {
#pragma unroll
            for (int ks = 0; ks < 4; ++ks) {
                const s16x4 lo = vtr(vp + d0 * 4096 + ks * 1024), hh = vtr(vp + d0 * 4096 + ks * 1024 + 512);
                const bf16x8 vf = (bf16x8){lo[0], lo[1], lo[2], lo[3], hh[0], hh[1], hh[2], hh[3]};
                o[d0] = __builtin_amdgcn_mfma_f32_32x32x16_bf16(__builtin_bit_cast(bf16x8, pw[ks]), vf, o[d0], 0, 0, 0);
            }
            if (DV > 64) __builtin_amdgcn_sched_barrier(0);
        }
        sl = (sl == 2) ? 0 : sl + 1; sl2 = (sl2 == 2) ? 0 : sl2 + 1;
    }
    asm volatile("s_waitcnt lgkmcnt(0)\n\ts_barrier" ::: "memory");
#undef ATT_TILE
#undef ATT_DMA
}
#define ATT_SBAR() __builtin_amdgcn_sched_barrier(0)
template <int DV>
__device__ __forceinline__ void attn_pipe(f32x16 (&o)[DV / 32], float& l_out, const bf16* Qw, const bf16* Kb, const bf16* Vb, int vpitch,
                                          int t0, int n1, int masked, int qpos, LAS unsigned char* lds, int wid, int lane, unsigned long long* att_tm = nullptr) {
    constexpr int NV = DV / 64, KSLOT = 8192, VSLOT = DV * 128, LV = 3 * KSLOT;
    unsigned long long att_twait = 0; (void)att_twait;
#if ATT_TIMING
    const unsigned long long att_t0 = __builtin_amdgcn_s_memtime();
#endif
    const int r32 = lane & 31, hi = lane >> 5, NT = n1 + 4;
    const unsigned lds0 = (unsigned)(unsigned long)lds;
    const char* Kbu = (const char*)uniform_ptr(Kb); const char* Vbu = (const char*)uniform_ptr(Vb);
    const unsigned koff = (unsigned)((8 * wid + (lane >> 3)) * 128 + (((lane & 7) ^ (((8 * wid + (lane >> 3)) >> 1) & 7)) * 16));
    unsigned voff[NV];
#pragma unroll
    for (int j = 0; j < NV; ++j) { const int pi = wid + 8 * j, db = pi >> 2, kg = pi & 3; voff[j] = (unsigned)((16 * kg + (lane >> 2)) * vpitch + db * 32 + (lane & 3) * 8) * 2u; }
    const unsigned kdst = lds0 + wid * 1024, vdst = lds0 + LV + wid * 1024;
#define AP_TILE(i_) ((i_) < n1 ? t0 + (i_) : 256 + (i_) - n1)
#define AP_DMA_K(t_, sl_) glds16s(koff, Kbu + (size_t)AP_TILE(t_) * 8192, (unsigned)__builtin_amdgcn_readfirstlane(kdst + (sl_) * KSLOT))
#define AP_DMA_V(t_, sl_) do { const char* vb__ = Vbu + (size_t)AP_TILE(t_) * 128 * vpitch; _Pragma("unroll") for (int j_ = 0; j_ < NV; ++j_) glds16s(voff[j_], vb__, (unsigned)__builtin_amdgcn_readfirstlane(vdst + (sl_) * VSLOT + j_ * 8192)); } while (0)
#define AP_WAITBAR_STEADY() do { if (NV == 1) ATT_WAITBAR(2); else ATT_WAITBAR(3); } while (0)
#define AP_WAITBAR_VONLY()  do { if (NV == 1) ATT_WAITBAR(1); else ATT_WAITBAR(2); } while (0)
#define AP_MASK(C0_, C1_, t_) do { if (masked) { const int tl__ = AP_TILE(t_); if (tl__ < 256) { asm volatile("s_nop 15\n\ts_nop 7" : "+v"(C0_), "+v"(C1_)); const int kb__ = 64 * tl__ + 4 * hi - (qpos + r32) + 128; \
        _Pragma("unroll") for (int r = 0; r < 16; ++r) { const int kv = kb__ + (r & 3) + 8 * (r >> 2); if ((unsigned)kv > 256u) C0_[r] = -INFINITY; if ((unsigned)(kv + 32) > 256u) C1_[r] = -INFINITY; } } } } while (0)
    const lds_cptr lds3 = (lds_cptr)lds;
    lds_cptr kpd[4];
#pragma unroll
    for (int d0 = 0; d0 < 4; ++d0) kpd[d0] = lds3 + r32 * 128 + (((2 * d0 + hi) ^ ((r32 >> 1) & 7)) * 16);
    const lds_cptr vp0 = lds3 + LV + ((lane >> 4) & 1) * 32 + (lane & 3) * 8 + (4 * hi + ((lane & 15) >> 2)) * 64;
    AP_DMA_K(0, 0); AP_DMA_V(0, 0); AP_DMA_K(1, 1);
    bf16x8 qr[4];
#pragma unroll
    for (int d0 = 0; d0 < 4; ++d0) qr[d0] = *(const bf16x8*)(Qw + (size_t)r32 * 64 + d0 * 16 + hi * 8);
    AP_DMA_K(2, 2);
    if (NV == 1) ATT_WAITBAR(3); else ATT_WAITBAR(4);
    float l_reg = 0.f;
    unsigned long long ts0_ = 0, ts1_ = 0, att_tA = 0; (void)ts0_; (void)ts1_; (void)att_tA;
    const f32x16 zero16 = {};
    f32x16 pA0, pA1, pB0, pB1;
    bf16x8 kf[8];
    {
#pragma unroll
        for (int d0 = 0; d0 < 4; ++d0) { kf[2 * d0] = *(const LAS bf16x8*)(kpd[d0]); kf[2 * d0 + 1] = *(const LAS bf16x8*)(kpd[d0] + 4096); }
        pA0 = __builtin_amdgcn_mfma_f32_32x32x16_bf16(kf[0], qr[0], zero16, 0, 0, 0); pA1 = __builtin_amdgcn_mfma_f32_32x32x16_bf16(kf[1], qr[0], zero16, 0, 0, 0);
#pragma unroll
        for (int d0 = 1; d0 < 4; ++d0) { pA0 = __builtin_amdgcn_mfma_f32_32x32x16_bf16(kf[2 * d0], qr[d0], pA0, 0, 0, 0); pA1 = __builtin_amdgcn_mfma_f32_32x32x16_bf16(kf[2 * d0 + 1], qr[d0], pA1, 0, 0, 0); }
        AP_MASK(pA0, pA1, 0);
#pragma unroll
        for (int r = 0; r < 16; ++r) { pA0[r] = __builtin_amdgcn_exp2f(pA0[r]); pA1[r] = __builtin_amdgcn_exp2f(pA1[r]); }
    }
    ATT_WAITBAR(0);
    AP_DMA_K(3, 0); AP_DMA_V(1, 1);
    int sl_prev = 0, sl_cur = 1, sl_next = 2;
#define AP_ROT() do { sl_prev = sl_cur; sl_cur = sl_next; sl_next = (sl_next == 2) ? 0 : sl_next + 1; } while (0)
#pragma unroll
    for (int d0 = 0; d0 < 4; ++d0) { kf[2 * d0] = *(const LAS bf16x8*)(kpd[d0] + sl_cur * KSLOT); kf[2 * d0 + 1] = *(const LAS bf16x8*)(kpd[d0] + sl_cur * KSLOT + 4096); }
    AP_WAITBAR_STEADY();
    s16x4 vlo[NV == 1 ? 8 : 4], vhi[NV == 1 ? 8 : 4]; u32x4 pw0, pw1, pw2, pw3;
#define AP_PKW(P, B) pkbf(P[B], P[B + 1])
#define AP_PAF(k) __builtin_bit_cast(bf16x8, pw##k)
#define AP_VFR(i) (bf16x8){vlo[i][0], vlo[i][1], vlo[i][2], vlo[i][3], vhi[i][0], vhi[i][1], vhi[i][2], vhi[i][3]}
#define AP_PIN(x) asm volatile("" : "+v"(x))
#define AP_GAPA(MF, A0, A1, A2, A3, W0, W1, PW) do { MF; sacc += A0; sacc += A1; sacc += A2; sacc += A3; AP_PIN(sacc); W0; W1; AP_PIN(PW); ATT_SBAR(); } while (0)
#define AP_EX(v) __builtin_amdgcn_exp2f(v)
#define AP_GAPB4(MF, X, B) do { MF; X[B] = AP_EX(X[B]); X[B + 1] = AP_EX(X[B + 1]); X[B + 2] = AP_EX(X[B + 2]); X[B + 3] = AP_EX(X[B + 3]); AP_PIN(X); ATT_SBAR(); } while (0)
#define AP_GAPB2(MF, X, B) do { MF; X[B] = AP_EX(X[B]); X[B + 1] = AP_EX(X[B + 1]); AP_PIN(X); ATT_SBAR(); } while (0)
#define AP_VRD(i) do { vlo[i] = vtr(vp_ + (((i) >> 2) * 4096 + ((i) & 3) * 1024)); vhi[i] = vtr(vp_ + (((i) >> 2) * 4096 + ((i) & 3) * 1024 + 512)); } while (0)
#define AP_VRD_A(i) do { if (NV == 1) { AP_VRD(i); ATT_SBAR(); } } while (0)
#define AP_VRD_G(g) do { if (NV == 2 && (g) < 6) { if (((g) & 1) == 0) vlo[(g) >> 1] = vtr(vp_ + ((g) >> 1) * 4096); else vhi[(g) >> 1] = vtr(vp_ + ((g) >> 1) * 4096 + 512); ATT_SBAR(); } } while (0)
#define AP_VRD2(j) do { vlo[(j) & 3] = vtr(vp_ + (((j) & 3) * 4096 + ((j) >> 2) * 1024)); vhi[(j) & 3] = vtr(vp_ + (((j) & 3) * 4096 + ((j) >> 2) * 1024 + 512)); } while (0)
#define AP_KRD(G, j) do { if (G) { kf[2 * (j)] = *(const LAS bf16x8*)(kpd[j] + sl_next * KSLOT); kf[2 * (j) + 1] = *(const LAS bf16x8*)(kpd[j] + sl_next * KSLOT + 4096); ATT_SBAR(); } } while (0)
#if ATT_TIMING >= 3
#define AP_STAMP(v) do { asm volatile("s_memtime %0\n\ts_waitcnt lgkmcnt(0)" : "=s"(v) :: "memory"); ATT_SBAR(); } while (0)
#else
#define AP_STAMP(v) do { } while (0)
#endif
#define AP_MF(D, A, B, C) D = __builtin_amdgcn_mfma_f32_32x32x16_bf16(A, B, C, 0, 0, 0)
#define AP_QK0(D, A, B) asm volatile("v_mfma_f32_32x32x16_bf16 %0, %1, %2, 0" : "=&v"(D) : "v"(A), "v"(B))
#define AP_QK(D, A, B)  asm volatile("v_mfma_f32_32x32x16_bf16 %0, %1, %2, %0" : "+v"(D) : "v"(A), "v"(B))
#define AP_STEP(C0, C1, P0, P1, t, GK, GV, GL) do { ATT_SBAR(); AP_STAMP(ts0_); \
    const lds_cptr vp_ = vp0 + sl_prev * VSLOT; \
    AP_VRD_A(0); AP_VRD_G(0); float sacc = (P0[0] + P0[1]); \
    AP_GAPA(AP_QK0(C0, kf[0], qr[0]), P0[2], P0[3], P0[4], P0[5],     pw0[0] = AP_PKW(P0, 0),  pw0[1] = AP_PKW(P0, 2),  pw0); \
    AP_VRD_A(4); AP_VRD_G(1); AP_GAPA(AP_QK0(C1, kf[1], qr[0]), P0[6], P0[7], P0[8], P0[9],     pw0[2] = AP_PKW(P0, 4),  pw0[3] = AP_PKW(P0, 6),  pw0); \
    AP_VRD_A(1); AP_VRD_G(2); AP_GAPA(AP_QK(C0, kf[2], qr[1]),     P0[10], P0[11], P0[12], P0[13], pw1[0] = AP_PKW(P0, 8),  pw1[1] = AP_PKW(P0, 10), pw1); \
    AP_VRD_A(5); AP_VRD_G(3); AP_GAPA(AP_QK(C1, kf[3], qr[1]),     P0[14], P0[15], P1[0], P1[1],   pw1[2] = AP_PKW(P0, 12), pw1[3] = AP_PKW(P0, 14), pw1); \
    AP_VRD_A(2); AP_VRD_G(4); AP_GAPA(AP_QK(C0, kf[4], qr[2]),     P1[2], P1[3], P1[4], P1[5],     pw2[0] = AP_PKW(P1, 0),  pw2[1] = AP_PKW(P1, 2),  pw2); \
    AP_VRD_A(6); AP_VRD_G(5); AP_GAPA(AP_QK(C1, kf[5], qr[2]),     P1[6], P1[7], P1[8], P1[9],     pw2[2] = AP_PKW(P1, 4),  pw2[3] = AP_PKW(P1, 6),  pw2); \
    AP_VRD_A(3); AP_VRD_G(6); AP_GAPA(AP_QK(C0, kf[6], qr[3]),     P1[10], P1[11], P1[12], P1[13], pw3[0] = AP_PKW(P1, 8),  pw3[1] = AP_PKW(P1, 10), pw3); \
    AP_VRD_A(7); AP_VRD_G(7); AP_GAPA(AP_QK(C1, kf[7], qr[3]),     P1[14], P1[15], 0.f, 0.f,       pw3[2] = AP_PKW(P1, 12), pw3[3] = AP_PKW(P1, 14), pw3); \
    l_reg += sacc; AP_STAMP(ts1_); att_tA += ts1_ - ts0_; \
    if (GK) { AP_DMA_K((t) + 3, sl_cur); } if (GV) { AP_DMA_V((t) + 1, sl_next); } \
    AP_MASK(C0, C1, t); \
    ATT_SBAR(); \
    if constexpr (NV == 1) { \
        AP_GAPB4(AP_MF(o[0], AP_PAF(0), AP_VFR(0), o[0]), C0, 0); \
        AP_GAPB4(AP_MF(o[1], AP_PAF(0), AP_VFR(4), o[1]), C0, 4); \
        AP_KRD(GL, 0); AP_GAPB4(AP_MF(o[0], AP_PAF(1), AP_VFR(1), o[0]), C0, 8); \
        AP_KRD(GL, 1); AP_GAPB4(AP_MF(o[1], AP_PAF(1), AP_VFR(5), o[1]), C0, 12); \
        AP_KRD(GL, 2); AP_GAPB4(AP_MF(o[0], AP_PAF(2), AP_VFR(2), o[0]), C1, 0); \
        AP_KRD(GL, 3); AP_GAPB4(AP_MF(o[1], AP_PAF(2), AP_VFR(6), o[1]), C1, 4); \
        AP_GAPB4(AP_MF(o[0], AP_PAF(3), AP_VFR(3), o[0]), C1, 8); \
        AP_GAPB4(AP_MF(o[1], AP_PAF(3), AP_VFR(7), o[1]), C1, 12); \
    } else { \
        AP_VRD2(3); ATT_SBAR(); AP_GAPB2(AP_MF(o[0], AP_PAF(0), AP_VFR(0), o[0]), C0, 0); \
        AP_VRD2(4); ATT_SBAR(); AP_GAPB2(AP_MF(o[1], AP_PAF(0), AP_VFR(1), o[1]), C0, 2); \
        AP_VRD2(5); ATT_SBAR(); AP_GAPB2(AP_MF(o[2], AP_PAF(0), AP_VFR(2), o[2]), C0, 4); \
        AP_VRD2(6); ATT_SBAR(); AP_GAPB2(AP_MF(o[3], AP_PAF(0), AP_VFR(3), o[3]), C0, 6); \
        AP_VRD2(7); ATT_SBAR(); AP_KRD(GL, 0); AP_GAPB2(AP_MF(o[0], AP_PAF(1), AP_VFR(0), o[0]), C0, 8); \
        AP_VRD2(8); ATT_SBAR(); AP_GAPB2(AP_MF(o[1], AP_PAF(1), AP_VFR(1), o[1]), C0, 10); \
        AP_VRD2(9); ATT_SBAR(); AP_KRD(GL, 1); AP_GAPB2(AP_MF(o[2], AP_PAF(1), AP_VFR(2), o[2]), C0, 12); \
        AP_VRD2(10); ATT_SBAR(); AP_GAPB2(AP_MF(o[3], AP_PAF(1), AP_VFR(3), o[3]), C0, 14); \
        AP_VRD2(11); ATT_SBAR(); AP_KRD(GL, 2); AP_GAPB2(AP_MF(o[0], AP_PAF(2), AP_VFR(0), o[0]), C1, 0); \
        AP_VRD2(12); ATT_SBAR(); AP_GAPB2(AP_MF(o[1], AP_PAF(2), AP_VFR(1), o[1]), C1, 2); \
        AP_VRD2(13); ATT_SBAR(); AP_KRD(GL, 3); AP_GAPB2(AP_MF(o[2], AP_PAF(2), AP_VFR(2), o[2]), C1, 4); \
        AP_VRD2(14); ATT_SBAR(); AP_GAPB2(AP_MF(o[3], AP_PAF(2), AP_VFR(3), o[3]), C1, 6); \
        AP_VRD2(15); ATT_SBAR(); AP_GAPB2(AP_MF(o[0], AP_PAF(3), AP_VFR(0), o[0]), C1, 8); \
        AP_GAPB2(AP_MF(o[1], AP_PAF(3), AP_VFR(1), o[1]), C1, 10); \
        AP_GAPB2(AP_MF(o[2], AP_PAF(3), AP_VFR(2), o[2]), C1, 12); \
        AP_GAPB2(AP_MF(o[3], AP_PAF(3), AP_VFR(3), o[3]), C1, 14); \
    } } while (0)
    int t = 1;
    for (; t + 5 < NT; t += 2) {
        AP_STEP(pB0, pB1, pA0, pA1, t, true, true, true);     AP_WAITBAR_STEADY(); AP_ROT();
        AP_STEP(pA0, pA1, pB0, pB1, t + 1, true, true, true); AP_WAITBAR_STEADY(); AP_ROT();
    }
#define AP_ENDW(tt) do { if ((tt) + 3 < NT) { AP_WAITBAR_STEADY(); } else if ((tt) + 2 < NT) { AP_WAITBAR_VONLY(); } else { ATT_WAITBAR(0); } } while (0)
    for (; t + 1 < NT; t += 2) {
        AP_STEP(pB0, pB1, pA0, pA1, t, (t + 3 < NT), (t + 1 < NT), (t + 1 < NT));         AP_ENDW(t);     AP_ROT();
        AP_STEP(pA0, pA1, pB0, pB1, t + 1, (t + 4 < NT), (t + 2 < NT), (t + 2 < NT));     AP_ENDW(t + 1); AP_ROT();
    }
    AP_STEP(pB0, pB1, pA0, pA1, NT - 1, false, false, false);
    {
        float sacc = 0.f;
#pragma unroll
        for (int r = 0; r < 16; ++r) sacc += pB0[r] + pB1[r];
        l_reg += sacc;
        pw0 = (u32x4){AP_PKW(pB0, 0), AP_PKW(pB0, 2), AP_PKW(pB0, 4), AP_PKW(pB0, 6)}; pw1 = (u32x4){AP_PKW(pB0, 8), AP_PKW(pB0, 10), AP_PKW(pB0, 12), AP_PKW(pB0, 14)};
        pw2 = (u32x4){AP_PKW(pB1, 0), AP_PKW(pB1, 2), AP_PKW(pB1, 4), AP_PKW(pB1, 6)}; pw3 = (u32x4){AP_PKW(pB1, 8), AP_PKW(pB1, 10), AP_PKW(pB1, 12), AP_PKW(pB1, 14)};
        ATT_SBAR();
        const lds_cptr vp = vp0 + sl_cur * VSLOT;
#pragma unroll
        for (int d0 = 0; d0 < DV / 32; ++d0) {
            s16x4 lo[4], hh[4];
#pragma unroll
            for (int ks = 0; ks < 4; ++ks) { lo[ks] = vtr(vp + d0 * 4096 + ks * 1024); hh[ks] = vtr(vp + d0 * 4096 + ks * 1024 + 512); }
#define AP_PK(k) (bf16x8){lo[k][0], lo[k][1], lo[k][2], lo[k][3], hh[k][0], hh[k][1], hh[k][2], hh[k][3]}
            o[d0] = __builtin_amdgcn_mfma_f32_32x32x16_bf16(AP_PAF(0), AP_PK(0), o[d0], 0, 0, 0);
            o[d0] = __builtin_amdgcn_mfma_f32_32x32x16_bf16(AP_PAF(1), AP_PK(1), o[d0], 0, 0, 0);
            o[d0] = __builtin_amdgcn_mfma_f32_32x32x16_bf16(AP_PAF(2), AP_PK(2), o[d0], 0, 0, 0);
            o[d0] = __builtin_amdgcn_mfma_f32_32x32x16_bf16(AP_PAF(3), AP_PK(3), o[d0], 0, 0, 0);
#undef AP_PK
            ATT_SBAR();
        }
    }
    l_out = l_reg;
    asm volatile("s_waitcnt lgkmcnt(0)\n\ts_barrier" ::: "memory");
#if ATT_TIMING
    if (lane == 0 && NT > 100) { const unsigned long long att_t1 = __builtin_amdgcn_s_memtime(); atomicAdd(att_tm + (NV - 1) * 2, (ATT_TIMING >= 3) ? att_tA : att_twait); atomicAdd(att_tm + (NV - 1) * 2 + 1, att_t1 - att_t0); }
#endif
#undef AP_TILE
#undef AP_DMA_K
#undef AP_DMA_V
#undef AP_WAITBAR_STEADY
#undef AP_WAITBAR_VONLY
#undef AP_MASK
#undef AP_ROT
#undef AP_PKW
#undef AP_PAF
#undef AP_VFR
#undef AP_PIN
#undef AP_GAPA
#undef AP_EX
#undef AP_GAPB4
#undef AP_GAPB2
#undef AP_VRD
#undef AP_VRD_A
#undef AP_VRD_G
#undef AP_VRD2
#undef AP_KRD
#undef AP_MF
#undef AP_STAMP
#undef AP_QK0
#undef AP_QK
#undef AP_STEP
#undef AP_ENDW
}
typedef int v8i __attribute__((ext_vector_type(8)));
template <int DV>
__device__ __forceinline__ void attn_f8(f32x16 (&o)[DV / 32], f32x16& ol, const unsigned char* Qw8, const unsigned char* Kb8, const unsigned char* Vt8,
                                        int t0, int n1, int masked, int qpos, LAS unsigned char* lds, int wid, int lane, unsigned long long* att_tm = nullptr) {
    constexpr int NS = 3, NSL = 2 * NS;
    constexpr int KSLOT = 4096, VSLOT = DV * 64, LV = NSL * KSLOT, ND = DV / 32;
    unsigned long long att_twait = 0, att_tA = 0, tsa_ = 0, tsb_ = 0; (void)att_twait; (void)att_tm; (void)att_tA; (void)tsa_; (void)tsb_;
#if ATT_TIMING
    const unsigned long long att_t0 = __builtin_amdgcn_s_memtime();
#endif
#if ATT_TIMING >= 3
#define AF_STAMP(v) do { asm volatile("s_memtime %0\n\ts_waitcnt lgkmcnt(0)" : "=s"(v) :: "memory"); ATT_SBAR(); } while (0)
#else
#define AF_STAMP(v) do { } while (0)
#endif
#ifndef ATT_SEG
#define ATT_SEG 1
#endif
    const int r32 = lane & 31, hi = lane >> 5, NT = n1 + 4;
    const unsigned lds0 = (unsigned)(unsigned long)lds;
    const char* Kbu = (const char*)uniform_ptr(Kb8); const char* Vbu = (const char*)uniform_ptr(Vt8);
    const int kpi = wid & 3, vpi = (DV == 128) ? wid : (wid & 3);
    const bool do_k = wid < 4, do_v = (DV == 128) || wid >= 4;
    const int prow = lane >> 2, ppos = lane & 3;
    const unsigned koff = (unsigned)((16 * kpi + prow) * 64 + ((ppos ^ (((16 * kpi + prow) >> 2) & 3)) * 16));
    const unsigned voff = (unsigned)((16 * vpi + prow) * 64 + ((ppos ^ (((16 * vpi + prow) >> 2) & 3)) * 16));
    const unsigned kdst = lds0 + kpi * 1024, vdst = lds0 + LV + vpi * 1024;
#define AF_TILE(i_) ((i_) < n1 ? t0 + (i_) : 256 + (i_) - n1)
#define AF_DMA_K(t_, sl_) if (do_k) glds16s(koff, Kbu + (size_t)AF_TILE(t_) * 4096, (unsigned)__builtin_amdgcn_readfirstlane(kdst + (sl_) * KSLOT))
#define AF_DMA_V(t_, sl_) if (do_v) glds16s(voff, Vbu + (size_t)AF_TILE(t_) * (DV * 64), (unsigned)__builtin_amdgcn_readfirstlane(vdst + (sl_) * VSLOT))
#define AF_MASK(C0_, C1_, t_) do { if (masked) { const int tl__ = AF_TILE(t_); if (tl__ < 256) { asm volatile("s_nop 15\n\ts_nop 15" : "+v"(C0_), "+v"(C1_)); const int kb__ = 64 * tl__ + 4 * hi - (qpos + r32) + 128; \
        _Pragma("unroll") for (int r = 0; r < 16; ++r) { const int kv = kb__ + (r & 3) + 8 * (r >> 2); if ((unsigned)kv > 256u) C0_[r] = -INFINITY; if ((unsigned)(kv + 32) > 256u) C1_[r] = -INFINITY; } } } } while (0)
    const lds_cptr lds3 = (lds_cptr)lds;
    const lds_cptr fa0 = lds3 + r32 * 64 + (((2 * hi) ^ ((r32 >> 2) & 3)) * 16), fa1 = lds3 + r32 * 64 + (((2 * hi + 1) ^ ((r32 >> 2) & 3)) * 16);
#define AF_FRAG(off_) __builtin_bit_cast(v8i, (u32x4x2){*(const LAS u32x4*)(fa0 + (off_)), *(const LAS u32x4*)(fa1 + (off_))})
    struct u32x4x2 { u32x4 a, b; };
    AF_DMA_K(0, 0); AF_DMA_V(0, 0);
#pragma unroll
    for (int j = 1; j <= NS + 1; ++j) if (j < NT) AF_DMA_K(j, j);
#pragma unroll
    for (int j = 1; j < NS; ++j) AF_DMA_V(j, j);
    const v8i qf = __builtin_bit_cast(v8i, (u32x4x2){*(const u32x4*)(Qw8 + (size_t)r32 * 64 + 32 * hi), *(const u32x4*)(Qw8 + (size_t)r32 * 64 + 32 * hi + 16)});
    ATT_WAITBAR(0);
    ol = f32x16{};
    const v8i ones8 = {0x38383838, 0x38383838, 0x38383838, 0x38383838, 0x38383838, 0x38383838, 0x38383838, 0x38383838};
    const int sc1 = 0x7F7F7F7F, scq = 0x7D7D7D7D;
    const f32x16 zero16 = {};
    f32x16 P0, P1;
    v8i kf0, kf1;
    {
        kf0 = AF_FRAG(0); kf1 = AF_FRAG(2048);
        P0 = __builtin_amdgcn_mfma_scale_f32_32x32x64_f8f6f4(kf0, qf, zero16, 0, 0, 0, sc1, 0, scq);
        P1 = __builtin_amdgcn_mfma_scale_f32_32x32x64_f8f6f4(kf1, qf, zero16, 0, 0, 0, sc1, 0, scq);
        AF_MASK(P0, P1, 0);
#pragma unroll
        for (int r = 0; r < 16; ++r) { P0[r] = __builtin_amdgcn_exp2f(P0[r]); P1[r] = __builtin_amdgcn_exp2f(P1[r]); }
    }
    kf0 = AF_FRAG(1 * KSLOT); kf1 = AF_FRAG(1 * KSLOT + 2048);
    asm volatile("s_waitcnt lgkmcnt(0)\n\ts_barrier" ::: "memory");
    int one4_ = 0x38383838; asm volatile("" : "+s"(one4_));
    v8i ones8r = {one4_, one4_, one4_, one4_, one4_, one4_, one4_, one4_}; asm volatile("" : "+v"(ones8r));
    v8i vfa, vfb, p8 = {};
#define AF_PIN(x) asm volatile("" : "+v"(x))
#define AF_CVT(w_, P, B) do { int w__ = __builtin_amdgcn_cvt_pk_bf8_f32(P[B], P[B + 1], p8[w_], false); w__ = __builtin_amdgcn_cvt_pk_bf8_f32(P[B + 2], P[B + 3], w__, true); p8[w_] = w__; } while (0)
#define AF_QK(D, A) asm volatile(AF_QKNOP "v_mfma_scale_f32_32x32x64_f8f6f4 %0, %1, %2, 0, %3, %4 op_sel_hi:[0,0,0]" : "=&v"(D) : "v"(A), "v"(qf), "v"(sc1), "v"(scq))
#define AF_P8() p8
#define AF_PV(d0_, VF) asm volatile("s_nop 1\n\tv_mfma_scale_f32_32x32x64_f8f6f4 %0, %1, %2, %0, %3, %3 op_sel_hi:[0,0,0] cbsz:1" : "+v"(o[d0_]) : "v"(p8), "v"(VF), "v"(sc1))
#define AF_PL() asm volatile("s_nop 1\n\tv_mfma_scale_f32_32x32x64_f8f6f4 %0, %1, %2, %0, %3, %3 op_sel_hi:[0,0,0] cbsz:1" : "+v"(ol) : "v"(p8), "v"(ones8r), "v"(sc1))
#define AF_PVn(d0_, VF) asm volatile(AF_PVNOP "v_mfma_scale_f32_32x32x64_f8f6f4 %0, %1, %2, %0, %3, %3 op_sel_hi:[0,0,0] cbsz:1" : "+v"(o[d0_]) : "v"(p8), "v"(VF), "v"(sc1))
#define AF_PLn() asm volatile(AF_PLNOP "v_mfma_scale_f32_32x32x64_f8f6f4 %0, %1, %2, %0, %3, %3 op_sel_hi:[0,0,0] cbsz:1" : "+v"(ol) : "v"(p8), "v"(ones8r), "v"(sc1))
#define AF_EXP(X, B, N) do { _Pragma("unroll") for (int e_ = 0; e_ < (N); ++e_) X[(B) + e_] = __builtin_amdgcn_exp2f(X[(B) + e_]); AF_PIN(X); ATT_SBAR(); } while (0)
#define AF_SUMPACK() do { \
        AF_CVT(0, P0, 0); AF_CVT(1, P0, 4); AF_CVT(2, P0, 8); AF_CVT(3, P0, 12); AF_CVT(4, P1, 0); AF_CVT(5, P1, 4); AF_CVT(6, P1, 8); AF_CVT(7, P1, 12); } while (0)
#define AF_SUB(t, GL_) do { \
        ATT_SBAR(); \
        const int vo_ = LV + (((t) - 1) % NSL) * VSLOT, kn_ = (((t) + 1) % NSL) * KSLOT; \
        vfa = AF_FRAG(vo_); vfb = AF_FRAG(vo_ + 2048); ATT_SBAR(); \
        AF_SUMPACK(); ATT_SBAR(); \
        AF_QK(P0, kf0); AF_QK(P1, kf1); \
        AF_MASK(P0, P1, t); \
        ATT_SBAR(); __builtin_amdgcn_s_setprio(1); \
        if constexpr (ND == 2) { \
            AF_PLn(); AF_PVn(0, vfa); AF_EXP(P0, 0, 16); \
            if (GL_) { kf0 = AF_FRAG(kn_); kf1 = AF_FRAG(kn_ + 2048); ATT_SBAR(); } \
            AF_PVn(1, vfb); AF_EXP(P1, 0, 16); \
        } else { \
            AF_PLn(); AF_PVn(0, vfa); vfa = AF_FRAG(vo_ + 4096); ATT_SBAR(); AF_EXP(P0, 0, 8); \
            AF_PVn(1, vfb); vfb = AF_FRAG(vo_ + 6144); ATT_SBAR(); AF_EXP(P0, 8, 8); \
            if (GL_) { kf0 = AF_FRAG(kn_); ATT_SBAR(); } \
            AF_PVn(2, vfa); AF_EXP(P1, 0, 8); \
            if (GL_) { kf1 = AF_FRAG(kn_ + 2048); ATT_SBAR(); } \
            AF_PVn(3, vfb); AF_EXP(P1, 8, 8); \
        } __builtin_amdgcn_s_setprio(0); } while (0)
    for (int t_ = 1; t_ < NT; t_ += NS) {
        int t = t_; asm volatile("" : "+s"(t));
#pragma unroll
        for (int j = 0; j < NS; ++j) { if (t + NS + 1 + j < NT) AF_DMA_K(t + NS + 1 + j, (t + NS + 1 + j) % NSL); if (t + NS - 1 + j < NT) AF_DMA_V(t + NS - 1 + j, (t + NS - 1 + j) % NSL); }
        AF_SUB(t, (t + 1 < NT));
#pragma unroll
        for (int j = 1; j < NS; ++j) { if (t + j < NT) { AF_SUB(t + j, (t + j + 1 < NT)); } }
        ATT_WAITBAR(0);
    }
    {
        AF_SUMPACK();
        ATT_SBAR();
        AF_PL();
        const int vo_ = LV + ((NT - 1) % NSL) * VSLOT;
#pragma unroll
        for (int d0 = 0; d0 < ND; ++d0) { vfa = AF_FRAG(vo_ + d0 * 2048); AF_PV(d0, vfa); ATT_SBAR(); }
        asm volatile("s_nop 15\n\ts_nop 15" ::: "memory");
    }
    asm volatile("s_waitcnt lgkmcnt(0)\n\ts_barrier" ::: "memory");
#if ATT_TIMING
    if (lane == 0 && NT > 100) { const unsigned long long att_t1 = __builtin_amdgcn_s_memtime(); atomicAdd(att_tm + (ND / 2 - 1 + (ND == 2 ? 0 : 0)) * 2, (ATT_TIMING >= 3) ? att_tA : att_twait); atomicAdd(att_tm + (ND / 2 - 1) * 2 + 1, att_t1 - att_t0); }
#endif
#undef AF_STAMP
#undef AF_TILE
#undef AF_DMA_K
#undef AF_DMA_V
#undef AF_MASK
#undef AF_FRAG
#undef AF_PIN
#undef AF_CVT
#undef AF_QK
#undef AF_P8
#undef AF_PV
#undef AF_PVn
#undef AF_PLn
#undef AF_PL
#undef AF_EXP
#undef AF_SUMPACK
#undef AF_SUB
}
__device__ __forceinline__ void row_inv(float (&rli)[16], float lsum, float extra, LAS float* wsf, int r32, int hi) {
    const float l = pg8::swap_sum32(lsum) + extra;
    LDS_WAIT();
    if (hi == 0) wsf[r32] = l;
    LDS_WAIT(); asm volatile("" ::: "memory");
#pragma unroll
    for (int r = 0; r < 16; ++r) rli[r] = __builtin_amdgcn_rcpf(wsf[crow(r, hi)]);
    LDS_WAIT(); asm volatile("" ::: "memory");
}
}

#ifndef DBG_NO_MOE
#define DBG_NO_MOE 0
#endif
#ifndef DBG_NO_MIX
#define DBG_NO_MIX 0
#endif
#ifndef DBG_AB
#define DBG_AB 0
#endif
#ifndef TPROBE
#define TPROBE -1
#endif
#ifndef REPEAT_MASK
#define E_REP1 1
#define E_REP2 1
#define TPBIN 25
#define E_ABL 0
#define E_GENERIC 0
#define E_MFMA 1
#define REPEAT_MASK 0
#endif
#define REP_BEGIN(c) for (int rep_ = 0; rep_ < (SKIP_ALL ? 0 : (((REPEAT_MASK >> (c)) & 1) ? 2 : 1)); ++rep_) {
#define REP_END }
#ifndef ATT_FN
#define ATT_FN attn_pipe
#endif
#ifndef PH_MASK
#define PH_MASK 0x3ff
#endif
#define PH_ON(i) ((PH_MASK >> (i)) & 1)
#ifndef SPREAD_PH
#define SPREAD_PH -1
#endif
#ifndef SKIP_ALL
#define SKIP_ALL 0
#endif
#ifndef ATT_VARIANT
#define ATT_VARIANT 0
#endif
struct Args { const float* in[28]; float* out; unsigned char* ws; int ph_lo, ph_hi; };
enum { I_X = 0, I_C, I_CTX, I_CCTX, I_WMOD, I_BMOD, I_NMIX, I_NFFN, I_WINAB, I_WOUTAB, I_QNA, I_KNA, I_SINKA, I_QNB, I_KNB, I_WINC, I_WOUTC, I_QNC, I_KNC, I_LAMC, I_SUBLN,
       I_WGRP, I_BGRP, I_WEXP, I_BEXP, I_W1, I_W3, I_W2 };

__global__ void __launch_bounds__(NTHREADS, 2) mega(Args args) {
    extern __shared__ __attribute__((aligned(16))) unsigned char lds_[];
    LAS unsigned char* lds = (LAS unsigned char*)lds_;
    volatile LAS unsigned* MISC = (volatile LAS unsigned*)(lds + MISC_OFF);
    const int tid0 = threadIdx.x;
    const int G = gridDim.x, bx = blockIdx.x;
    const int vcu = (G % 8 == 0) ? (bx % 8) * (G / 8) + bx / 8 : bx;
    const int NGW = G * NWAVES;
#define PHASE_IDS() int tid = tid0; asm volatile("" : "+v"(tid)); const int lane = tid & 63, wave = __builtin_amdgcn_readfirstlane(tid >> 6), gw = vcu * NWAVES + wave; (void)lane; (void)wave; (void)gw
    unsigned char* ws = args.ws;
    unsigned* ctl = (unsigned*)(ws + WS_CTL);
    float* mod = (float*)(ws + WS_MOD); float* modc = mod + DEPTH * 6144;
    float* rope = (float*)(ws + WS_ROPE);
    float* xcur = (float*)(ws + WS_XCUR);
    bf16* HB = (bf16*)(ws + WS_HB); bf16* QKV = (bf16*)(ws + WS_QKV); bf16* OB = (bf16*)(ws + WS_OB); float* O1S = (float*)(ws + WS_O1S);
    bf16* XG = (bf16*)(ws + WS_XG); bf16* HG = (bf16*)(ws + WS_HG); bf16* YG = (bf16*)(ws + WS_YG);
    int* tok_e = (int*)(ws + WS_ROUTE + RT_TOKE); int* tok_p = (int*)(ws + WS_ROUTE + RT_TOKP); float* tok_w = (float*)(ws + WS_ROUTE + RT_TOKW);
    int* drow = (int*)(ws + WS_ROUTE + RT_DROW); float* rw = (float*)(ws + WS_ROUTE + RT_RW); int* tile_e = (int*)(ws + WS_ROUTE + RT_TILE); int* ntl = (int*)(ws + WS_ROUTE + RT_NT);

    for (int u = tid0; u < (LDS_BYTES - LDSCTL_OFF) / 4; u += NTHREADS) ((LAS unsigned*)(lds + LDSCTL_OFF))[u] = 0u;
    __syncthreads();
    const int ph_lo = args.ph_lo, ph_hi = args.ph_hi;
    XcdBarrier bar; bar.bar = ctl + CW_BAR; bar.x = 0; bar.st = nullptr;
    if (ph_hi - ph_lo > 1) bar = xcd_barrier_post(ctl + CW_BAR, MISC + 8);
#if TPROBE >= 0
    unsigned long long* tms = (unsigned long long*)(ws + WS_CTL + 262144);
    if (bx == 0 && tid0 == 0) { const unsigned long long t0_ = __builtin_amdgcn_s_memrealtime(); MISC[16] = (unsigned)t0_; MISC[17] = (unsigned)(t0_ >> 32); }
#define TSTAMP(cls) do { if (bx == 0 && tid0 == 0) { const unsigned long long now_ = __builtin_amdgcn_s_memrealtime(); const unsigned long long prev_ = ((unsigned long long)MISC[17] << 32) | MISC[16]; \
        tms[cls] += now_ - prev_; MISC[16] = (unsigned)now_; MISC[17] = (unsigned)(now_ >> 32); } } while (0)
#else
#define TSTAMP(cls) do { } while (0)
#endif
#define IN(k) (ph_lo <= (k) && (k) < ph_hi)
#define SEAM(k) do { if (IN(k) && IN((k) + 1)) xcd_barrier(bar); } while (0)

    if (IN(0)) { if (!PH_ON(0)) __builtin_trap(); asm volatile("; MARK_PHASE p0" ::: "memory"); PHASE_IDS(); REP_BEGIN(0)
        {
            LAS float* sc = (LAS float*)lds; LAS float* scc = sc + 1024; LAS float* red = scc + 1024;
            for (int k = tid; k < 1024; k += NTHREADS) { const float a = args.in[I_C][k], b = args.in[I_CCTX][k];
                sc[k] = a / (1.f + __expf(-a)); scc[k] = b / (1.f + __expf(-b)); }
            __syncthreads();
            for (int it = bx; it < DEPTH * 96; it += G) {
                const int l = it / 96, col = (it % 96) * 64 + lane;
                const float* w = args.in[I_WMOD] + (size_t)l * 1024 * 6144 + col;
                float a0 = 0.f, a1 = 0.f;
#pragma unroll 32
                for (int kk = 0; kk < 128; ++kk) { const int k = wave * 128 + kk; const float wv = w[(size_t)k * 6144]; a0 += sc[k] * wv; a1 += scc[k] * wv; }
                red[wave * 64 + lane] = a0; red[512 + wave * 64 + lane] = a1;
                __syncthreads();
                if (wave < 2) { float s = 0.f;
#pragma unroll
                    for (int w8 = 0; w8 < 8; ++w8) s += red[wave * 512 + w8 * 64 + lane];
                    s += args.in[I_BMOD][l * 6144 + col];
                    (wave == 0 ? mod : modc)[l * 6144 + col] = s; }
                __syncthreads();
            }
        }
        for (int idx = bx * NTHREADS + tid; idx < 320 * 16; idx += G * NTHREADS) {
            const int t = idx >> 4, j = idx & 15; const float pos = (float)(t < 256 ? t : t - 256);
            const float inv = exp2f(-(float)j * (13.287712379549449f / 16.f));
            const float ang = pos * inv, rev = ang * 0.15915494309189535f, fr = rev - rintf(rev);
            const float cs = __builtin_amdgcn_cosf(fr), sn = __builtin_amdgcn_sinf(fr);
            if (t < 256) { rope[t * 16 + j] = cs; rope[4096 + t * 16 + j] = sn; } else { rope[8192 + (t - 256) * 16 + j] = cs; rope[9216 + (t - 256) * 16 + j] = sn; }
        }
        { float* wtr = (float*)(ws + WS_ROUTE + RT_WTR);
          for (int idx = bx * NTHREADS + tid; idx < DEPTH * 36 * 1024; idx += G * NTHREADS) { const int ll = idx / 36864, o = (idx >> 10) % 36, k = idx & 1023;
              wtr[idx] = (o < 4) ? args.in[I_WGRP][((size_t)ll * 1024 + k) * 4 + o] : args.in[I_WEXP][((size_t)ll * 1024 + k) * 32 + (o - 4)]; } }
        {
            LAS float* scr = (LAS float*)(lds + wave * 16384);
            constexpr int N_INAB = 2 * 16 * 48, N_INC = 2 * 16 * 96, N_OUT = 2 * 16 * 32, N_W13 = DEPTH * NEXP * 16 * 32, N_W2 = DEPTH * NEXP * 8 * 32;
            constexpr int NITEMS = N_INAB + N_INC + 2 * N_OUT + N_W13 + N_W2;
            for (int it = gw; it < NITEMS; it += NGW) {
                int r = it;
                if (r < N_INAB) { const int i = r / (16 * 48), q = r % (16 * 48), kb = q / 48, nb = q % 48, pin = (nb * 32) & 255, pn = (nb * 32) >> 8, bj = pin >> 7, wc = (pin & 127) >> 5;
#if FP8_B
                    transpose_item8(args.in[I_WINAB] + (size_t)i * 1024 * 1536, 1536, (4 * pn + wc) * 64 + bj * 32, (unsigned char*)(ws + WS_BT_INAB) + (size_t)i * 1536 * 1024, 1024, nb * 32, kb * 64, scr, lane); continue; }
#else
                    transpose_item(args.in[I_WINAB] + (size_t)i * 1024 * 1536, 1536, (4 * pn + wc) * 64 + bj * 32, (bf16*)(ws + WS_BT_INAB) + (size_t)i * 1536 * 1024, 1024, nb * 32, kb * 64, scr, lane); continue; }
#endif
                r -= N_INAB;
                if (r < N_INC) { const int i = r / (16 * 96), q = r % (16 * 96), kb = q / 96, nb = q % 96, pin = (nb * 32) & 255, pn = (nb * 32) >> 8, bj = pin >> 7, wc = (pin & 127) >> 5;
#if FP8_B
                    transpose_item8(args.in[I_WINC] + (size_t)i * 1024 * 3072, 3072, (4 * pn + wc) * 64 + bj * 32, (unsigned char*)(ws + WS_BT_INC) + (size_t)i * 3072 * 1024, 1024, nb * 32, kb * 64, scr, lane); continue; }
#else
                    transpose_item(args.in[I_WINC] + (size_t)i * 1024 * 3072, 3072, (4 * pn + wc) * 64 + bj * 32, (bf16*)(ws + WS_BT_INC) + (size_t)i * 3072 * 1024, 1024, nb * 32, kb * 64, scr, lane); continue; }
#endif
                r -= N_INC;
                if (r < N_OUT) { const int i = r / (16 * 32), q = r % (16 * 32), kb = q / 32, nb = q % 32;
                    transpose_item(args.in[I_WOUTAB] + (size_t)i * 1024 * 1024, 1024, nb * 32, (bf16*)(ws + WS_BT_OUTAB) + (size_t)i * 1024 * 1024, 1024, nb * 32, kb * 64, scr, lane); continue; }
                r -= N_OUT;
                if (r < N_OUT) { const int i = r / (16 * 32), q = r % (16 * 32), kb = q / 32, nb = q % 32;
                    transpose_item(args.in[I_WOUTC] + (size_t)i * 1024 * 1024, 1024, nb * 32, (bf16*)(ws + WS_BT_OUTC) + (size_t)i * 1024 * 1024, 1024, nb * 32, kb * 64, scr, lane); continue; }
                r -= N_OUT;
                if (r < N_W13) { const int le = r / (16 * 32), q = r % (16 * 32), kb = q / 32, nb = q % 32, pin = (nb * 32) & 255, pn = (nb * 32) >> 8, bj = pin >> 7, wc = (pin & 127) >> 5;
#if FP8_G
                    transpose_item8(args.in[bj ? I_W3 : I_W1] + (size_t)le * 1024 * 512, 512, pn * 128 + wc * 32, (unsigned char*)(ws + WS_BT_W13) + (size_t)le * 1024 * 1024, 1024, nb * 32, kb * 64, scr, lane); continue; }
#else
                    transpose_item(args.in[bj ? I_W3 : I_W1] + (size_t)le * 1024 * 512, 512, pn * 128 + wc * 32, (bf16*)(ws + WS_BT_W13) + (size_t)le * 1024 * 1024, 1024, nb * 32, kb * 64, scr, lane); continue; }
#endif
                r -= N_W13;
                { const int le = r / (8 * 32), q = r % (8 * 32), kb = q / 32, nb = q % 32;
#if FP8_H
                    transpose_item8(args.in[I_W2] + (size_t)le * 512 * 1024, 1024, nb * 32, (unsigned char*)(ws + WS_BT_W2) + (size_t)le * 1024 * 512, 512, nb * 32, kb * 64, scr, lane); }
#else
                    transpose_item(args.in[I_W2] + (size_t)le * 512 * 1024, 1024, nb * 32, (bf16*)(ws + WS_BT_W2) + (size_t)le * 1024 * 512, 512, nb * 32, kb * 64, scr, lane); }
#endif
            }
        }
        __syncthreads();
    REP_END }
    SEAM(0); TSTAMP(0);

    for (int l = 0; l < DEPTH; ++l) {
        const int pb = 1 + 8 * l, li = l >> 1;
        const bool isC = (l & 1) != 0, last = (l == DEPTH - 1);
        const float* modl = mod + l * 6144; const float* modcl = modc + l * 6144;
        const int mrows = last ? SEQ : MT;

        if (IN(pb + 0)) { if (!PH_ON(1)) __builtin_trap(); asm volatile("; MARK_PHASE pb+0" ::: "memory"); PHASE_IDS(); REP_BEGIN(1)
            const float* gmix = args.in[I_NMIX] + l * 1024;
            int mstart = gw;
            if (NGW == 2048) {
                const bool comb = l > 0 && rep_ == 0 && !((DBG_NO_MOE >> (l > 0 ? l - 1 : 0)) & 1);
                int dj = 0;
                if (comb && lane < 16) dj = drow[2 * (gw + 2048 * (lane >> 1)) + (lane & 1)];
                f32x4 gn[4], sh[4], sc[4], gt[4];
#pragma unroll
                for (int j = 0; j < 4; ++j) { const int c0 = 4 * lane + 256 * j; gn[j] = *(const f32x4*)(gmix + c0); sh[j] = *(const f32x4*)(modl + c0); sc[j] = *(const f32x4*)(modl + 1024 + c0);
                    gt[j] = comb ? *(const f32x4*)(mod + (l - 1) * 6144 + 5 * 1024 + c0) : (f32x4){0.f, 0.f, 0.f, 0.f}; }
                const float* srcb = (l == 0 ? args.in[I_X] : xcur) + (size_t)gw * 1024 + 4 * lane;
                f32x4 xv[2][4]; u32x2 y0[2][4], y1[2][4];
#define A_ISSUE(it, b) { _Pragma("unroll") for (int j = 0; j < 4; ++j) xv[b][j] = *(const f32x4*)(srcb + (size_t)2048 * 1024 * (it) + 256 * j); \
                    if (comb) { const int d0 = __builtin_amdgcn_readlane(dj, 2 * (it)), d1 = __builtin_amdgcn_readlane(dj, 2 * (it) + 1); \
                        _Pragma("unroll") for (int j = 0; j < 4; ++j) { y0[b][j] = *(const u32x2*)(YG + (size_t)d0 * 1024 + 4 * lane + 256 * j); y1[b][j] = *(const u32x2*)(YG + (size_t)d1 * 1024 + 4 * lane + 256 * j); } } \
                    else { _Pragma("unroll") for (int j = 0; j < 4; ++j) { y0[b][j] = (u32x2){0u, 0u}; y1[b][j] = (u32x2){0u, 0u}; } } }
                A_ISSUE(0, 0)
#pragma unroll
                for (int it = 0; it < 8; ++it) { const int b = it & 1; const int m = gw + 2048 * it;
                    if (it + 1 < 8) { if (b) A_ISSUE(it + 1, 0) else A_ISSUE(it + 1, 1) }
                    asm volatile("" ::: "memory");
                    f32x4 v[4]; float ss = 0.f;
#pragma unroll
                    for (int j = 0; j < 4; ++j) { const u32x2 a0 = y0[b][j], a1 = y1[b][j];
                        v[j] = comb ? xv[b][j] + gt[j] * (f32x4){bflo(a0.x) + bflo(a1.x), bfhi(a0.x) + bfhi(a1.x), bflo(a0.y) + bflo(a1.y), bfhi(a0.y) + bfhi(a1.y)} : xv[b][j];
                        *(f32x4*)(xcur + (size_t)m * 1024 + 4 * lane + 256 * j) = v[j];
                        ss += (v[j][0] * v[j][0] + v[j][1] * v[j][1]) + (v[j][2] * v[j][2] + v[j][3] * v[j][3]); }
                    const float rstd = __builtin_amdgcn_rsqf(wave_sum(ss) * (1.f / 1024.f) + RMS_EPS);
#pragma unroll
                    for (int j = 0; j < 4; ++j) { const int c0 = 4 * lane + 256 * j; const f32x4 h = v[j] * rstd * gn[j] * (sc[j] + 1.f) + sh[j];
#if FP8_B
                        *(unsigned*)((unsigned char*)HB + (size_t)m * 1024 + c0) = pg8::pk4_e4m3(h[0], h[1], h[2], h[3]); }
#else
                        *(u32x2*)(HB + (size_t)m * 1024 + c0) = (u32x2){pkbf(h[0], h[1]), pkbf(h[2], h[3])}; }
#endif
                    asm volatile("" ::: "memory");
                }
#undef A_ISSUE
                mstart = gw + 2048 * 8;
            }
            for (int m = mstart; m < MT; m += NGW) {
                const bool isctx = m >= SEQ;
                const float* src = (l == 0) ? (isctx ? args.in[I_CTX] + (size_t)(m - SEQ) * 1024 : args.in[I_X] + (size_t)m * 1024) : xcur + (size_t)m * 1024;
                f32x4 v[4];
#pragma unroll
                for (int j = 0; j < 4; ++j) v[j] = *(const f32x4*)(src + 4 * lane + 256 * j);
                if (l > 0 && rep_ == 0 && !((DBG_NO_MOE >> (l - 1)) & 1)) {
                    const int d0 = drow[2 * m], d1 = drow[2 * m + 1];
                    const float* gate = (isctx ? modc : mod) + (l - 1) * 6144 + 5 * 1024;
#pragma unroll
                    for (int j = 0; j < 4; ++j) { const u32x2 y0 = *(const u32x2*)(YG + (size_t)d0 * 1024 + 4 * lane + 256 * j), y1 = *(const u32x2*)(YG + (size_t)d1 * 1024 + 4 * lane + 256 * j);
                        const f32x4 gt = *(const f32x4*)(gate + 4 * lane + 256 * j);
                        v[j] = v[j] + gt * (f32x4){bflo(y0.x) + bflo(y1.x), bfhi(y0.x) + bfhi(y1.x), bflo(y0.y) + bflo(y1.y), bfhi(y0.y) + bfhi(y1.y)}; }
                }
#pragma unroll
                for (int j = 0; j < 4; ++j) *(f32x4*)(xcur + (size_t)m * 1024 + 4 * lane + 256 * j) = v[j];
                float ss = 0.f;
#pragma unroll
                for (int j = 0; j < 4; ++j) ss += (v[j][0] * v[j][0] + v[j][1] * v[j][1]) + (v[j][2] * v[j][2] + v[j][3] * v[j][3]);
                const float rstd = __builtin_amdgcn_rsqf(wave_sum(ss) * (1.f / 1024.f) + RMS_EPS);
                const float* mm = isctx ? modcl : modl;
#pragma unroll
                for (int j = 0; j < 4; ++j) { const int c0 = 4 * lane + 256 * j; const f32x4 gn = *(const f32x4*)(gmix + c0), sh = *(const f32x4*)(mm + c0), scl = *(const f32x4*)(mm + 1024 + c0);
                    const f32x4 h = v[j] * rstd * gn * (scl + 1.f) + sh;
#if FP8_B
                    *(unsigned*)((unsigned char*)HB + (size_t)m * 1024 + c0) = pg8::pk4_e4m3(h[0], h[1], h[2], h[3]); }
#else
                    *(u32x2*)(HB + (size_t)m * 1024 + c0) = (u32x2){pkbf(h[0], h[1]), pkbf(h[2], h[3])}; }
#endif
            }
        REP_END }
        SEAM(pb + 0); TSTAMP(1);

        if (IN(pb + 1)) { if (!PH_ON(2)) __builtin_trap(); asm volatile("; MARK_PHASE pb+1" ::: "memory"); PHASE_IDS(); REP_BEGIN((isC ? 3 : 2))
            const int N = isC ? 3072 : 1536;
            constexpr size_t ESZ = FP8_B ? 1 : 2;
            pg8::Gemm g{HB, isC ? (const bf16*)(ws + WS_BT_INC + (size_t)li * 3072 * 1024 * ESZ) : (const bf16*)(ws + WS_BT_INAB + (size_t)li * 1536 * 1024 * ESZ), MT, N, 1024};
            pg8::StaticOrder S; S.init(MT, N, G, bx);
#if USE_FP8
            pg8::EpiQKV8 E{(unsigned char*)QKV, isC ? args.in[I_QNC] + li * 64 : args.in[I_QNA] + li * 64, isC ? args.in[I_KNC] + li * 64 : args.in[I_KNA] + li * 64,
                           args.in[I_QNB] + li * 64, args.in[I_KNB] + li * 64, rope, isC ? 1 : 0};
            pg8::gemm_phase<pg8::EpiQKV8, pg8::StaticOrder, true, true, FP8_B != 0>(lds, g, S, E);
#else
            pg8::EpiQKV E{QKV, isC ? args.in[I_QNC] + li * 64 : args.in[I_QNA] + li * 64, isC ? args.in[I_KNC] + li * 64 : args.in[I_KNA] + li * 64,
                          args.in[I_QNB] + li * 64, args.in[I_KNB] + li * 64, rope, isC ? 1 : 0};
            pg8::gemm_phase<pg8::EpiQKV, pg8::StaticOrder, true, true>(lds, g, S, E);
#endif
        REP_END }
        SEAM(pb + 1); TSTAMP(isC ? 3 : 2);

#if SPREAD_PH >= 0
        unsigned long long spr_t0 = __builtin_amdgcn_s_memrealtime();
#endif
        if (IN(pb + 2)) { if (!PH_ON(3)) __builtin_trap(); asm volatile("; MARK_PHASE pb+2" ::: "memory"); PHASE_IDS(); REP_BEGIN((isC ? 5 : 4))
            const int r32 = lane & 31, hi = lane >> 5;
            LAS float* wsf = (LAS float*)(lds + LDS_WSF) + wave * 32;
            if (!isC && ATT_VARIANT != 2) {
                LAS bf16* stg = (LAS bf16*)(lds + LDS_STAGE) + wave * 2048;
                for (int u = vcu; u < 1040; u += G) {
                    int head16, qt, t0, n1, masked, has_sink, kvslot, vslot, qslot;
                    if (u < 512) { const int h = u >> 6; qt = u & 63; head16 = 8 + h; t0 = 0; n1 = 256; masked = 0; has_sink = 0; qslot = 12 + h; kvslot = 20 + (h >> 2); vslot = 22 + (h >> 2); }
                    else if (u < 1024) { const int h = (u - 512) >> 6; qt = u & 63; head16 = h; t0 = (4 * qt - 2 > 0) ? 4 * qt - 2 : 0; const int t1 = (4 * qt + 6 < 256) ? 4 * qt + 6 : 256; n1 = t1 - t0;
                        masked = 1; has_sink = 1; qslot = h; kvslot = 8 + (h >> 2); vslot = 10 + (h >> 2); }
                    else { const int h16 = u - 1024; qt = 64; head16 = h16; t0 = 0; n1 = 0; masked = 0;
                        if (h16 < 8) { has_sink = 1; qslot = h16; kvslot = 8 + (h16 >> 2); vslot = 10 + (h16 >> 2); } else { const int h = h16 - 8; has_sink = 0; qslot = 12 + h; kvslot = 20 + (h >> 2); vslot = 22 + (h >> 2); } }
                    const int row0 = qt * 256 + wave * 32;
                    f32x16 o[2]; o[0] = f32x16{}; o[1] = f32x16{}; float lsum = 0.f; (void)lsum;
#if USE_FP8
                    f32x16 ol;
                    { const unsigned char* q8 = (const unsigned char*)QKV; const int vidx = (vslot < 12) ? vslot - 10 : vslot - 20;
                      att::attn_f8<64>(o, ol, q8 + (size_t)qslot * pg8::E_SL8 + (size_t)row0 * 64, q8 + (size_t)kvslot * pg8::E_SL8, q8 + 24 * pg8::E_SL8 + (size_t)vidx * pg8::E_VT_AB,
                                       t0, n1, masked, row0, lds, wave, lane, (unsigned long long*)(ws + WS_CTL + 300000)); }
#else
                    att::ATT_FN<64>(o, lsum, QKV + (size_t)qslot * SLOT + (size_t)row0 * 64, QKV + (size_t)kvslot * SLOT, QKV + (size_t)vslot * SLOT, 64, t0, n1, masked, row0, lds, wave, lane, (unsigned long long*)(ws + WS_CTL + 300000));
#endif
                    const float extra = has_sink ? __builtin_amdgcn_exp2f(args.in[I_SINKA][li * 8 + (head16 & 7)] * LOG2E) : 0.f;
                    int ln = lane; asm volatile("" : "+v"(ln));
                    const int r32e = ln & 31, hie = ln >> 5;
                    float rli[16];
#if USE_FP8
#pragma unroll
                    for (int r = 0; r < 16; ++r) rli[r] = __builtin_amdgcn_rcpf(ol[r] + extra);
#else
                    att::row_inv(rli, lsum, extra, wsf, r32e, hie);
#endif
#pragma unroll
                    for (int r = 0; r < 16; ++r) { const int orow = att::crow(r, hie);
#pragma unroll
                        for (int d0 = 0; d0 < 2; ++d0) stg[orow * 64 + d0 * 32 + r32e] = ((DBG_AB == 1 && head16 < 8) || (DBG_AB == 2 && head16 >= 8) || (DBG_AB == 3 && u >= 1024)) ? (bf16)0 : (bf16)(pkbf(o[d0][r] * rli[r], 0.f) & 0xffffu); }
                    LDS_WAIT(); asm volatile("" ::: "memory");
                    bf16* Ow = OB + (size_t)row0 * 1024 + head16 * 64;
#pragma unroll
                    for (int i = 0; i < 4; ++i) { const int row = i * 8 + (ln >> 3), ch = ln & 7; const u32x4 vv = *(const LAS u32x4*)(stg + row * 64 + ch * 8); *(u32x4*)(Ow + (size_t)row * 1024 + ch * 8) = vv; }
                    LDS_WAIT(); asm volatile("" ::: "memory");
                }
            } else if (ATT_VARIANT != 1) {
                LAS bf16* stg = (LAS bf16*)(lds + LDS_STAGE) + wave * 4096;
                const float lam_init = 0.8f - 0.6f * __expf(-0.3f * (float)l);
                const float* lp = args.in[I_LAMC] + li * 256;
                const float lam = __expf(wave_sum(lp[lane] * lp[64 + lane])) - __expf(wave_sum(lp[128 + lane] * lp[192 + lane])) + lam_init;
                const float* subln = args.in[I_SUBLN] + li * 128;
                const int nunits = last ? 512 : 520;
                for (int u = vcu; u < nunits; u += G) {
                    int h, qt, n1;
                    if (u < 512) { h = u >> 6; qt = u & 63; n1 = 256; } else { h = u - 512; qt = 64; n1 = 0; }
                    const int row0 = qt * 256 + wave * 32;
                    const __amdgpu_buffer_rsrc_t o1rs = __builtin_amdgcn_make_buffer_rsrc((void*)(O1S + ((size_t)u * 8 + wave) * 4096), 0, 4096 * 4, 0x00020000);
                    f32x16 o[4]; float rli[16];
                    for (int comp = 0; comp < 2; ++comp) {
#pragma unroll
                        for (int d0 = 0; d0 < 4; ++d0) o[d0] = f32x16{};
                        float lsum = 0.f; (void)lsum;
#if USE_FP8
                        f32x16 ol;
                        { const unsigned char* q8 = (const unsigned char*)QKV;
                          att::attn_f8<128>(o, ol, q8 + (size_t)(2 * h + comp) * pg8::E_SL8 + (size_t)row0 * 64, q8 + (size_t)(16 + 2 * h + comp) * pg8::E_SL8, q8 + 32 * pg8::E_SL8 + (size_t)h * pg8::E_VT_C,
                                            0, n1, 0, 0, lds, wave, lane, (unsigned long long*)(ws + WS_CTL + 300000)); }
#else
                        att::ATT_FN<128>(o, lsum, QKV + (size_t)(2 * h + comp) * SLOT + (size_t)row0 * 64, QKV + (size_t)(16 + 2 * h + comp) * SLOT, QKV + (size_t)(32 + 2 * h) * SLOT, 128, 0, n1, 0, 0, lds, wave, lane, (unsigned long long*)(ws + WS_CTL + 300000));
#endif
#if USE_FP8
#pragma unroll
                        for (int r = 0; r < 16; ++r) rli[r] = __builtin_amdgcn_rcpf(ol[r]);
#else
                        { int l1 = lane; asm volatile("" : "+v"(l1)); att::row_inv(rli, lsum, 0.f, wsf, l1 & 31, l1 >> 5); }
#endif
                        if (comp == 0) {
                            int l0 = lane; asm volatile("" : "+v"(l0));
#pragma unroll
                            for (int d0 = 0; d0 < 4; ++d0) {
#pragma unroll
                                for (int r = 0; r < 16; ++r) __builtin_amdgcn_raw_buffer_store_b32(__builtin_bit_cast(unsigned, o[d0][r] * rli[r]), o1rs, l0 * 4, (d0 * 16 + r) * 256, 0);
                                asm volatile("" ::: "memory"); }
                        }
                    }
                    int ln = lane; asm volatile("" : "+v"(ln));
                    const int r32e = ln & 31, hie = ln >> 5;
                    float ssr[16];
#pragma unroll
                    for (int r = 0; r < 16; ++r) ssr[r] = 0.f;
#pragma unroll
                    for (int d0 = 0; d0 < 4; ++d0) {
#pragma unroll
                        for (int r = 0; r < 16; ++r) { const float vv = __builtin_bit_cast(float, __builtin_amdgcn_raw_buffer_load_b32(o1rs, ln * 4, (d0 * 16 + r) * 256, 0)) - lam * (o[d0][r] * rli[r]); o[d0][r] = vv; ssr[r] += vv * vv; }
                        asm volatile("" ::: "memory"); }
#pragma unroll
                    for (int r = 0; r < 16; ++r) { float s = dpp_sum16(ssr[r]); s += __shfl_xor(s, 16);
                        ssr[r] = __builtin_amdgcn_rsqf(s * (1.f / 128.f) + RMS_EPS) * (1.f - lam_init); }
#pragma unroll
                    for (int d0 = 0; d0 < 4; ++d0) { const float sg = subln[d0 * 32 + r32e];
#pragma unroll
                        for (int r = 0; r < 16; ++r) stg[att::crow(r, hie) * 128 + d0 * 32 + r32e] = (bf16)(pkbf(o[d0][r] * ssr[r] * sg, 0.f) & 0xffffu); }
                    LDS_WAIT(); asm volatile("" ::: "memory");
                    bf16* Ow = OB + (size_t)row0 * 1024 + h * 128;
#pragma unroll
                    for (int i = 0; i < 8; ++i) { const int row = i * 4 + (ln >> 4), ch = ln & 15; const u32x4 vv = *(const LAS u32x4*)(stg + row * 128 + ch * 8); *(u32x4*)(Ow + (size_t)row * 1024 + ch * 8) = vv; }
                    LDS_WAIT(); asm volatile("" ::: "memory");
                }
            }
            __syncthreads();
        REP_END }
#if SPREAD_PH >= 0
        if (tid0 == 0 && (isC ? 5 : 4) == SPREAD_PH) { const unsigned long long d_ = __builtin_amdgcn_s_memrealtime() - spr_t0; unsigned long long* sp = (unsigned long long*)(ws + WS_CTL + 400000);
            atomicAdd(sp, d_); atomicMax(sp + 1, d_); atomicAdd(sp + 2, 1ull); }
#endif
        SEAM(pb + 2); TSTAMP(isC ? 5 : 4);

        if (IN(pb + 3) && !((DBG_NO_MIX >> l) & 1)) { if (!PH_ON(4)) __builtin_trap(); asm volatile("; MARK_PHASE pb+3" ::: "memory"); PHASE_IDS(); REP_BEGIN(6)
            const bf16* WoT = isC ? (const bf16*)(ws + WS_BT_OUTC) + (size_t)li * 1024 * 1024 : (const bf16*)(ws + WS_BT_OUTAB) + (size_t)li * 1024 * 1024;
            int mD = mrows;
            if (G == 256 && mrows == MT) {
                const int rg = bx >> 4, cg = bx & 15, cb = wave & 3, kh = wave >> 2, n16 = lane & 15, kq = lane >> 4;
                const bf16* ap = OB + (size_t)(SEQ + 16 * rg + n16) * 1024 + 512 * kh + 8 * kq;
                const bf16* bp = WoT + (size_t)(64 * cg + 16 * cb + n16) * 1024 + 512 * kh + 8 * kq;
                bf16x8 av[16], bv[16];
#pragma unroll
                for (int q = 0; q < 16; ++q) { av[q] = *(const bf16x8*)(ap + 32 * q); bv[q] = *(const bf16x8*)(bp + 32 * q); }
                asm volatile("" ::: "memory");
                f32x4 dacc = {0.f, 0.f, 0.f, 0.f};
#pragma unroll
                for (int q = 0; q < 16; ++q) dacc = __builtin_amdgcn_mfma_f32_16x16x32_bf16(av[q], bv[q], dacc, 0, 0, 0);
                LAS f32x4* red = (LAS f32x4*)lds;
                if (kh) red[cb * 64 + lane] = dacc;
                __syncthreads();
                if (!kh) { dacc += red[cb * 64 + lane];
                    const int c = 64 * cg + 16 * cb + n16; const float gt = rep_ ? 0.f : modcl[2 * 1024 + c];
#pragma unroll
                    for (int i = 0; i < 4; ++i) { float* xp = xcur + (size_t)(SEQ + 16 * rg + 4 * kq + i) * 1024 + c; *xp = *xp + gt * dacc[i]; } }
                __syncthreads();
                mD = SEQ;
            }
            pg8::Gemm g{OB, WoT, mD, 1024, 1024};
            pg8::StaticOrder S; S.init(mD, 1024, G, bx);
            const float* zgate = (const float*)(ws + WS_CTL + 512 * 1024);
            pg8::EpiResid E{xcur, rep_ ? zgate : modl + 2 * 1024, rep_ ? zgate : modcl + 2 * 1024};
            pg8::gemm_phase<pg8::EpiResid, pg8::StaticOrder, true, true>(lds, g, S, E);
        REP_END }
        SEAM(pb + 3); TSTAMP(6);

        if (IN(pb + 4)) { if (!PH_ON(5)) __builtin_trap(); asm volatile("; MARK_PHASE pb+4" ::: "memory"); PHASE_IDS(); REP_BEGIN(7)
            const float* gffn = args.in[I_NFFN] + l * 1024;
            const float* wtr = (const float*)(ws + WS_ROUTE + RT_WTR) + (size_t)l * 36 * 1024;
            const float* bg = args.in[I_BGRP] + l * 4; const float* be = args.in[I_BEXP] + l * 32;
            LAS unsigned* lcnt = (LAS unsigned*)(lds + LDS_XCH + 512);
            if (tid < 32) lcnt[tid] = 0u;
#if E_MFMA
            constexpr int WPITCH = 1028;
            LAS float* wle = (LAS float*)(lds + LDS_RW); LAS float* wlg = wle + 32 * WPITCH;
            { const f32x4* wg4 = (const f32x4*)wtr + tid; f32x4 wv[18];
#pragma unroll
              for (int j = 0; j < 18; ++j) wv[j] = wg4[512 * j];
              asm volatile("" ::: "memory");
              const int c4 = tid & 255;
#pragma unroll
              for (int j = 0; j < 18; ++j) { const int o = (tid >> 8) + 2 * j;
                  if (j < 2) *(LAS f32x4*)(wlg + o * 1024 + 4 * c4) = wv[j];
                  else { const int e = o - 4, rho = 16 * ((e >> 2) & 1) + 4 * (e >> 3) + (e & 3); *(LAS f32x4*)(wle + rho * WPITCH + 4 * c4) = wv[j]; } }
              __syncthreads(); }
            LAS float* lc = (LAS float*)(lds + LDS_PAR); LAS float* lsh = lc + 1024;
            if (tid < 256) { const f32x4 g4 = *(const f32x4*)(gffn + 4 * tid), s4 = *(const f32x4*)(modl + 3 * 1024 + 4 * tid), c4v = *(const f32x4*)(modl + 4 * 1024 + 4 * tid);
                *(LAS f32x4*)(lc + 4 * tid) = g4 * (c4v + 1.f); *(LAS f32x4*)(lsh + 4 * tid) = s4; }
            __syncthreads();
            TSTAMP(11);
            const int n16 = lane & 15, kq = lane >> 4;
            if (G == 256) {
                if (mrows > SEQ && bx < 128) {
                    const int grp2 = lane >> 5, s32 = lane & 31;
                    const int m = SEQ + 2 * bx + grp2;
                    f32x4 t[8], gnv[8], shv[8], scv[8];
                    float ss = 0.f;
#pragma unroll
                    for (int jj = 0; jj < 8; ++jj) { const int c0 = 4 * s32 + 128 * jj; t[jj] = *(const f32x4*)(xcur + (size_t)m * 1024 + c0);
                        gnv[jj] = *(const f32x4*)(gffn + c0); shv[jj] = *(const f32x4*)(modcl + 3 * 1024 + c0); scv[jj] = *(const f32x4*)(modcl + 4 * 1024 + c0); }
                    asm volatile("" ::: "memory");
#pragma unroll
                    for (int jj = 0; jj < 8; ++jj) ss += (t[jj][0] * t[jj][0] + t[jj][1] * t[jj][1]) + (t[jj][2] * t[jj][2] + t[jj][3] * t[jj][3]);
                    ss = dpp_sum16(ss); ss += __shfl_xor(ss, 16);
                    const float rstd = __builtin_amdgcn_rsqf(ss * (1.f / 1024.f) + RMS_EPS);
#pragma unroll
                    for (int jj = 0; jj < 8; ++jj) { const int c0 = 4 * s32 + 128 * jj;
                        t[jj] = t[jj] * rstd * (gnv[jj] * (scv[jj] + 1.f)) + shv[jj];
                        if (wave == 0) {
#if FP8_G
                            *(unsigned*)((unsigned char*)HB + (size_t)m * 1024 + c0) = pg8::pk4_e4m3(t[jj][0], t[jj][1], t[jj][2], t[jj][3]);
#else
                            *(u32x2*)(HB + (size_t)m * 1024 + c0) = (u32x2){pkbf(t[jj][0], t[jj][1]), pkbf(t[jj][2], t[jj][3])};
#endif
                        } }
                    LAS float* accx = (LAS float*)(lds + LDS_XCH + 640);
                    const LAS float* wbase = wle + 4 * s32;
#pragma unroll 1
                    for (int op = wave; op < 18; op += 8) {
                        const int o = 2 * op, ea = o - 4, eb = o - 3;
                        const int ra = o < 4 ? 32 * WPITCH + o * 1024 : (16 * ((ea >> 2) & 1) + 4 * (ea >> 3) + (ea & 3)) * WPITCH;
                        const int rb = o + 1 < 4 ? 32 * WPITCH + (o + 1) * 1024 : (16 * ((eb >> 2) & 1) + 4 * (eb >> 3) + (eb & 3)) * WPITCH;
                        f32x4 wa[8], wb[8];
#pragma unroll
                        for (int jj = 0; jj < 8; ++jj) { wa[jj] = *(const LAS f32x4*)(wbase + ra + 128 * jj); wb[jj] = *(const LAS f32x4*)(wbase + rb + 128 * jj); }
                        asm volatile("" ::: "memory");
                        float a0 = 0.f, a1 = 0.f;
#pragma unroll
                        for (int jj = 0; jj < 8; ++jj) { a0 += (t[jj][0] * wa[jj][0] + t[jj][1] * wa[jj][1]) + (t[jj][2] * wa[jj][2] + t[jj][3] * wa[jj][3]);
                            a1 += (t[jj][0] * wb[jj][0] + t[jj][1] * wb[jj][1]) + (t[jj][2] * wb[jj][2] + t[jj][3] * wb[jj][3]); }
                        a0 = dpp_sum16(a0); a1 = dpp_sum16(a1);
                        a0 += __shfl_xor(a0, 16); a1 += __shfl_xor(a1, 16);
                        if (s32 == 0) { accx[grp2 * 36 + o] = a0; accx[grp2 * 36 + o + 1] = a1; }
                        asm volatile("" ::: "memory"); }
                    __syncthreads();
                    if (wave == 0) {
                        float acc[36];
#pragma unroll
                        for (int o = 0; o < 36; ++o) acc[o] = accx[grp2 * 36 + o];
                        float lg[4]; int gidx = 0; float gmax;
#pragma unroll
                        for (int q = 0; q < 4; ++q) lg[q] = acc[q] + bg[q];
                        gmax = lg[0];
#pragma unroll
                        for (int q = 1; q < 4; ++q) if (lg[q] > gmax) { gmax = lg[q]; gidx = q; }
                        float gden = 0.f;
#pragma unroll
                        for (int q = 0; q < 4; ++q) gden += __expf(lg[q] - gmax);
                        const float gprob = 1.f / gden;
                        float le8[8];
#pragma unroll
                        for (int k = 0; k < 8; ++k) { float sv = acc[4 + k] + be[k];
#pragma unroll
                            for (int q = 1; q < 4; ++q) sv = (gidx == q) ? acc[4 + 8 * q + k] + be[8 * q + k] : sv;
                            le8[k] = sv; }
                        int i1 = 0; float m1 = le8[0];
#pragma unroll
                        for (int k = 1; k < 8; ++k) if (le8[k] > m1) { m1 = le8[k]; i1 = k; }
                        int i2 = -1; float m2 = -3.0e38f;
#pragma unroll
                        for (int k = 0; k < 8; ++k) if (k != i1 && le8[k] > m2) { m2 = le8[k]; i2 = k; }
                        const float e2 = __expf(m2 - m1), inv = 1.f / (1.f + e2);
                        const float w1 = gprob * inv, w2 = gprob * e2 * inv;
                        if (s32 == 0 && rep_ == 0) {
                            const int ea = gidx * 8 + i1, eb = gidx * 8 + i2;
                            const int pa = (int)__hip_atomic_fetch_add(lcnt + ea, 1u, __ATOMIC_RELAXED, __HIP_MEMORY_SCOPE_WORKGROUP) | (bx << 16), pb2 = (int)__hip_atomic_fetch_add(lcnt + eb, 1u, __ATOMIC_RELAXED, __HIP_MEMORY_SCOPE_WORKGROUP) | (bx << 16);
                            tok_e[2 * m] = ea; tok_e[2 * m + 1] = eb; tok_p[2 * m] = pa; tok_p[2 * m + 1] = pb2; tok_w[2 * m] = w1; tok_w[2 * m + 1] = w2;
                        }
                    }
                }
                TSTAMP(12);
                const int p = wave & 3, h = wave >> 2, grp = bx + 256 * p, m = grp * 16 + n16;
#define E_OFF(i) (64 * ((i) >> 2) + 4 * ((i) & 3))
                const float* xr = xcur + (size_t)m * 1024 + 16 * kq + 512 * h;
                LAS float* ssx = (LAS float*)(lds + LDS_XCH);
                float ss = 0.f;
#pragma unroll 1
                for (int i0 = 0; i0 < 32; i0 += 16) { f32x4 v[16];
#pragma unroll
                    for (int j = 0; j < 16; ++j) v[j] = *(const f32x4*)(xr + 16 * i0 + E_OFF(j));
                    asm volatile("" ::: "memory");
#pragma unroll
                    for (int j = 0; j < 16; ++j) ss += (v[j][0] * v[j][0] + v[j][1] * v[j][1]) + (v[j][2] * v[j][2] + v[j][3] * v[j][3]); }
                ss += __shfl_xor(ss, 16); ss += __shfl_xor(ss, 32);
                if (kq == 0) ssx[wave * 16 + n16] = ss;
                __syncthreads();
                TSTAMP(13);
                const float rstd = __builtin_amdgcn_rsqf((ssx[p * 16 + n16] + ssx[(p + 4) * 16 + n16]) * (1.f / 1024.f) + RMS_EPS);
                unsigned char* trow = (unsigned char*)HB + (size_t)m * (FP8_G ? 1024 : 2048) + (FP8_G ? 1 : 2) * (16 * kq + 512 * h);
                const LAS float* a0p = wle + n16 * WPITCH + 16 * kq + 512 * h; const LAS float* a1p = a0p + 16 * WPITCH; const LAS float* wgp = wlg + 16 * kq + 512 * h;
                const LAS float* lcp = lc + 16 * kq + 512 * h;
                f32x4 D0 = {0.f, 0.f, 0.f, 0.f}, D1 = {0.f, 0.f, 0.f, 0.f}; float gl0 = 0.f, gl1 = 0.f, gl2 = 0.f, gl3 = 0.f;
                f32x4 xv[16];
#pragma unroll
                for (int j = 0; j < 16; ++j) xv[j] = *(const f32x4*)(xr + E_OFF(j));
#pragma unroll 1
                for (int ib = 0; ib < 2; ++ib) {
                    const GAS float* xp = (const GAS float*)(xr + 256);
                    GAS unsigned char* tp = (GAS unsigned char*)(trow + (FP8_G ? 256 : 512) * ib);
                    const LAS float* a0b = a0p + 256 * ib; const LAS float* a1b = a1p + 256 * ib; const LAS float* wgb = wgp + 256 * ib; const LAS float* lcb = lcp + 256 * ib;
                    asm volatile("" : "+v"(xp), "+v"(tp), "+v"(a0b), "+v"(a1b), "+v"(wgb), "+v"(lcb));
                    u32x4 tq;
#pragma unroll
                    for (int j = 0; j < 16; ++j) {
                        const f32x4 cv = *(const LAS f32x4*)(lcb + E_OFF(j)), sv = *(const LAS f32x4*)(lcb + 1024 + E_OFF(j));
                        const f32x4 t = xv[j] * rstd * cv + sv;
                        if (!(E_ABL & 8)) xv[j] = *(const GAS f32x4*)(xp + E_OFF(j));
#if FP8_G
                        tq[j & 3] = pg8::pk4_e4m3(t[0], t[1], t[2], t[3]);
                        if ((j & 3) == 3 && !(E_ABL & 4)) *(GAS u32x4*)(tp + 64 * (j >> 2)) = tq;
#else
                        *(GAS u32x2*)(tp + 2 * E_OFF(j)) = (u32x2){pkbf(t[0], t[1]), pkbf(t[2], t[3])};
#endif
                        const f32x4 a0 = *(const LAS f32x4*)(a0b + E_OFF(j)), a1 = *(const LAS f32x4*)(a1b + E_OFF(j));
                        const f32x4 w0 = *(const LAS f32x4*)(wgb + E_OFF(j)), w1 = *(const LAS f32x4*)(wgb + 1024 + E_OFF(j)), w2 = *(const LAS f32x4*)(wgb + 2048 + E_OFF(j)), w3 = *(const LAS f32x4*)(wgb + 3072 + E_OFF(j));
                        if (!(E_ABL & 2)) { gl0 += (t[0] * w0[0] + t[1] * w0[1]) + (t[2] * w0[2] + t[3] * w0[3]); gl1 += (t[0] * w1[0] + t[1] * w1[1]) + (t[2] * w1[2] + t[3] * w1[3]);
                        gl2 += (t[0] * w2[0] + t[1] * w2[1]) + (t[2] * w2[2] + t[3] * w2[3]); gl3 += (t[0] * w3[0] + t[1] * w3[1]) + (t[2] * w3[2] + t[3] * w3[3]); }
#pragma unroll
                        for (int e = 0; e < 4; ++e) if (!(E_ABL & 1)) { D0 = __builtin_amdgcn_mfma_f32_16x16x4f32(a0[e], t[e], D0, 0, 0, 0); D1 = __builtin_amdgcn_mfma_f32_16x16x4f32(a1[e], t[e], D1, 0, 0, 0); }
                        asm volatile("" ::: "memory"); }
                }
#undef E_OFF
                __syncthreads();
                TSTAMP(14);
                LAS float* part = (LAS float*)(lds + LDS_RW) + p * 12 * 64 + lane;
                if (h) {
#pragma unroll
                    for (int k = 0; k < 4; ++k) { part[k * 64] = D0[k]; part[(4 + k) * 64] = D1[k]; }
                    part[8 * 64] = gl0; part[9 * 64] = gl1; part[10 * 64] = gl2; part[11 * 64] = gl3; }
                __syncthreads();
                if (!h) {
#pragma unroll
                    for (int k = 0; k < 4; ++k) { D0[k] += part[k * 64]; D1[k] += part[(4 + k) * 64]; }
                    gl0 += part[8 * 64]; gl1 += part[9 * 64]; gl2 += part[10 * 64]; gl3 += part[11 * 64];
                gl0 += __shfl_xor(gl0, 16); gl1 += __shfl_xor(gl1, 16); gl2 += __shfl_xor(gl2, 16); gl3 += __shfl_xor(gl3, 16);
                gl0 += __shfl_xor(gl0, 32); gl1 += __shfl_xor(gl1, 32); gl2 += __shfl_xor(gl2, 32); gl3 += __shfl_xor(gl3, 32);
                float lg[4] = {gl0 + bg[0], gl1 + bg[1], gl2 + bg[2], gl3 + bg[3]}; int gidx = 0; float gmax = lg[0];
#pragma unroll
                for (int q = 1; q < 4; ++q) if (lg[q] > gmax) { gmax = lg[q]; gidx = q; }
                float gden = 0.f;
#pragma unroll
                for (int q = 0; q < 4; ++q) gden += __expf(lg[q] - gmax);
                const float gprob = 1.f / gden;
                float le8[8];
#pragma unroll
                for (int k = 0; k < 4; ++k) { le8[k] = D0[k] + be[8 * kq + k]; le8[4 + k] = D1[k] + be[8 * kq + 4 + k]; }
                int i1 = 0; float m1 = le8[0];
#pragma unroll
                for (int k = 1; k < 8; ++k) if (le8[k] > m1) { m1 = le8[k]; i1 = k; }
                int i2 = -1; float m2 = -3.0e38f;
#pragma unroll
                for (int k = 0; k < 8; ++k) if (k != i1 && le8[k] > m2) { m2 = le8[k]; i2 = k; }
                const float e2 = __expf(m2 - m1), inv = 1.f / (1.f + e2);
                const float w1r = gprob * inv, w2r = gprob * e2 * inv;
                if (kq == gidx && rep_ == 0) {
                    const int ea = gidx * 8 + i1, eb = gidx * 8 + i2;
                    const int pa = (int)__hip_atomic_fetch_add(lcnt + ea, 1u, __ATOMIC_RELAXED, __HIP_MEMORY_SCOPE_WORKGROUP) | (bx << 16), pb2 = (int)__hip_atomic_fetch_add(lcnt + eb, 1u, __ATOMIC_RELAXED, __HIP_MEMORY_SCOPE_WORKGROUP) | (bx << 16);
                    tok_e[2 * m] = ea; tok_e[2 * m + 1] = eb; tok_p[2 * m] = pa; tok_p[2 * m + 1] = pb2; tok_w[2 * m] = w1r; tok_w[2 * m + 1] = w2r;
                }
                }
                __syncthreads();
                TSTAMP(15);
            } else {
#if E_GENERIC
            if (wave >= 4) {
                const int grp2 = lane >> 5, s32 = lane & 31;
                for (int m0 = SEQ + 2 * (bx + G * (wave - 4)); m0 < mrows; m0 += 2 * G * 4) {
                    const int m = m0 + grp2;
                    f32x4 t[8];
                    float ss = 0.f;
#pragma unroll
                    for (int jj = 0; jj < 8; ++jj) { t[jj] = *(const f32x4*)(xcur + (size_t)m * 1024 + 4 * s32 + 128 * jj); ss += (t[jj][0] * t[jj][0] + t[jj][1] * t[jj][1]) + (t[jj][2] * t[jj][2] + t[jj][3] * t[jj][3]); }
                    ss = dpp_sum16(ss); ss += __shfl_xor(ss, 16);
                    const float rstd = __builtin_amdgcn_rsqf(ss * (1.f / 1024.f) + RMS_EPS);
#pragma unroll
                    for (int jj = 0; jj < 8; ++jj) { const int c0 = 4 * s32 + 128 * jj; const f32x4 gn = *(const f32x4*)(gffn + c0), sh = *(const f32x4*)(modcl + 3 * 1024 + c0), scl = *(const f32x4*)(modcl + 4 * 1024 + c0);
                        t[jj] = t[jj] * rstd * (gn * (scl + 1.f)) + sh;
#if FP8_G
                        *(unsigned*)((unsigned char*)HB + (size_t)m * 1024 + c0) = pg8::pk4_e4m3(t[jj][0], t[jj][1], t[jj][2], t[jj][3]); }
#else
                        *(u32x2*)(HB + (size_t)m * 1024 + c0) = (u32x2){pkbf(t[jj][0], t[jj][1]), pkbf(t[jj][2], t[jj][3])}; }
#endif
                    float acc[36];
                    const LAS float* wbase = wle + 4 * s32; asm volatile("" : "+v"(wbase));
#pragma unroll
                    for (int o = 0; o < 36; o += 2) {
                        const int ea = o - 4, eb = o - 3;
                        const int ra = o < 4 ? 32 * WPITCH + o * 1024 : (16 * ((ea >> 2) & 1) + 4 * (ea >> 3) + (ea & 3)) * WPITCH;
                        const int rb = o + 1 < 4 ? 32 * WPITCH + (o + 1) * 1024 : (16 * ((eb >> 2) & 1) + 4 * (eb >> 3) + (eb & 3)) * WPITCH;
                        f32x4 wa[8], wb[8];
#pragma unroll
                        for (int jj = 0; jj < 8; ++jj) { wa[jj] = *(const LAS f32x4*)(wbase + ra + 128 * jj); wb[jj] = *(const LAS f32x4*)(wbase + rb + 128 * jj); }
                        asm volatile("" ::: "memory");
                        float a0 = 0.f, a1 = 0.f;
#pragma unroll
                        for (int jj = 0; jj < 8; ++jj) { a0 += (t[jj][0] * wa[jj][0] + t[jj][1] * wa[jj][1]) + (t[jj][2] * wa[jj][2] + t[jj][3] * wa[jj][3]);
                            a1 += (t[jj][0] * wb[jj][0] + t[jj][1] * wb[jj][1]) + (t[jj][2] * wb[jj][2] + t[jj][3] * wb[jj][3]); }
                        a0 = dpp_sum16(a0); a1 = dpp_sum16(a1);
                        acc[o] = a0 + __shfl_xor(a0, 16); acc[o + 1] = a1 + __shfl_xor(a1, 16);
                        asm volatile("" ::: "memory"); }
                    float lg[4]; int gidx = 0; float gmax;
#pragma unroll
                    for (int q = 0; q < 4; ++q) lg[q] = acc[q] + bg[q];
                    gmax = lg[0];
#pragma unroll
                    for (int q = 1; q < 4; ++q) if (lg[q] > gmax) { gmax = lg[q]; gidx = q; }
                    float gden = 0.f;
#pragma unroll
                    for (int q = 0; q < 4; ++q) gden += __expf(lg[q] - gmax);
                    const float gprob = 1.f / gden;
                    float le8[8];
#pragma unroll
                    for (int k = 0; k < 8; ++k) { float sv = acc[4 + k] + be[k];
#pragma unroll
                        for (int q = 1; q < 4; ++q) sv = (gidx == q) ? acc[4 + 8 * q + k] + be[8 * q + k] : sv;
                        le8[k] = sv; }
                    int i1 = 0; float m1 = le8[0];
#pragma unroll
                    for (int k = 1; k < 8; ++k) if (le8[k] > m1) { m1 = le8[k]; i1 = k; }
                    int i2 = -1; float m2 = -3.0e38f;
#pragma unroll
                    for (int k = 0; k < 8; ++k) if (k != i1 && le8[k] > m2) { m2 = le8[k]; i2 = k; }
                    const float e2 = __expf(m2 - m1), inv = 1.f / (1.f + e2);
                    const float w1 = gprob * inv, w2 = gprob * e2 * inv;
                    if (s32 == 0 && rep_ == 0) {
                        const int ea = gidx * 8 + i1, eb = gidx * 8 + i2;
                        const int pa = (int)__hip_atomic_fetch_add(lcnt + ea, 1u, __ATOMIC_RELAXED, __HIP_MEMORY_SCOPE_WORKGROUP) | (bx << 16), pb2 = (int)__hip_atomic_fetch_add(lcnt + eb, 1u, __ATOMIC_RELAXED, __HIP_MEMORY_SCOPE_WORKGROUP) | (bx << 16);
                        tok_e[2 * m] = ea; tok_e[2 * m + 1] = eb; tok_p[2 * m] = pa; tok_p[2 * m + 1] = pb2; tok_w[2 * m] = w1; tok_w[2 * m + 1] = w2;
                    }
                }
            } else
            for (int grp = bx + G * wave; grp < (SEQ >> 4); grp += G * 4) {
                const int m = grp * 16 + n16;
                const float* xr = xcur + (size_t)m * 1024 + 4 * kq;
                float ss = 0.f;
#pragma unroll 1
                for (int r1_ = 0; r1_ < E_REP1; ++r1_) { ss = 0.f; asm volatile("" : "+v"(ss));
#pragma unroll 1
                for (int i0 = 0; i0 < 64; i0 += 16) { f32x4 v[16];
#pragma unroll
                    for (int j = 0; j < 16; ++j) v[j] = *(const f32x4*)(xr + 16 * (i0 + j));
                    asm volatile("" ::: "memory");
#pragma unroll
                    for (int j = 0; j < 16; ++j) ss += (v[j][0] * v[j][0] + v[j][1] * v[j][1]) + (v[j][2] * v[j][2] + v[j][3] * v[j][3]); } }
                ss += __shfl_xor(ss, 16); ss += __shfl_xor(ss, 32);
                const float rstd = __builtin_amdgcn_rsqf(ss * (1.f / 1024.f) + RMS_EPS);
                unsigned char* trow = (unsigned char*)HB + (size_t)m * (FP8_G ? 1024 : 2048) + (FP8_G ? 4 : 8) * kq;
                const LAS float* a0p = wle + n16 * WPITCH + 4 * kq; const LAS float* a1p = a0p + 16 * WPITCH; const LAS float* wgp = wlg + 4 * kq;
                const LAS float* lcp = lc + 4 * kq; const LAS float* lshp = lsh + 4 * kq;
                f32x4 D0, D1; float gl0, gl1, gl2, gl3;
#pragma unroll 1
                for (int r2_ = 0; r2_ < E_REP2; ++r2_) {
                D0 = (f32x4){0.f, 0.f, 0.f, 0.f}; D1 = D0; gl0 = 0.f; gl1 = 0.f; gl2 = 0.f; gl3 = 0.f;
                asm volatile("" : "+v"(D0), "+v"(D1), "+v"(gl0), "+v"(gl1), "+v"(gl2), "+v"(gl3));
                f32x4 xv[16];
#pragma unroll
                for (int j = 0; j < 16; ++j) xv[j] = *(const f32x4*)(xr + 16 * j);
#pragma unroll 1
                for (int ib = 0; ib < 4; ++ib) {
                    const GAS float* xp = (const GAS float*)(xr + 256 * (ib < 3 ? ib + 1 : 3));
                    GAS unsigned char* tp = (GAS unsigned char*)(trow + (FP8_G ? 256 : 512) * ib);
                    const LAS float* a0b = a0p + 256 * ib; const LAS float* a1b = a1p + 256 * ib; const LAS float* wgb = wgp + 256 * ib; const LAS float* lcb = lcp + 256 * ib;
                    asm volatile("" : "+v"(xp), "+v"(tp), "+v"(a0b), "+v"(a1b), "+v"(wgb), "+v"(lcb));
#pragma unroll
                    for (int j = 0; j < 16; ++j) {
                        const f32x4 cv = *(const LAS f32x4*)(lcb + 16 * j), sv = *(const LAS f32x4*)(lcb + 1024 + 16 * j);
                        const f32x4 t = xv[j] * rstd * cv + sv;
                        xv[j] = *(const GAS f32x4*)(xp + 16 * j);
#if FP8_G
                        *(GAS unsigned*)(tp + 16 * j) = pg8::pk4_e4m3(t[0], t[1], t[2], t[3]);
#else
                        *(GAS u32x2*)(tp + 32 * j) = (u32x2){pkbf(t[0], t[1]), pkbf(t[2], t[3])};
#endif
                        const f32x4 a0 = *(const LAS f32x4*)(a0b + 16 * j), a1 = *(const LAS f32x4*)(a1b + 16 * j);
                        const f32x4 w0 = *(const LAS f32x4*)(wgb + 16 * j), w1 = *(const LAS f32x4*)(wgb + 1024 + 16 * j), w2 = *(const LAS f32x4*)(wgb + 2048 + 16 * j), w3 = *(const LAS f32x4*)(wgb + 3072 + 16 * j);
                        gl0 += (t[0] * w0[0] + t[1] * w0[1]) + (t[2] * w0[2] + t[3] * w0[3]); gl1 += (t[0] * w1[0] + t[1] * w1[1]) + (t[2] * w1[2] + t[3] * w1[3]);
                        gl2 += (t[0] * w2[0] + t[1] * w2[1]) + (t[2] * w2[2] + t[3] * w2[3]); gl3 += (t[0] * w3[0] + t[1] * w3[1]) + (t[2] * w3[2] + t[3] * w3[3]);
#pragma unroll
                        for (int e = 0; e < 4; ++e) { D0 = __builtin_amdgcn_mfma_f32_16x16x4f32(a0[e], t[e], D0, 0, 0, 0); D1 = __builtin_amdgcn_mfma_f32_16x16x4f32(a1[e], t[e], D1, 0, 0, 0); }
                        asm volatile("" ::: "memory"); }
                }
                }
                gl0 += __shfl_xor(gl0, 16); gl1 += __shfl_xor(gl1, 16); gl2 += __shfl_xor(gl2, 16); gl3 += __shfl_xor(gl3, 16);
                gl0 += __shfl_xor(gl0, 32); gl1 += __shfl_xor(gl1, 32); gl2 += __shfl_xor(gl2, 32); gl3 += __shfl_xor(gl3, 32);
                float lg[4] = {gl0 + bg[0], gl1 + bg[1], gl2 + bg[2], gl3 + bg[3]}; int gidx = 0; float gmax = lg[0];
#pragma unroll
                for (int q = 1; q < 4; ++q) if (lg[q] > gmax) { gmax = lg[q]; gidx = q; }
                float gden = 0.f;
#pragma unroll
                for (int q = 0; q < 4; ++q) gden += __expf(lg[q] - gmax);
                const float gprob = 1.f / gden;
                float le8[8];
#pragma unroll
                for (int k = 0; k < 4; ++k) { le8[k] = D0[k] + be[8 * kq + k]; le8[4 + k] = D1[k] + be[8 * kq + 4 + k]; }
                int i1 = 0; float m1 = le8[0];
#pragma unroll
                for (int k = 1; k < 8; ++k) if (le8[k] > m1) { m1 = le8[k]; i1 = k; }
                int i2 = -1; float m2 = -3.0e38f;
#pragma unroll
                for (int k = 0; k < 8; ++k) if (k != i1 && le8[k] > m2) { m2 = le8[k]; i2 = k; }
                const float e2 = __expf(m2 - m1), inv = 1.f / (1.f + e2);
                const float w1r = gprob * inv, w2r = gprob * e2 * inv;
                if (kq == gidx && rep_ == 0) {
                    const int ea = gidx * 8 + i1, eb = gidx * 8 + i2;
                    const int pa = (int)__hip_atomic_fetch_add(lcnt + ea, 1u, __ATOMIC_RELAXED, __HIP_MEMORY_SCOPE_WORKGROUP) | (bx << 16), pb2 = (int)__hip_atomic_fetch_add(lcnt + eb, 1u, __ATOMIC_RELAXED, __HIP_MEMORY_SCOPE_WORKGROUP) | (bx << 16);
                    tok_e[2 * m] = ea; tok_e[2 * m + 1] = eb; tok_p[2 * m] = pa; tok_p[2 * m + 1] = pb2; tok_w[2 * m] = w1r; tok_w[2 * m + 1] = w2r;
                }
            }
#else
                __builtin_trap();
#endif
            }
#else
            const int grp = lane >> 5, s32 = lane & 31;
            { LAS f32x4* wl = (LAS f32x4*)(lds + LDS_RW); const f32x4* wg4 = (const f32x4*)wtr;
              for (int i = tid; i < 36 * 256; i += NTHREADS) wl[i] = wg4[i];
              __syncthreads(); }
            const LAS f32x4* wl4 = (const LAS f32x4*)(lds + LDS_RW) + s32;
            for (int m0 = gw * 2; m0 < mrows; m0 += NGW * 2) {
                const int m = m0 + grp;
                const bool isctx = m0 >= SEQ; const float* mm = isctx ? modcl : modl;
                f32x4 t[8];
                float ss = 0.f;
#pragma unroll
                for (int jj = 0; jj < 8; ++jj) { t[jj] = *(const f32x4*)(xcur + (size_t)m * 1024 + 4 * s32 + 128 * jj); ss += (t[jj][0] * t[jj][0] + t[jj][1] * t[jj][1]) + (t[jj][2] * t[jj][2] + t[jj][3] * t[jj][3]); }
                ss = dpp_sum16(ss); ss += __shfl_xor(ss, 16);
                const float rstd = __builtin_amdgcn_rsqf(ss * (1.f / 1024.f) + RMS_EPS);
                int s32o = s32; asm volatile("" : "+v"(s32o));
#pragma unroll
                for (int jj = 0; jj < 8; ++jj) { const int c0 = 4 * s32o + 128 * jj; const f32x4 gn = *(const f32x4*)(gffn + c0), sh = *(const f32x4*)(mm + 3 * 1024 + c0), scl = *(const f32x4*)(mm + 4 * 1024 + c0);
                    t[jj] = t[jj] * rstd * gn * (scl + 1.f) + sh;
#if FP8_G
                    *(unsigned*)((unsigned char*)HB + (size_t)m * 1024 + c0) = pg8::pk4_e4m3(t[jj][0], t[jj][1], t[jj][2], t[jj][3]); }
#else
                    *(u32x2*)(HB + (size_t)m * 1024 + c0) = (u32x2){pkbf(t[jj][0], t[jj][1]), pkbf(t[jj][2], t[jj][3])}; }
#endif
                float acc[36];
                const LAS f32x4* wlo = wl4; asm volatile("" : "+v"(wlo));
#pragma unroll
                for (int o = 0; o < 36; o += 2) {
                    f32x4 wa[8], wb[8];
#pragma unroll
                    for (int jj = 0; jj < 8; ++jj) { wa[jj] = wlo[o * 256 + jj * 32]; wb[jj] = wlo[(o + 1) * 256 + jj * 32]; }
                    asm volatile("" ::: "memory");
                    float a0 = 0.f, a1 = 0.f;
#pragma unroll
                    for (int jj = 0; jj < 8; ++jj) { a0 += (t[jj][0] * wa[jj][0] + t[jj][1] * wa[jj][1]) + (t[jj][2] * wa[jj][2] + t[jj][3] * wa[jj][3]);
                        a1 += (t[jj][0] * wb[jj][0] + t[jj][1] * wb[jj][1]) + (t[jj][2] * wb[jj][2] + t[jj][3] * wb[jj][3]); }
                    a0 = dpp_sum16(a0); a1 = dpp_sum16(a1);
                    acc[o] = a0 + __shfl_xor(a0, 16); acc[o + 1] = a1 + __shfl_xor(a1, 16);
                    asm volatile("" ::: "memory"); }
                float lg[4]; int gidx = 0; float gmax;
#pragma unroll
                for (int q = 0; q < 4; ++q) lg[q] = acc[q] + bg[q];
                gmax = lg[0];
#pragma unroll
                for (int q = 1; q < 4; ++q) if (lg[q] > gmax) { gmax = lg[q]; gidx = q; }
                float gden = 0.f;
#pragma unroll
                for (int q = 0; q < 4; ++q) gden += __expf(lg[q] - gmax);
                const float gprob = 1.f / gden;
                float le8[8];
#pragma unroll
                for (int k = 0; k < 8; ++k) { float s = acc[4 + k] + be[k];
#pragma unroll
                    for (int q = 1; q < 4; ++q) s = (gidx == q) ? acc[4 + 8 * q + k] + be[8 * q + k] : s;
                    le8[k] = s; }
                int i1 = 0; float m1 = le8[0];
#pragma unroll
                for (int k = 1; k < 8; ++k) if (le8[k] > m1) { m1 = le8[k]; i1 = k; }
                int i2 = -1; float m2 = -3.0e38f;
#pragma unroll
                for (int k = 0; k < 8; ++k) if (k != i1 && le8[k] > m2) { m2 = le8[k]; i2 = k; }
                const float e2 = __expf(m2 - m1), inv = 1.f / (1.f + e2);
                const float w1 = gprob * inv, w2 = gprob * e2 * inv;
                if (s32 == 0 && rep_ == 0) {
                    const int ea = gidx * 8 + i1, eb = gidx * 8 + i2;
                    const int pa = (int)__hip_atomic_fetch_add(lcnt + ea, 1u, __ATOMIC_RELAXED, __HIP_MEMORY_SCOPE_WORKGROUP) | (bx << 16), pb2 = (int)__hip_atomic_fetch_add(lcnt + eb, 1u, __ATOMIC_RELAXED, __HIP_MEMORY_SCOPE_WORKGROUP) | (bx << 16);
                    tok_e[2 * m] = ea; tok_e[2 * m + 1] = eb; tok_p[2 * m] = pa; tok_p[2 * m + 1] = pb2; tok_w[2 * m] = w1; tok_w[2 * m + 1] = w2;
                }
            }
#endif
            __syncthreads();
            if (tid < 32 && rep_ == 0) ctl[CW_CNT + l * 16384 + bx * 32 + tid] = lcnt[tid];
        REP_END }
        SEAM(pb + 4); TSTAMP(7);

        if (IN(pb + 5)) { if (!PH_ON(6)) __builtin_trap(); asm volatile("; MARK_PHASE pb+5" ::: "memory"); PHASE_IDS(); REP_BEGIN(8)
            LAS int* sbt = (LAS int*)lds;
            LAS int* seg = sbt + 8192; LAS int* ebase = seg + 512;
            { const unsigned* cg = ctl + CW_CNT + l * 16384 + tid; int cv[16];
#pragma unroll
              for (int j = 0; j < 16; ++j) cv[j] = (int)__hip_atomic_load(cg + 512 * j, __ATOMIC_RELAXED, __HIP_MEMORY_SCOPE_AGENT);
#pragma unroll
              for (int j = 0; j < 16; ++j) sbt[tid + 512 * j] = cv[j]; }
            __syncthreads();
            const int fe = tid & 31, fsg = tid >> 5;
            { int ssum = 0;
#pragma unroll
              for (int c = 0; c < 16; ++c) ssum += sbt[(16 * fsg + c) * 32 + fe];
              seg[fsg * 32 + fe] = ssum; }
            __syncthreads();
            int pad = 0, tot = 0;
            if (lane < 32) {
#pragma unroll
                for (int q = 0; q < 16; ++q) tot += seg[q * 32 + lane];
                pad = (tot + 255) & ~255; }
            int incl = pad;
#pragma unroll
            for (int o = 1; o < 32; o <<= 1) { const int t = __shfl_up(incl, o); if (lane >= o) incl += t; }
            const int base = incl - pad;
            if (wave == 0 && lane < 32) { ebase[lane] = base; ebase[32 + lane] = pad; }
            __syncthreads();
            { int run = ebase[fe];
              for (int q = 0; q < fsg; ++q) run += seg[q * 32 + fe];
#pragma unroll
              for (int c = 0; c < 16; ++c) { const int idx = (16 * fsg + c) * 32 + fe; const int cnt = sbt[idx]; sbt[idx] = run; run += cnt; } }
            __syncthreads();
#if FP8_G
            if (NGW == 2048) {
                static_assert(MT <= 9 * 256 * 8 && SEQ >= 8 * 256 * 8, "dispatch batch");
                constexpr int NGWC = 2048;
                const int mj = gw + NGWC * (lane >> 1);
                int rowj = 0;
                if (lane < 18 && mj < mrows) { const int e = tok_e[2 * mj + (lane & 1)], pp = tok_p[2 * mj + (lane & 1)]; const float w = tok_w[2 * mj + (lane & 1)];
                    rowj = sbt[(pp >> 16) * 32 + e] + (pp & 0xffff); drow[2 * mj + (lane & 1)] = rowj; rw[rowj] = w; }
                const unsigned char* src = (const unsigned char*)HB + (size_t)gw * 1024 + 16 * lane;
                const bool last = gw + NGWC * 8 < mrows;
                u32x4 rv[9];
#pragma unroll
                for (int it = 0; it < 8; ++it) rv[it] = *(const u32x4*)(src + (size_t)NGWC * 1024 * it);
                rv[8] = (u32x4){0u, 0u, 0u, 0u}; if (last) rv[8] = *(const u32x4*)(src + (size_t)NGWC * 1024 * 8);
#pragma unroll
                for (int it = 0; it < 9; ++it) if (it < 8 || last) {
                    const int r0 = __builtin_amdgcn_readlane(rowj, 2 * it), r1 = __builtin_amdgcn_readlane(rowj, 2 * it + 1);
                    *(u32x4*)((unsigned char*)XG + (size_t)r0 * 1024 + 16 * lane) = rv[it]; *(u32x4*)((unsigned char*)XG + (size_t)r1 * 1024 + 16 * lane) = rv[it]; }
            } else
#endif
            for (int m = gw; m < mrows; m += NGW) {
#pragma unroll
                for (int k = 0; k < 2; ++k) {
                    const int e = tok_e[2 * m + k], pp = tok_p[2 * m + k];
                    const int row = sbt[(pp >> 16) * 32 + e] + (pp & 0xffff);
#if FP8_G
                    *(u32x4*)((unsigned char*)XG + (size_t)row * 1024 + 16 * lane) = *(const u32x4*)((const unsigned char*)HB + (size_t)m * 1024 + 16 * lane);
#else
                    const bf16* src = HB + (size_t)m * 1024; bf16* dst = XG + (size_t)row * 1024;
#pragma unroll
                    for (int j = 0; j < 2; ++j) *(u32x4*)(dst + 8 * lane + 512 * j) = *(const u32x4*)(src + 8 * lane + 512 * j);
#endif
                    if (lane == 0) { drow[2 * m + k] = row; rw[row] = tok_w[2 * m + k]; }
                }
            }
            if (bx == 0 && wave == 0) {
                if (lane < 32) for (int t = base >> 8; t < (base + pad) >> 8; ++t) tile_e[t] = lane;
                if (lane == 31) ntl[0] = (base + pad) >> 8;
            }
        REP_END }
        SEAM(pb + 5); TSTAMP(8);

        if (IN(pb + 6)) { if (!PH_ON(7)) __builtin_trap(); asm volatile("; MARK_PHASE pb+6" ::: "memory"); PHASE_IDS(); REP_BEGIN(9)
            LAS int* tab = (LAS int*)(lds + TAB_OFF);
            if (tid < 256) tab[tid] = tile_e[tid];
            if (tid == 0) tab[256] = ntl[0];
            __syncthreads();
            const int nt = tab[256];
            constexpr size_t ESZ = FP8_G ? 1 : 2;
            pg8::Gemm g{XG, (const bf16*)(ws + WS_BT_W13 + (size_t)l * NEXP * 1024 * 1024 * ESZ), XG_ROWS, 1024, 1024};
            pg8::MoeOrder S{tab, nt * 4, G, bx};
            pg8::EpiSwiGLU E{HG, FP8_H};
            pg8::gemm_phase<pg8::EpiSwiGLU, pg8::MoeOrder, true, true, FP8_G != 0>(lds, g, S, E);
        REP_END }
        SEAM(pb + 6); TSTAMP(9);

        if (IN(pb + 7)) { if (!PH_ON(8)) __builtin_trap(); asm volatile("; MARK_PHASE pb+7" ::: "memory"); PHASE_IDS(); REP_BEGIN(10)
            LAS int* tab = (LAS int*)(lds + TAB_OFF);
            if (tid < 256) tab[tid] = tile_e[tid];
            if (tid == 0) tab[256] = ntl[0];
            __syncthreads();
            const int nt = tab[256];
            constexpr size_t ESZ = FP8_H ? 1 : 2;
            pg8::Gemm g{HG, (const bf16*)(ws + WS_BT_W2 + (size_t)l * NEXP * 1024 * 512 * ESZ), XG_ROWS, 1024, 512};
            pg8::MoeOrder S{tab, nt * 4, G, bx};
            pg8::EpiY E{YG, rw};
            pg8::gemm_phase<pg8::EpiY, pg8::MoeOrder, true, true, FP8_H != 0>(lds, g, S, E);
        REP_END }
        SEAM(pb + 7); TSTAMP(10);
    }

    if (IN(NPH - 1)) { if (!PH_ON(9)) __builtin_trap(); asm volatile("; MARK_PHASE final" ::: "memory"); PHASE_IDS();
        const float* gate = mod + (DEPTH - 1) * 6144 + 5 * 1024;
#if ATT_TIMING
        float tscale; { const unsigned long long* tm = (const unsigned long long*)(ws + WS_CTL + 300000); const int ti_ = ((ATT_TIMING - 1) & 1) * 2; const double fr = (double)tm[ti_] / (double)tm[ti_ + 1];
            tscale = 1.05f + 0.05f * (float)(int)(fr * 16.0 + 0.5); }
#endif
#if TPROBE >= 0
#if TPROBE == 98
        float tscale; { const unsigned long long* sp = (const unsigned long long*)(ws + WS_CTL + 400000); const double mean = (double)sp[0] / (double)sp[2], mx = (double)sp[1];
            tscale = 1.05f + 0.05f * (float)(int)((mx / mean - 1.0) * 100.0 + 0.5); }
#elif TPROBE == 97
        float tscale; { unsigned long long tot = tms[7]; for (int q = 11; q < 16; ++q) tot += tms[q]; tscale = 1.0f + 0.1f * (float)(int)((double)tot / 100.0 / (double)TPBIN + 0.5); }
#elif TPROBE == 99
        float tscale; { unsigned long long tot = 0; for (int q = 0; q < 11; ++q) tot += tms[q]; tscale = 1.05f + 0.05f * (float)(int)((double)tot / 100.0 / 64.0 + 0.5); }
#else
        float tscale; { tscale = 1.0f + 0.1f * (float)(int)((double)tms[TPROBE] / 100.0 / (double)TPBIN + 0.5); }
#endif
#endif
#if !(ATT_TIMING || TPROBE >= 0)
        if (NGW == 2048) {
            int dj = 0; if (lane < 16) dj = drow[2 * (gw + 2048 * (lane >> 1)) + (lane & 1)];
            f32x4 gt[4];
#pragma unroll
            for (int j = 0; j < 4; ++j) gt[j] = *(const f32x4*)(gate + 4 * lane + 256 * j);
            f32x4 xv[2][4]; u32x2 y0[2][4], y1[2][4];
#define F_ISSUE(it, b) { const int d0 = __builtin_amdgcn_readlane(dj, 2 * (it)), d1 = __builtin_amdgcn_readlane(dj, 2 * (it) + 1); \
                _Pragma("unroll") for (int j = 0; j < 4; ++j) { const int c0 = 4 * lane + 256 * j; xv[b][j] = *(const f32x4*)(xcur + (size_t)(gw + 2048 * (it)) * 1024 + c0); \
                    y0[b][j] = *(const u32x2*)(YG + (size_t)d0 * 1024 + c0); y1[b][j] = *(const u32x2*)(YG + (size_t)d1 * 1024 + c0); } }
            F_ISSUE(0, 0)
#pragma unroll
            for (int it = 0; it < 8; ++it) { const int b = it & 1;
                if (it + 1 < 8) { if (b) F_ISSUE(it + 1, 0) else F_ISSUE(it + 1, 1) }
                asm volatile("" ::: "memory");
#pragma unroll
                for (int j = 0; j < 4; ++j) { const u32x2 a0 = y0[b][j], a1 = y1[b][j]; f32x4 v = xv[b][j];
                    if (!((DBG_NO_MOE >> 3) & 1)) v = v + gt[j] * (f32x4){bflo(a0.x) + bflo(a1.x), bfhi(a0.x) + bfhi(a1.x), bflo(a0.y) + bflo(a1.y), bfhi(a0.y) + bfhi(a1.y)};
                    *(f32x4*)(args.out + (size_t)(gw + 2048 * it) * 1024 + 4 * lane + 256 * j) = v; }
                asm volatile("" ::: "memory");
            }
#undef F_ISSUE
        } else
#endif
        for (int m = gw; m < SEQ; m += NGW) {
            const int d0 = drow[2 * m], d1 = drow[2 * m + 1];
#pragma unroll
            for (int j = 0; j < 4; ++j) { const int c0 = 4 * lane + 256 * j;
                f32x4 v = *(const f32x4*)(xcur + (size_t)m * 1024 + c0);
                const u32x2 y0 = *(const u32x2*)(YG + (size_t)d0 * 1024 + c0), y1 = *(const u32x2*)(YG + (size_t)d1 * 1024 + c0);
                const f32x4 gt = *(const f32x4*)(gate + c0);
                if (!((DBG_NO_MOE >> 3) & 1)) v = v + gt * (f32x4){bflo(y0.x) + bflo(y1.x), bfhi(y0.x) + bfhi(y1.x), bflo(y0.y) + bflo(y1.y), bfhi(y0.y) + bfhi(y1.y)};
#if ATT_TIMING || TPROBE >= 0
                v = *(const f32x4*)(args.in[I_X] + (size_t)m * 1024 + c0);
#endif
#if TPROBE >= 0 || ATT_TIMING
                v = v * tscale;
#endif
                *(f32x4*)(args.out + (size_t)m * 1024 + c0) = v; }
        }
    }
#undef IN
#undef SEAM
}

#ifndef MK_PER_PHASE
#define MK_PER_PHASE 0
#endif
extern "C" void kernel_launch(void* const* d_in, const int* in_sizes, int n_in, void* d_out, int out_size, void* d_ws, size_t ws_size, hipStream_t stream) {
    static int grid = 0;
    if (grid == 0) {
        if (n_in != 28 || out_size != SEQ * DM || ws_size < WS_END) { fprintf(stderr, "kernel_launch: unexpected shapes (n_in %d, out %d, ws %zu)\n", n_in, out_size, ws_size); grid = -1; return; }
        int dev = 0, cus = 0;
        if (hipGetDevice(&dev) != hipSuccess || hipDeviceGetAttribute(&cus, hipDeviceAttributeMultiprocessorCount, dev) != hipSuccess) { grid = -1; return; }
        if (hipFuncSetAttribute((const void*)mega, hipFuncAttributeMaxDynamicSharedMemorySize, LDS_BYTES) != hipSuccess) { fprintf(stderr, "kernel_launch: hipFuncSetAttribute failed\n"); grid = -1; return; }
        (void)hipGetLastError();
        grid = cus < 256 ? cus : 256;
    }
    if (grid < 0) return;
    (void)hipMemsetAsync((char*)d_ws + WS_CTL, 0, CTL_ZERO_BYTES, stream);
    Args a{};
    for (int i = 0; i < 28; ++i) a.in[i] = (const float*)d_in[i];
    a.out = (float*)d_out; a.ws = (unsigned char*)d_ws;
#if MK_PER_PHASE
    for (int p = 0; p < NPH; ++p) { a.ph_lo = p; a.ph_hi = p + 1; hipLaunchKernelGGL(mega, dim3(grid), dim3(NTHREADS), LDS_BYTES, stream, a); }
#else
    a.ph_lo = 0; a.ph_hi = NPH; hipLaunchKernelGGL(mega, dim3(grid), dim3(NTHREADS), LDS_BYTES, stream, a);
#endif
}
```

```cpp
#include <hip/hip_runtime.h>
#include <cstdio>
#include <cstdint>
namespace pg8 {
#define PG8_LAS __attribute__((address_space(3)))
typedef unsigned short bf16_t;
typedef short bf16x8 __attribute__((ext_vector_type(8)));
typedef float f32x4 __attribute__((ext_vector_type(4)));
typedef unsigned u32x4 __attribute__((ext_vector_type(4)));
constexpr int BM = 256, BK = 64, HALF = 128, HTB = HALF * BK * 2  , STAGE_BYTES = 8 * HTB, NXCD = 8, WGM = 8;

__host__ __device__ __forceinline__ int lds_byte(int r, int c) { const int st = (r >> 4) * 2 + (c >> 5), rr = r & 15, cc = c & 31, ob = rr * 64 + cc * 2; return st * 1024 + (ob ^ (((ob >> 9) & 1) << 5)); }
__host__ __device__ __forceinline__ void stage_rc(int b, int& R, int& C) { const int st = b / 1024, sb = b % 1024, swz = sb ^ (((sb >> 9) & 1) << 5); R = (st >> 1) * 16 + swz / 64; C = (st & 1) * 32 + (swz % 64) / 2; }
__host__ __device__ __forceinline__ int perm32(int rho) { const int n = rho >> 4, i = rho & 15; return 8 * (i >> 2) + 4 * n + (i & 3); }

struct Unit { int pm, pn; };
struct Gemm { const bf16_t* A; const bf16_t* Bt; int M, N, K; };

struct StaticOrder {
    int nM, nN, nwg, G, c;
    __host__ __device__ void init(int M, int N, int G_, int c_) { nM = M / BM; nN = N / BM; nwg = nM * nN; G = G_; c = c_; }
    __host__ __device__ bool next(int i, Unit& u) const {
        const long L = (long)i * G + c; if (L >= nwg) return false;
        int wgid = (int)L; { const int q = nwg / NXCD, r = nwg % NXCD, xcd = wgid % NXCD, off = wgid / NXCD; wgid = (xcd < r ? xcd * (q + 1) : r * (q + 1) + (xcd - r) * q) + off; }
        const int nig = WGM * nN, gid = wgid / nig, fm = gid * WGM, gsz = (nM - fm) < WGM ? (nM - fm) : WGM;
        u.pm = fm + ((wgid % nig) % gsz); u.pn = (wgid % nig) / gsz; return true;
    }
    __device__ __forceinline__ void a_ready(const Unit&) const {}
    __device__ __forceinline__ void done(const Unit&) const {}
};

__device__ __forceinline__ unsigned cvt_pk_bf16(float lo, float hi) { unsigned r; asm volatile("v_cvt_pk_bf16_f32 %0, %1, %2" : "=v"(r) : "v"(lo), "v"(hi)); return r; }
typedef float f32x2v __attribute__((ext_vector_type(2)));
typedef unsigned u32x2v __attribute__((ext_vector_type(2)));
typedef __bf16 bf16x2v __attribute__((ext_vector_type(2)));
__device__ __forceinline__ unsigned pkbf(float lo, float hi) { f32x2v v = {lo, hi}; bf16x2v b = __builtin_convertvector(v, bf16x2v); return __builtin_bit_cast(unsigned, b); }
__device__ __forceinline__ float swap_sum16(float x) { return x + __shfl_xor(x, 16); }
__device__ __forceinline__ float swap_sum32(float x) { return x + __shfl_xor(x, 32); }
constexpr int E_SEQ = 16384, E_MT = 16640;
constexpr size_t E_SLOT = (size_t)E_MT * 64;
constexpr float E_C2 = 0.125f * 1.4426950408889634f;

struct EpiQKV {
    static constexpr bool PERM = true, AFTER_DRAIN = false;
    bf16_t* qkv; const float *gq0, *gk0, *gq1, *gk1; const float* rope; int isC;
    __device__ __forceinline__ void operator()(const f32x4 (&acc)[2][2][4][2], const Unit& u, int wr, int wc, int fr, int fq) const {
        const int gi = u.pn * 4 + wc;
        int type; const float* gain = gq0; bf16_t* out; int pitch = 64;
        if (!isC) {
            if (gi < 8) { type = 0; gain = gq0; } else if (gi < 10) { type = 1; gain = gk0; } else if (gi < 12) { type = 2; }
            else if (gi < 20) { type = 0; gain = gq1; } else if (gi < 22) { type = 1; gain = gk1; } else { type = 2; }
            out = qkv + (size_t)gi * E_SLOT;
        } else {
            if (gi < 16) { type = 0; gain = gq0; out = qkv + (size_t)gi * E_SLOT; }
            else if (gi < 32) { type = 1; gain = gk0; out = qkv + (size_t)gi * E_SLOT; }
            else { type = 2; const int vg = gi - 32; out = qkv + (size_t)(32 + 2 * (vg >> 1)) * E_SLOT + (vg & 1) * 64; pitch = 128; }
        }
        const int rowbase = u.pm * BM + wr * 64 + fr;
        if (type < 2) {
            f32x4 g[2][2];
#pragma unroll
            for (int bj = 0; bj < 2; ++bj)
#pragma unroll
                for (int n = 0; n < 2; ++n) g[bj][n] = *(const f32x4*)(gain + bj * 32 + 8 * fq + 4 * n);
            const float qs = (type == 0) ? E_C2 : 1.f;
#pragma unroll
            for (int ai = 0; ai < 2; ++ai)
#pragma unroll
                for (int m = 0; m < 4; ++m) {
                    const int r = rowbase + ai * HALF + m * 16;
                    f32x4 v[2][2];
#pragma unroll
                    for (int bj = 0; bj < 2; ++bj)
#pragma unroll
                        for (int n = 0; n < 2; ++n) v[bj][n] = acc[ai][bj][m][n];
                    float ss = 0.f;
#pragma unroll
                    for (int bj = 0; bj < 2; ++bj)
#pragma unroll
                        for (int n = 0; n < 2; ++n) ss += (v[bj][n][0] * v[bj][n][0] + v[bj][n][1] * v[bj][n][1]) + (v[bj][n][2] * v[bj][n][2] + v[bj][n][3] * v[bj][n][3]);
                    ss = swap_sum16(ss); ss = swap_sum32(ss);
                    const float rstd = __builtin_amdgcn_rsqf(ss * (1.f / 64.f) + 1e-6f) * qs;
#pragma unroll
                    for (int bj = 0; bj < 2; ++bj)
#pragma unroll
                        for (int n = 0; n < 2; ++n) v[bj][n] = v[bj][n] * rstd * g[bj][n];
                    const int rr = (r < E_SEQ) ? r : 0;
                    const float* tb = (fq < 2) ? (rope + (rr >> 6) * 16 + 8 * fq) : (rope + 8192 + (rr & 63) * 16 + 8 * (fq - 2));
                    const int so = (fq < 2) ? 4096 : 1024;
#pragma unroll
                    for (int n = 0; n < 2; ++n) {
                        f32x4 cs = *(const f32x4*)(tb + 4 * n), sn = *(const f32x4*)(tb + so + 4 * n);
                        if (r >= E_SEQ) { cs = (f32x4){1.f, 1.f, 1.f, 1.f}; sn = (f32x4){0.f, 0.f, 0.f, 0.f}; }
                        const f32x4 y1 = v[0][n], y2 = v[1][n];
                        v[0][n] = y1 * cs - y2 * sn; v[1][n] = y2 * cs + y1 * sn;
                    }
#pragma unroll
                    for (int bj = 0; bj < 2; ++bj) {
                        u32x4 w; w.x = pkbf(v[bj][0][0], v[bj][0][1]); w.y = pkbf(v[bj][0][2], v[bj][0][3]); w.z = pkbf(v[bj][1][0], v[bj][1][1]); w.w = pkbf(v[bj][1][2], v[bj][1][3]);
                        *(u32x4*)(out + (size_t)r * 64 + bj * 32 + 8 * fq) = w;
                    }
                }
        } else {
#pragma unroll
            for (int ai = 0; ai < 2; ++ai)
#pragma unroll
                for (int m = 0; m < 4; ++m) {
                    const int r = rowbase + ai * HALF + m * 16;
#pragma unroll
                    for (int bj = 0; bj < 2; ++bj) {
                        const f32x4 v0 = acc[ai][bj][m][0], v1 = acc[ai][bj][m][1];
                        u32x4 w; w.x = pkbf(v0[0], v0[1]); w.y = pkbf(v0[2], v0[3]); w.z = pkbf(v1[0], v1[1]); w.w = pkbf(v1[2], v1[3]);
                        *(u32x4*)(out + (size_t)r * pitch + bj * 32 + 8 * fq) = w;
                    }
                }
        }
    }
};

constexpr size_t E_SL8 = (size_t)E_MT * 64;
constexpr size_t E_VT_AB = (size_t)260 * 64 * 64, E_VT_C = (size_t)260 * 128 * 64;
__device__ __forceinline__ unsigned pk4_e4m3(float a, float b, float c, float d) { int w = __builtin_amdgcn_cvt_pk_fp8_f32(a, b, 0, false); w = __builtin_amdgcn_cvt_pk_fp8_f32(c, d, w, true); return (unsigned)w; }
#ifndef QK16
#define QK16 0
#endif
typedef unsigned u32x4v __attribute__((ext_vector_type(4)));
#ifndef V_QUAD
#define V_QUAD 0
#endif
#ifndef QKV_NOV
#define QKV_NOV 0
#endif
struct EpiQKV8 {
    static constexpr bool PERM = true, AFTER_DRAIN = false;
    unsigned char* q8; const float *gq0, *gk0, *gq1, *gk1; const float* rope; int isC;
    __device__ __forceinline__ void operator()(const f32x4 (&acc)[2][2][4][2], const Unit& u, int wr, int wc, int fr, int fq) const {
        const int gi = u.pn * 4 + wc;
        int type; const float* gain = gq0; unsigned char* out = q8 + (size_t)gi * E_SL8; int dv = 64, dbase = 0;
        if (!isC) {
            if (gi < 8) { type = 0; gain = gq0; } else if (gi < 10) { type = 1; gain = gk0; } else if (gi < 12) { type = 2; out = q8 + 24 * E_SL8 + (size_t)(gi - 10) * E_VT_AB; }
            else if (gi < 20) { type = 0; gain = gq1; } else if (gi < 22) { type = 1; gain = gk1; } else { type = 2; out = q8 + 24 * E_SL8 + (size_t)(gi - 20) * E_VT_AB; }
        } else {
            if (gi < 16) { type = 0; gain = gq0; } else if (gi < 32) { type = 1; gain = gk0; }
            else { type = 2; const int vg = gi - 32; out = q8 + 32 * E_SL8 + (size_t)(vg >> 1) * E_VT_C; dv = 128; dbase = (vg & 1) * 64; }
        }
        const int rowbase = u.pm * BM + wr * 64 + fr;
        if (type < 2) {
            f32x4 g[2][2];
#pragma unroll
            for (int bj = 0; bj < 2; ++bj)
#pragma unroll
                for (int n = 0; n < 2; ++n) g[bj][n] = *(const f32x4*)(gain + bj * 32 + 8 * fq + 4 * n);
            const float qs = (type == 0) ? 4.f * E_C2 : 1.f;
#pragma unroll
            for (int ai = 0; ai < 2; ++ai)
#pragma unroll
                for (int m = 0; m < 4; ++m) {
                    const int r = rowbase + ai * HALF + m * 16;
                    f32x4 v[2][2];
#pragma unroll
                    for (int bj = 0; bj < 2; ++bj)
#pragma unroll
                        for (int n = 0; n < 2; ++n) v[bj][n] = acc[ai][bj][m][n];
                    float ss = 0.f;
#pragma unroll
                    for (int bj = 0; bj < 2; ++bj)
#pragma unroll
                        for (int n = 0; n < 2; ++n) ss += (v[bj][n][0] * v[bj][n][0] + v[bj][n][1] * v[bj][n][1]) + (v[bj][n][2] * v[bj][n][2] + v[bj][n][3] * v[bj][n][3]);
                    ss = swap_sum16(ss); ss = swap_sum32(ss);
                    const float rstd = __builtin_amdgcn_rsqf(ss * (1.f / 64.f) + 1e-6f) * qs;
#pragma unroll
                    for (int bj = 0; bj < 2; ++bj)
#pragma unroll
                        for (int n = 0; n < 2; ++n) v[bj][n] = v[bj][n] * rstd * g[bj][n];
                    const int rr = (r < E_SEQ) ? r : 0;
                    const float* tb = (fq < 2) ? (rope + (rr >> 6) * 16 + 8 * fq) : (rope + 8192 + (rr & 63) * 16 + 8 * (fq - 2));
                    const int so = (fq < 2) ? 4096 : 1024;
#pragma unroll
                    for (int n = 0; n < 2; ++n) {
                        f32x4 cs = *(const f32x4*)(tb + 4 * n), sn = *(const f32x4*)(tb + so + 4 * n);
                        if (r >= E_SEQ) { cs = (f32x4){1.f, 1.f, 1.f, 1.f}; sn = (f32x4){0.f, 0.f, 0.f, 0.f}; }
                        const f32x4 y1 = v[0][n], y2 = v[1][n];
                        v[0][n] = y1 * cs - y2 * sn; v[1][n] = y2 * cs + y1 * sn;
                    }
#if QK16
                    { u32x4v w; w.x = pk4_e4m3(v[0][0][0], v[0][0][1], v[0][0][2], v[0][0][3]); w.y = pk4_e4m3(v[0][1][0], v[0][1][1], v[0][1][2], v[0][1][3]);
                      w.z = pk4_e4m3(v[1][0][0], v[1][0][1], v[1][0][2], v[1][0][3]); w.w = pk4_e4m3(v[1][1][0], v[1][1][1], v[1][1][2], v[1][1][3]);
                      if (QKV_NOV < 2) *(u32x4v*)(out + (size_t)r * 64 + 16 * fq) = w; }
#else
#pragma unroll
                    for (int bj = 0; bj < 2; ++bj) {
                        u32x2v w; w.x = pk4_e4m3(v[bj][0][0], v[bj][0][1], v[bj][0][2], v[bj][0][3]); w.y = pk4_e4m3(v[bj][1][0], v[bj][1][1], v[bj][1][2], v[bj][1][3]);
                        if (QKV_NOV < 2) *(u32x2v*)(out + (size_t)r * 64 + bj * 32 + 8 * fq) = w;
                    }
#endif
                }
        } else {
#pragma unroll
            for (int ai = 0; ai < 2; ++ai)
#pragma unroll
                for (int m = 0; m < 4; ++m) {
                    const int r = rowbase + ai * HALF + m * 16;
                    const int pos = 32 * ((fr >> 2) & 1) + (fr & 3) + 4 * (2 * (m & 1) + (fr >> 3)) + 16 * (m >> 1);
#if V_QUAD
                    const unsigned sel1 = (fr & 1) ? 0x03070105u : 0x06020400u, sel2 = (fr & 2) ? 0x03020706u : 0x05040100u;
                    unsigned char* rq = out + ((size_t)(r >> 6) * dv + dbase + 8 * fq + (fr & 3)) * 64 + (pos & ~3);
#pragma unroll
                    for (int bj = 0; bj < 2; ++bj)
#pragma unroll
                        for (int n = 0; n < 2; ++n) { const unsigned w = pk4_e4m3(acc[ai][bj][m][n][0], acc[ai][bj][m][n][1], acc[ai][bj][m][n][2], acc[ai][bj][m][n][3]);
                            const unsigned t1 = (unsigned)__builtin_amdgcn_mov_dpp((int)w, 0xB1, 0xF, 0xF, true);
                            const unsigned x1 = __builtin_amdgcn_perm(t1, w, sel1);
                            const unsigned t2 = (unsigned)__builtin_amdgcn_mov_dpp((int)x1, 0x4E, 0xF, 0xF, true);
                            const unsigned x2 = __builtin_amdgcn_perm(t2, x1, sel2);
                            if (!QKV_NOV) *(unsigned*)(rq + (size_t)(bj * 32 + 4 * n) * 64) = x2; }
#else
                    unsigned char* rp = out + ((size_t)(r >> 6) * dv + dbase + 8 * fq) * 64 + pos;
#pragma unroll
                    for (int bj = 0; bj < 2; ++bj)
#pragma unroll
                        for (int n = 0; n < 2; ++n) { const unsigned w = pk4_e4m3(acc[ai][bj][m][n][0], acc[ai][bj][m][n][1], acc[ai][bj][m][n][2], acc[ai][bj][m][n][3]);
#pragma unroll
                            for (int e = 0; e < 4; ++e) if (!QKV_NOV) rp[(size_t)(bj * 32 + 4 * n + e) * 64] = (unsigned char)(w >> (8 * e)); }
#endif
                }
        }
    }
};

struct EpiResid {
    static constexpr bool PERM = true, AFTER_DRAIN = false;
    float* x; const float* gate_lat; const float* gate_ctx;
    __device__ __forceinline__ void operator()(const f32x4 (&acc)[2][2][4][2], const Unit& u, int wr, int wc, int fr, int fq) const {
        const float* gate = (u.pm == 64) ? gate_ctx : gate_lat;
        const int col0 = u.pn * BM + wc * 32 + 8 * fq, rowbase = u.pm * BM + wr * 64 + fr;
        f32x4 gv[2][2];
#pragma unroll
        for (int bj = 0; bj < 2; ++bj)
#pragma unroll
            for (int n = 0; n < 2; ++n) gv[bj][n] = *(const f32x4*)(gate + col0 + bj * HALF + 4 * n);
#pragma unroll
        for (int ai = 0; ai < 2; ++ai)
#pragma unroll
            for (int m = 0; m < 4; ++m) {
                float* xr = x + (size_t)(rowbase + ai * HALF + m * 16) * 1024 + col0;
#pragma unroll
                for (int bj = 0; bj < 2; ++bj)
#pragma unroll
                    for (int n = 0; n < 2; ++n) { f32x4 xv = *(f32x4*)(xr + bj * HALF + 4 * n); xv = xv + gv[bj][n] * acc[ai][bj][m][n]; *(f32x4*)(xr + bj * HALF + 4 * n) = xv; }
            }
    }
};

struct EpiSwiGLU {
    static constexpr bool PERM = true, AFTER_DRAIN = false;
    bf16_t* H; int fp8;
    __device__ __forceinline__ void operator()(const f32x4 (&acc)[2][2][4][2], const Unit& u, int wr, int wc, int fr, int fq) const {
        const int col0 = (u.pn & 3) * 128 + wc * 32 + 8 * fq, rowbase = u.pm * BM + wr * 64 + fr;
#pragma unroll
        for (int ai = 0; ai < 2; ++ai)
#pragma unroll
            for (int m = 0; m < 4; ++m) {
                float h[8];
#pragma unroll
                for (int n = 0; n < 2; ++n)
#pragma unroll
                    for (int e = 0; e < 4; ++e) { const float a = acc[ai][0][m][n][e], b = acc[ai][1][m][n][e];
                        h[4 * n + e] = a * b * __builtin_amdgcn_rcpf(1.f + __builtin_amdgcn_exp2f(-1.4426950408889634f * a)); }
                if (fp8) { u32x2v w; w.x = pk4_e4m3(h[0], h[1], h[2], h[3]); w.y = pk4_e4m3(h[4], h[5], h[6], h[7]);
                    *(u32x2v*)((unsigned char*)H + (size_t)(rowbase + ai * HALF + m * 16) * 512 + col0) = w; }
                else { u32x4 w; w.x = pkbf(h[0], h[1]); w.y = pkbf(h[2], h[3]); w.z = pkbf(h[4], h[5]); w.w = pkbf(h[6], h[7]);
                    *(u32x4*)(H + (size_t)(rowbase + ai * HALF + m * 16) * 512 + col0) = w; }
            }
    }
};

struct EpiY {
    static constexpr bool PERM = true, AFTER_DRAIN = false;
    bf16_t* Y; const float* rw;
    __device__ __forceinline__ void operator()(const f32x4 (&acc)[2][2][4][2], const Unit& u, int wr, int wc, int fr, int fq) const {
        const int col0 = (u.pn & 3) * BM + wc * 32 + 8 * fq, rowbase = u.pm * BM + wr * 64 + fr;
#pragma unroll
        for (int ai = 0; ai < 2; ++ai)
#pragma unroll
            for (int m = 0; m < 4; ++m) {
                const int r = rowbase + ai * HALF + m * 16; const float w8 = rw[r];
#pragma unroll
                for (int bj = 0; bj < 2; ++bj) { const f32x4 v0 = acc[ai][bj][m][0] * w8, v1 = acc[ai][bj][m][1] * w8;
                    u32x4 w; w.x = pkbf(v0[0], v0[1]); w.y = pkbf(v0[2], v0[3]); w.z = pkbf(v1[0], v1[1]); w.w = pkbf(v1[2], v1[3]);
                    *(u32x4*)(Y + (size_t)r * 1024 + col0 + bj * HALF) = w; }
            }
    }
};

struct MoeOrder {
    const PG8_LAS int* tile_e; int nunits, G, c;
    __device__ __forceinline__ bool next(int i, Unit& u) const {
        const int L = i * G + c; if (L >= nunits) return false;
        const int pm = L >> 2; const int e = tile_e[pm];
        u.pm = __builtin_amdgcn_readfirstlane(pm); u.pn = __builtin_amdgcn_readfirstlane(e * 4 + (L & 3)); return true;
    }
    __device__ __forceinline__ void a_ready(const Unit&) const {}
    __device__ __forceinline__ void done(const Unit&) const {}
};

typedef int v8i_t __attribute__((ext_vector_type(8)));
struct bf16x8x2 { bf16x8 a, b; };
__device__ __forceinline__ f32x4 mfma_bf16_sel(bf16x8 a, bf16x8 b, f32x4 c) { return __builtin_amdgcn_mfma_f32_16x16x32_bf16(a, b, c, 0, 0, 0); }
__device__ __forceinline__ f32x4 mfma_bf16_sel(v8i_t, v8i_t, f32x4 c) { return c; }
template <bool F8> struct FragT { typedef bf16x8 type; };
template <> struct FragT<true> { typedef v8i_t type; };
template <class Epi, class Sched, bool ALIGN_EPI = false, bool SP2 = false, bool FP8 = false>
__device__ __forceinline__ void gemm_phase(PG8_LAS unsigned char* lds, const Gemm g, const Sched& S, const Epi& E) {
    int tid_ = threadIdx.x; asm volatile("" : "+v"(tid_)); __builtin_assume(tid_ >= 0 && tid_ < 512);
    const int tid = tid_, wid = __builtin_amdgcn_readfirstlane(tid >> 6), lane = tid & 63, wr = wid >> 2, wc = wid & 3, fr = lane & 15, fq = lane >> 4;
    const int K = FP8 ? g.K / 2 : g.K, nt = K / BK;
    unsigned voffA[2], voffB[2];
#pragma unroll
    for (int i = 0; i < 2; ++i) { int R, C; stage_rc(tid * 16 + i * 8192, R, C); const int Rb = Epi::PERM ? ((R & ~31) + perm32(R & 31)) : R;
        voffA[i] = (unsigned)(R * K + C) * 2u; voffB[i] = (unsigned)(Rb * K + C) * 2u; }
    const size_t kstep = (size_t)(BK * 2);
    const size_t hstep = (size_t)HALF * K * 2;
    const size_t tstep = 2 * hstep;
    const unsigned ldsw = (unsigned)wid * 1024u;
    const int aoff = lds_byte(wr * 64 + fr, fq * (FP8 ? 16 : 8)), boff = lds_byte(wc * 32 + fr, fq * (FP8 ? 16 : 8));
    constexpr int KOFF = FP8 ? 16 : 1024;
#define PG8_SA(b, h) (((b) * 2 + (h)) * HTB)
#define PG8_SB(b, h) ((4 + (b) * 2 + (h)) * HTB)
#define PG8_STAGE(bufoff, gbase, voff) do { _Pragma("unroll") for (int _i = 0; _i < 2; ++_i) \
        __builtin_amdgcn_global_load_lds((const unsigned*)((const char*)(gbase) + (voff)[_i]), (PG8_LAS unsigned*)(lds + (bufoff) + ldsw + _i * 8192), 16, 0, 0); } while (0)
#define PG8_LDA(dst, b, h) do { _Pragma("unroll") for (int m = 0; m < 4; ++m) _Pragma("unroll") for (int k = 0; k < 2; ++k) dst[m][k] = *(const PG8_LAS bf16x8*)(lds + PG8_SA(b, h) + aoff + m * 2048 + k * KOFF); } while (0)
#define PG8_LDB(dst, b, h) do { _Pragma("unroll") for (int n = 0; n < 2; ++n) _Pragma("unroll") for (int k = 0; k < 2; ++k) dst[n][k] = *(const PG8_LAS bf16x8*)(lds + PG8_SB(b, h) + boff + n * 2048 + k * KOFF); } while (0)
#define PG8_MMA(ai, bj, At, Bt) do { __builtin_amdgcn_s_setprio(1); _Pragma("unroll") for (int m = 0; m < 4; ++m) _Pragma("unroll") for (int n = 0; n < 2; ++n) { \
        if constexpr (FP8) { asm volatile("v_mfma_scale_f32_16x16x128_f8f6f4 %0, %1, %2, %0, %3, %3 op_sel_hi:[0,0,0]" : "+v"(acc[ai][bj][m][n]) : "v"(__builtin_bit_cast(v8i_t, (bf16x8x2){Bt[n][0], Bt[n][1]})), "v"(__builtin_bit_cast(v8i_t, (bf16x8x2){At[m][0], At[m][1]})), "v"(mxsc)); } \
        else { _Pragma("unroll") for (int k = 0; k < 2; ++k) acc[ai][bj][m][n] = mfma_bf16_sel(Bt[n][k], At[m][k], acc[ai][bj][m][n]); } } __builtin_amdgcn_s_setprio(0); } while (0)
#define PG8_WAIT_V(n) asm volatile("s_waitcnt vmcnt(" #n ")" ::: "memory")
#define PG8_WAIT_L(n) asm volatile("s_waitcnt lgkmcnt(" #n ")" ::: "memory")
#define PG8_BAR __builtin_amdgcn_s_barrier()
#define PG8_SCHED __builtin_amdgcn_sched_barrier(0)
    Unit cur, nxt; int ui = 0;
    if (!S.next(0, cur)) return;
    f32x4 acc[2][2][4][2];
#pragma unroll
    for (int a = 0; a < 2; ++a)
#pragma unroll
        for (int b = 0; b < 2; ++b)
#pragma unroll
            for (int m = 0; m < 4; ++m)
#pragma unroll
                for (int n = 0; n < 2; ++n) acc[a][b][m][n] = (f32x4){0.f, 0.f, 0.f, 0.f};
    int mxsc = 0x7F7F7F7F; asm volatile("" : "+v"(mxsc));
    bf16x8 At[4][2], B0[2][2], B1[2][2];
    const char* cA = (const char*)g.A + (size_t)cur.pm * tstep; const char* cB = (const char*)g.Bt + (size_t)cur.pn * tstep;
    S.a_ready(cur);
    if constexpr (SP2) {
        PG8_STAGE(PG8_SB(0, 0), cB, voffB); PG8_STAGE(PG8_SB(0, 1), cB + hstep, voffB); PG8_STAGE(PG8_SA(0, 0), cA, voffA); PG8_STAGE(PG8_SA(0, 1), cA + hstep, voffA);
        if (wr == 1) PG8_BAR;
        PG8_WAIT_V(2); PG8_BAR;
        PG8_STAGE(PG8_SB(1, 0), cB + kstep, voffB); PG8_STAGE(PG8_SA(1, 0), cA + kstep, voffA); PG8_STAGE(PG8_SB(1, 1), cB + hstep + kstep, voffB);
        PG8_WAIT_V(6); PG8_BAR;
    } else {
        PG8_STAGE(PG8_SB(0, 0), cB, voffB); PG8_STAGE(PG8_SA(0, 0), cA, voffA); PG8_STAGE(PG8_SB(0, 1), cB + hstep, voffB); PG8_STAGE(PG8_SA(0, 1), cA + hstep, voffA);
        if (wr == 1) PG8_BAR;
        PG8_WAIT_V(4); PG8_BAR;
        PG8_STAGE(PG8_SB(1, 0), cB + kstep, voffB); PG8_STAGE(PG8_SA(1, 0), cA + kstep, voffA); PG8_STAGE(PG8_SB(1, 1), cB + hstep + kstep, voffB);
        PG8_WAIT_V(6); PG8_BAR;
    }
    for (;;) {
        const bool has_next = S.next(ui + 1, nxt);
        const char* nA = has_next ? (const char*)g.A + (size_t)nxt.pm * tstep : cA; const char* nB = has_next ? (const char*)g.Bt + (size_t)nxt.pn * tstep : cB;
#pragma nounroll
        for (int t = 0; t < nt; t += 2) {
            const bool last = (t == nt - 2);
            const char* a1 = cA + (size_t)(t + 1) * kstep;
            const char* a2 = last ? nA : cA + (size_t)(t + 2) * kstep; const char* b2 = last ? nB : cB + (size_t)(t + 2) * kstep;
            const char* a3 = a2 + kstep; const char* b3 = b2 + kstep;
            if (last && has_next) S.a_ready(nxt);
            if constexpr (SP2) {
            PG8_LDB(B0, 0, 0); PG8_LDB(B1, 0, 1); PG8_SCHED; PG8_LDA(At, 0, 0); PG8_STAGE(PG8_SA(1, 1), a1 + hstep, voffA);
            PG8_WAIT_V(8); PG8_WAIT_L(0); PG8_BAR; PG8_MMA(0, 0, At, B0); PG8_MMA(0, 1, At, B1); PG8_BAR; PG8_SCHED;
            PG8_LDA(At, 0, 1); PG8_STAGE(PG8_SB(0, 0), b2, voffB); PG8_STAGE(PG8_SB(0, 1), b2 + hstep, voffB); PG8_STAGE(PG8_SA(0, 0), a2, voffA);
            PG8_WAIT_V(8); PG8_WAIT_L(0); PG8_BAR; PG8_MMA(1, 0, At, B0); PG8_MMA(1, 1, At, B1); PG8_BAR; PG8_SCHED;
            PG8_LDB(B0, 1, 0); PG8_LDB(B1, 1, 1); PG8_SCHED; PG8_LDA(At, 1, 0); PG8_STAGE(PG8_SA(0, 1), a2 + hstep, voffA);
            PG8_WAIT_V(8); PG8_WAIT_L(0); PG8_BAR; PG8_MMA(0, 0, At, B0); PG8_MMA(0, 1, At, B1); PG8_BAR; PG8_SCHED;
            PG8_LDA(At, 1, 1); PG8_STAGE(PG8_SB(1, 0), b3, voffB); PG8_STAGE(PG8_SB(1, 1), b3 + hstep, voffB); PG8_STAGE(PG8_SA(1, 0), a3, voffA);
            PG8_WAIT_V(8); PG8_WAIT_L(0); PG8_BAR; PG8_MMA(1, 0, At, B0); PG8_MMA(1, 1, At, B1); PG8_BAR; PG8_SCHED;
            } else {
            PG8_LDB(B0, 0, 0); PG8_SCHED; PG8_LDA(At, 0, 0); PG8_STAGE(PG8_SA(1, 1), a1 + hstep, voffA);
            PG8_WAIT_L(8); PG8_BAR; PG8_WAIT_L(0); PG8_MMA(0, 0, At, B0); PG8_BAR; PG8_SCHED;
            PG8_LDB(B1, 0, 1); PG8_STAGE(PG8_SB(0, 0), b2, voffB);
            PG8_BAR; PG8_WAIT_L(0); PG8_MMA(0, 1, At, B1); PG8_BAR;
            PG8_LDA(At, 0, 1); PG8_STAGE(PG8_SA(0, 0), a2, voffA);
            PG8_BAR; PG8_WAIT_L(0); PG8_MMA(1, 0, At, B0); PG8_BAR; PG8_SCHED;
            PG8_STAGE(PG8_SB(0, 1), b2 + hstep, voffB);
            PG8_WAIT_V(6); PG8_BAR; PG8_MMA(1, 1, At, B1); PG8_BAR;
            PG8_LDB(B0, 1, 0); PG8_SCHED; PG8_LDA(At, 1, 0); PG8_STAGE(PG8_SA(0, 1), a2 + hstep, voffA);
            PG8_WAIT_L(8); PG8_BAR; PG8_WAIT_L(0); PG8_MMA(0, 0, At, B0); PG8_BAR; PG8_SCHED;
            PG8_LDB(B1, 1, 1); PG8_STAGE(PG8_SB(1, 0), b3, voffB);
            PG8_BAR; PG8_WAIT_L(0); PG8_MMA(0, 1, At, B1); PG8_BAR;
            PG8_LDA(At, 1, 1); PG8_STAGE(PG8_SA(1, 0), a3, voffA);
            PG8_BAR; PG8_WAIT_L(0); PG8_MMA(1, 0, At, B0); PG8_BAR; PG8_SCHED;
            PG8_STAGE(PG8_SB(1, 1), b3 + hstep, voffB);
            PG8_WAIT_V(6); PG8_BAR; PG8_MMA(1, 1, At, B1); PG8_BAR;
            }
        }
        if constexpr (FP8) asm volatile("s_nop 15\n\ts_nop 7" ::: "memory");
        if constexpr (ALIGN_EPI) { if (wr == 0) PG8_BAR; }
        if constexpr (!Epi::AFTER_DRAIN) { E(acc, cur, wr, wc, fr, fq); S.done(cur); }
        if (!has_next) break;
#pragma unroll
        for (int a = 0; a < 2; ++a)
#pragma unroll
            for (int b = 0; b < 2; ++b)
#pragma unroll
                for (int m = 0; m < 4; ++m)
#pragma unroll
                    for (int n = 0; n < 2; ++n) acc[a][b][m][n] = (f32x4){0.f, 0.f, 0.f, 0.f};
        cur = nxt; cA = nA; cB = nB; ++ui;
        if constexpr (ALIGN_EPI) { if (wr == 1) PG8_BAR; }
    }
    PG8_WAIT_V(0);
    if constexpr (!ALIGN_EPI) { if (wr == 0) PG8_BAR; }
    PG8_BAR;
    if constexpr (Epi::AFTER_DRAIN) { E.fused(acc, cur, wr, wc, fr, fq, lds, wid, lane); S.done(cur); }
#undef PG8_SA
#undef PG8_SB
#undef PG8_STAGE
#undef PG8_LDA
#undef PG8_LDB
#undef PG8_MMA
#undef PG8_WAIT_V
#undef PG8_WAIT_L
#undef PG8_BAR
#undef PG8_SCHED
}
}
#define LAS __attribute__((address_space(3)))
#define XB_TMO      128
#define XB_XCNT(j)  (256  + 64 * (j))
#define XB_XSUB(j)  (1280 + 64 * (j))
#define XB_XGEN(j)  (2304 + 64 * (j))
#define XB_TOP      3328
#define XB_TOPGEN   3392
#define XCD_BAR_WORDS 3456
#define XB_SPIN_CAP (1u << 18)

__device__ __forceinline__ unsigned xb_ld(unsigned* p)              { return __hip_atomic_load(p, __ATOMIC_RELAXED, __HIP_MEMORY_SCOPE_AGENT); }
__device__ __forceinline__ unsigned xb_add(unsigned* p, unsigned v) { return __hip_atomic_fetch_add(p, v, __ATOMIC_RELAXED, __HIP_MEMORY_SCOPE_AGENT); }
__device__ __forceinline__ unsigned xb_xcc_id() { return (unsigned)__builtin_amdgcn_s_getreg((3 << 11) | 20) & 0xFu; }
#define XB_SPIN(cond, bar) do { unsigned _sp = 0; while (cond) { __builtin_amdgcn_s_sleep(1); \
    if ((++_sp & 255u) == 0u) { if (xb_ld(&(bar)[XB_TMO])) break; if (_sp > XB_SPIN_CAP) { atomicAdd(&(bar)[XB_TMO], 1u); break; } } } } while (0)

struct XcdBarrier {
    unsigned* bar; unsigned x;
    volatile LAS unsigned* st;
};

__device__ __forceinline__ XcdBarrier xcd_barrier_post(unsigned* bar, volatile LAS unsigned* st) {
    XcdBarrier b; b.bar = bar; b.x = xb_xcc_id(); b.st = st;
    if (threadIdx.x == 0) (void)xb_add(&bar[XB_XCNT(b.x)], 1u);
    return b;
}
__device__ __forceinline__ void xcd_barrier_complete(unsigned* bar, unsigned x, unsigned& nloc, unsigned& nx) {
    const unsigned G = gridDim.x * gridDim.y * gridDim.z;
    unsigned sum, cnt, mine, sp = 0u;
    for (;;) {
        sum = 0u; cnt = 0u; mine = 0u;
#pragma unroll
        for (unsigned j = 0; j < 16; ++j) { const unsigned c = xb_ld(&bar[XB_XCNT(j)]); sum += c; cnt += (c > 0u) ? 1u : 0u; mine = (j == x) ? c : mine; }
        if (sum == G) break;
        __builtin_amdgcn_s_sleep(1);
        if ((++sp & 255u) == 0u) { if (xb_ld(&bar[XB_TMO])) break; if (sp > XB_SPIN_CAP) { atomicAdd(&bar[XB_TMO], 1u); break; } }
    }
    nloc = mine > 0u ? mine : 1u; nx = cnt > 0u ? cnt : 1u;
}

__device__ __forceinline__ void xcd_barrier(const XcdBarrier& b) {
    asm volatile("s_waitcnt vmcnt(0)" ::: "memory");
    __syncthreads();
    if (threadIdx.x == 0) {
        unsigned* bar = b.bar;
        __builtin_amdgcn_s_waitcnt(0);
        unsigned nloc = b.st[0], nx = b.st[1];
        if (nloc == 0u) { xcd_barrier_complete(bar, b.x, nloc, nx); b.st[0] = nloc; b.st[1] = nx; }
        const unsigned old = xb_add(&bar[XB_XSUB(b.x)], 1u);
        const unsigned gen = old / nloc;
        if (old + 1u == (gen + 1u) * nloc) {
            __builtin_amdgcn_fence(__ATOMIC_RELEASE, "agent");
            asm volatile("s_waitcnt vmcnt(0)" ::: "memory");
            const unsigned og = xb_add(&bar[XB_TOP], 1u);
            const unsigned tg = og / nx;
            if (og + 1u == (tg + 1u) * nx) xb_add(&bar[XB_TOPGEN], 1u);
            else XB_SPIN(xb_ld(&bar[XB_TOPGEN]) == tg, bar);
            __builtin_amdgcn_fence(__ATOMIC_ACQUIRE, "agent");
            xb_add(&bar[XB_XGEN(b.x)], 1u);
            asm volatile("s_waitcnt vmcnt(0)" ::: "memory");
        } else {
            XB_SPIN(xb_ld(&bar[XB_XGEN(b.x)]) == gen, bar);
            __builtin_amdgcn_fence(__ATOMIC_ACQUIRE, "agent");
            asm volatile("s_waitcnt vmcnt(0)" ::: "memory");
        }
    }
    __syncthreads();
}

#ifndef GEMM_FP8
#define GEMM_FP8 1
#endif
#ifndef FP8_B
#define FP8_B 1
#define FP8_B_UNUSED GEMM_FP8
#endif
#ifndef FP8_G
#define FP8_G GEMM_FP8
#endif
#ifndef FP8_H
#define FP8_H GEMM_FP8
#endif
#ifndef USE_FP8
#define USE_FP8 1
#endif
#ifndef ATT_TIMING
#define ATT_TIMING 0
#endif
#define GAS __attribute__((address_space(1)))
typedef unsigned short bf16;
typedef float f32x4 __attribute__((ext_vector_type(4)));
typedef float f32x16 __attribute__((ext_vector_type(16)));
typedef short bf16x8 __attribute__((ext_vector_type(8)));
typedef short s16x4 __attribute__((ext_vector_type(4)));
typedef short v4i16_t __attribute__((ext_vector_type(4)));
typedef unsigned u32x4 __attribute__((ext_vector_type(4)));
typedef unsigned u32x2 __attribute__((ext_vector_type(2)));
using pg8::pkbf;

constexpr int DM = 1024, SEQ = 16384, CTXL = 256, MT = SEQ + CTXL, DEPTH = 4, NEXP = 32, DEXP = 512;
constexpr int XG_ROWS = 41472;
constexpr size_t SLOT = (size_t)MT * 64;
constexpr float LOG2E = 1.4426950408889634f, RMS_EPS = 1e-6f;
constexpr int NWAVES = 8, NTHREADS = 512;

constexpr size_t MiB = 1u << 20;
constexpr size_t WS_CTL = 0, CTL_ZERO_BYTES = 1 * MiB;
constexpr size_t WS_MOD = 1 * MiB;
constexpr size_t WS_ROPE = 1 * MiB + 512 * 1024;
constexpr size_t WS_BT_INAB = 2 * MiB, WS_BT_OUTAB = 8 * MiB, WS_BT_INC = 12 * MiB, WS_BT_OUTC = 24 * MiB;
constexpr size_t WS_BT_W13 = 32 * MiB, WS_BT_W2 = 288 * MiB;
constexpr size_t WS_XCUR = 416 * MiB, WS_HB = 481 * MiB, WS_QKV = 514 * MiB, WS_OB = 612 * MiB, WS_O1S = 645 * MiB;
constexpr size_t WS_XG = 710 * MiB, WS_HG = 791 * MiB, WS_YG = 832 * MiB, WS_ROUTE = 913 * MiB, WS_END = 915 * MiB;
constexpr size_t RT_WTR = 1408 * 1024;
constexpr size_t RT_TOKE = 0, RT_TOKP = 256 * 1024, RT_TOKW = 512 * 1024, RT_DROW = 768 * 1024, RT_RW = 1024 * 1024, RT_TILE = 1280 * 1024, RT_NT = 1280 * 1024 + 4096;
static_assert(WS_BT_W13 + (size_t)DEPTH * NEXP * 1024 * 1024 * 2 <= WS_BT_W2 && WS_BT_W2 + (size_t)DEPTH * NEXP * 1024 * 512 * 2 <= WS_XCUR, "ws map");
static_assert(WS_XCUR + (size_t)MT * DM * 4 <= WS_HB && WS_HB + (size_t)MT * DM * 2 <= WS_QKV && WS_QKV + 48 * SLOT * 2 <= WS_OB && WS_OB + (size_t)MT * DM * 2 <= WS_O1S, "ws map");
static_assert(WS_O1S + (size_t)520 * 131072 <= WS_XG && WS_XG + (size_t)XG_ROWS * DM * 2 <= WS_HG && WS_HG + (size_t)XG_ROWS * DEXP * 2 <= WS_YG && WS_YG + (size_t)XG_ROWS * DM * 2 <= WS_ROUTE, "ws map");
constexpr int CW_BAR = 4096, CW_CNT = 150016, CW_DIAG = 32768;

constexpr int LDS_STAGE = 73728, LDS_WSF = 139264, LDS_RW = 0  , LDS_PAR = 148480  , LDSCTL_OFF = 156672, MISC_OFF = LDSCTL_OFF + 320, TAB_OFF = LDSCTL_OFF + 1024, LDS_XCH = LDSCTL_OFF + 3072  , LDS_BYTES = 160768;
static_assert(TAB_OFF + 1024 + 64 <= LDS_BYTES, "LDS map");

constexpr int NPH = 2 + 8 * DEPTH;

#define LDS_WAIT() asm volatile("s_waitcnt lgkmcnt(0)" ::: "memory")
__device__ __forceinline__ float dpp_sum16(float v);
__device__ __forceinline__ float wave_sum(float v) { v = dpp_sum16(v); v += __shfl_xor(v, 16); v += __shfl_xor(v, 32); return v; }
__device__ __forceinline__ float dpp_sum16(float v) {
    v += __builtin_bit_cast(float, __builtin_amdgcn_update_dpp(0, __builtin_bit_cast(int, v), 0xB1, 0xF, 0xF, true));
    v += __builtin_bit_cast(float, __builtin_amdgcn_update_dpp(0, __builtin_bit_cast(int, v), 0x4E, 0xF, 0xF, true));
    v += __builtin_bit_cast(float, __builtin_amdgcn_update_dpp(0, __builtin_bit_cast(int, v), 0x141, 0xF, 0xF, true));
    v += __builtin_bit_cast(float, __builtin_amdgcn_update_dpp(0, __builtin_bit_cast(int, v), 0x140, 0xF, 0xF, true));
    return v;
}
__device__ __forceinline__ float bf2f(unsigned short u) { return __builtin_bit_cast(float, (unsigned)u << 16); }
__device__ __forceinline__ float bflo(unsigned u) { return __builtin_bit_cast(float, u << 16); }
__device__ __forceinline__ float bfhi(unsigned u) { return __builtin_bit_cast(float, u & 0xffff0000u); }

__device__ __forceinline__ void transpose_item(const float* W, int ldw, int srccol0, bf16* WT, int K, int dstrow0, int k0, LAS float* scr, int lane) {
    { f32x4 v[8]; const int rr = lane >> 3, cs = lane & 7;
#pragma unroll
      for (int i = 0; i < 8; ++i) v[i] = *(const GAS f32x4*)(W + (size_t)(k0 + 8 * i + rr) * ldw + srccol0 + 4 * cs);
#pragma unroll
      for (int i = 0; i < 8; ++i) { LAS float* d = scr + (8 * i + rr) * 33 + 4 * cs; d[0] = v[i][0]; d[1] = v[i][1]; d[2] = v[i][2]; d[3] = v[i][3]; } }
    LDS_WAIT(); asm volatile("" ::: "memory");
    const int c = lane & 7;
#pragma unroll
    for (int j = 0; j < 4; ++j) { const int n = (lane >> 3) + 8 * j; const LAS float* s = scr + (8 * c) * 33 + n;
        u32x4 o; o.x = pkbf(s[0 * 33], s[1 * 33]); o.y = pkbf(s[2 * 33], s[3 * 33]); o.z = pkbf(s[4 * 33], s[5 * 33]); o.w = pkbf(s[6 * 33], s[7 * 33]);
        *(GAS u32x4*)(WT + (size_t)(dstrow0 + n) * K + k0 + 8 * c) = o; }
    LDS_WAIT(); asm volatile("" ::: "memory");
}

__device__ __forceinline__ void transpose_item8(const float* W, int ldw, int srccol0, unsigned char* WT, int K, int dstrow0, int k0, LAS float* scr, int lane) {
    { f32x4 v[8]; const int rr = lane >> 3, cs = lane & 7;
#pragma unroll
      for (int i = 0; i < 8; ++i) v[i] = *(const GAS f32x4*)(W + (size_t)(k0 + 8 * i + rr) * ldw + srccol0 + 4 * cs);
#pragma unroll
      for (int i = 0; i < 8; ++i) { LAS float* d = scr + (8 * i + rr) * 33 + 4 * cs; d[0] = v[i][0]; d[1] = v[i][1]; d[2] = v[i][2]; d[3] = v[i][3]; } }
    LDS_WAIT(); asm volatile("" ::: "memory");
    const int c = lane & 7;
#pragma unroll
    for (int j = 0; j < 4; ++j) { const int n = (lane >> 3) + 8 * j; const LAS float* s = scr + (8 * c) * 33 + n;
        u32x2 o; o.x = pg8::pk4_e4m3(s[0 * 33], s[1 * 33], s[2 * 33], s[3 * 33]); o.y = pg8::pk4_e4m3(s[4 * 33], s[5 * 33], s[6 * 33], s[7 * 33]);
        *(GAS u32x2*)(WT + (size_t)(dstrow0 + n) * K + k0 + 8 * c) = o; }
    LDS_WAIT(); asm volatile("" ::: "memory");
}

#ifndef AF_QKNOP
#define AF_QKNOP ""
#endif
#ifndef AF_D128_ORDER
#define AF_D128_ORDER 3
#endif
#if AF_D128_ORDER == 1
#define AF_D128_BODY(GL_) AF_PLn(); AF_PRIO_POST(); AF_PVn(0, vfa); vfa = AF_FRAG(vo_ + 4096); ATT_SBAR(); AF_PVn(1, vfb); vfb = AF_FRAG(vo_ + 6144); ATT_SBAR(); AF_EXP(P0, 0, 16); \
            if (GL_) { kf0 = AF_FRAG(kn_); ATT_SBAR(); } AF_PVn(2, vfa); AF_PVn(3, vfb); if (GL_) { kf1 = AF_FRAG(kn_ + 2048); ATT_SBAR(); } AF_EXP(P1, 0, 16);
#elif AF_D128_ORDER == 2
#define AF_D128_BODY(GL_) AF_PLn(); AF_PRIO_POST(); AF_PVn(0, vfa); vfa = AF_FRAG(vo_ + 4096); ATT_SBAR(); AF_EXP(P0, 0, 16); \
            AF_PVn(1, vfb); vfb = AF_FRAG(vo_ + 6144); ATT_SBAR(); if (GL_) { kf0 = AF_FRAG(kn_); ATT_SBAR(); } AF_EXP(P1, 0, 8); \
            AF_PVn(2, vfa); if (GL_) { kf1 = AF_FRAG(kn_ + 2048); ATT_SBAR(); } AF_EXP(P1, 8, 8); \
            AF_PVn(3, vfb);
#elif AF_D128_ORDER == 3
#define AF_D128_BODY(GL_) AF_PLn(); AF_PRIO_POST(); AF_PVn(0, vfa); vfa = AF_FRAG(vo_ + 4096); ATT_SBAR(); AF_PVn(1, vfb); vfb = AF_FRAG(vo_ + 6144); ATT_SBAR(); AF_EXP(P0, 0, 8); \
            if (GL_) { kf0 = AF_FRAG(kn_); ATT_SBAR(); } AF_PVn(2, vfa); AF_EXP(P0, 8, 8); \
            if (GL_) { kf1 = AF_FRAG(kn_ + 2048); ATT_SBAR(); } AF_PVn(3, vfb); AF_EXP(P1, 0, 16);
#else
#define AF_D128_BODY(GL_) AF_PLn(); AF_PRIO_POST(); AF_PVn(0, vfa); vfa = AF_FRAG(vo_ + 4096); ATT_SBAR(); AF_EXP(P0, 0, 8); \
            AF_PVn(1, vfb); vfb = AF_FRAG(vo_ + 6144); ATT_SBAR(); AF_EXP(P0, 8, 8); \
            if (GL_) { kf0 = AF_FRAG(kn_); ATT_SBAR(); } \
            AF_PVn(2, vfa); AF_EXP(P1, 0, 8); \
            if (GL_) { kf1 = AF_FRAG(kn_ + 2048); ATT_SBAR(); } \
            AF_PVn(3, vfb); AF_EXP(P1, 8, 8);
#endif
#ifndef AF_D64_SPLIT
#define AF_D64_SPLIT 0
#endif
#if AF_D64_SPLIT == 1
#define AF_D64_BODY(GL_) AF_PLn(); AF_PRIO_POST(); AF_PVn(0, vfa); AF_EXP(P0, 0, 8); AF_PVn(1, vfb); AF_EXP(P0, 8, 8); \
            if (GL_) { kf0 = AF_FRAG(kn_); kf1 = AF_FRAG(kn_ + 2048); ATT_SBAR(); } AF_EXP(P1, 0, 16);
#elif AF_D64_SPLIT == 2
#define AF_D64_BODY(GL_) AF_PLn(); AF_PRIO_POST(); AF_PVn(0, vfa); AF_EXP(P0, 0, 16); \
            if (GL_) { kf0 = AF_FRAG(kn_); kf1 = AF_FRAG(kn_ + 2048); ATT_SBAR(); } AF_EXP(P1, 0, 8); AF_PVn(1, vfb); AF_EXP(P1, 8, 8);
#elif AF_D64_SPLIT == 3
#define AF_D64_BODY(GL_) AF_PLn(); AF_PRIO_POST(); AF_PVn(0, vfa); AF_EXP(P0, 0, 16); \
            if (GL_) { kf0 = AF_FRAG(kn_); kf1 = AF_FRAG(kn_ + 2048); ATT_SBAR(); } AF_EXP(P1, 0, 16); AF_PVn(1, vfb);
#else
#define AF_D64_BODY(GL_) AF_PLn(); AF_PRIO_POST(); AF_PVn(0, vfa); AF_EXP(P0, 0, 16); \
            if (GL_) { kf0 = AF_FRAG(kn_); kf1 = AF_FRAG(kn_ + 2048); ATT_SBAR(); } AF_PVn(1, vfb); AF_EXP(P1, 0, 16);
#endif
#ifndef AF_PRIO_AFTER_PL
#define AF_PRIO_AFTER_PL 0
#endif
#if AF_PRIO_AFTER_PL
#define AF_PRIO_PRE() do { } while (0)
#define AF_PRIO_POST() __builtin_amdgcn_s_setprio(1)
#else
#define AF_PRIO_PRE() __builtin_amdgcn_s_setprio(1)
#define AF_PRIO_POST() do { } while (0)
#endif
#ifndef AF_PVNOP
#define AF_PVNOP ""
#define AF_PLNOP "s_nop 0\n\t"
#endif
#ifndef AF_NOPS
#define AF_NOPS "1"
#endif
namespace att {
typedef __attribute__((address_space(3))) const char* lds_cptr;
__device__ __forceinline__ int crow(int r, int hi) { return (r & 3) + 8 * (r >> 2) + 4 * hi; }
__device__ __forceinline__ void glds16(const void* gsrc, unsigned lds_dst) { unsigned keep;
    asm volatile("s_mov_b32 %0, m0\n\ts_mov_b32 m0, %2\n\ts_nop 0\n\tglobal_load_lds_dwordx4 %1, off\n\ts_mov_b32 m0, %0" : "=&s"(keep) : "v"(gsrc), "s"(lds_dst) : "memory"); }
__device__ __forceinline__ void glds16s(unsigned voff, const void* sbase, unsigned lds_dst) {
    asm volatile("s_mov_b32 m0, %2\n\ts_nop 0\n\tglobal_load_lds_dwordx4 %0, %1" :: "v"(voff), "s"(sbase), "s"(lds_dst) : "memory", "m0"); }
__device__ __forceinline__ const void* uniform_ptr(const void* p) { const unsigned long long v = (unsigned long long)p;
    return (const void*)(((unsigned long long)(unsigned)__builtin_amdgcn_readfirstlane((int)(v >> 32)) << 32) | (unsigned)__builtin_amdgcn_readfirstlane((int)(unsigned)v)); }
__device__ __forceinline__ s16x4 vtr(lds_cptr p) { return __builtin_bit_cast(s16x4, __builtin_amdgcn_ds_read_tr16_b64_v4i16((LAS v4i16_t*)p)); }
#if ATT_TIMING
#define ATT_WAITBAR(N) do { unsigned long long ta_, tb_; asm volatile("s_memtime %0\n\ts_waitcnt vmcnt(" #N ") lgkmcnt(0)\n\ts_barrier\n\ts_memtime %1\n\ts_waitcnt lgkmcnt(0)" : "=s"(ta_), "=s"(tb_) :: "memory"); att_twait += tb_ - ta_; } while (0)
#else
#define ATT_WAITBAR(N) asm volatile("s_waitcnt vmcnt(" #N ") lgkmcnt(0)\n\ts_barrier" ::: "memory")
#endif

template <int DV>
__device__ __forceinline__ void attn_pass(f32x16 (&o)[DV / 32], float& lsum, const bf16* Qw, const bf16* Kb, const bf16* Vb, int vpitch,
                                          int t0, int n1, int masked, int qpos, LAS unsigned char* lds, int wid, int lane) {
    constexpr int NV = DV / 64, KSLOT = 8192, VSLOT = DV * 128, LV = 3 * KSLOT;
    unsigned long long att_twait = 0; (void)att_twait;
    const int r32 = lane & 31, hi = lane >> 5, n = n1 + 4;
    const unsigned lds0 = (unsigned)(unsigned long)lds;
    bf16x8 qr[4];
#pragma unroll
    for (int d0 = 0; d0 < 4; ++d0) qr[d0] = *(const bf16x8*)(Qw + (size_t)r32 * 64 + d0 * 16 + hi * 8);
    const bf16* ksrc = Kb + (size_t)lane * 64 + wid * 8;
    const bf16* vsrc[NV];
#pragma unroll
    for (int j = 0; j < NV; ++j) { const int pi = wid + 8 * j, db = pi >> 2, kg = pi & 3; vsrc[j] = Vb + (size_t)(16 * kg + (lane >> 2)) * vpitch + db * 32 + (lane & 3) * 8; }
#define ATT_TILE(i_) ((i_) < n1 ? t0 + (i_) : 256 + (i_) - n1)
#define ATT_DMA(tl_, sl_) do { const int tl__ = (tl_); const int sl__ = (sl_); \
        glds16(ksrc + (size_t)tl__ * 4096, (unsigned)__builtin_amdgcn_readfirstlane(lds0 + sl__ * KSLOT + wid * 1024)); \
        _Pragma("unroll") for (int j_ = 0; j_ < NV; ++j_) glds16(vsrc[j_] + (size_t)tl__ * 64 * vpitch, (unsigned)__builtin_amdgcn_readfirstlane(lds0 + LV + sl__ * VSLOT + (wid + 8 * j_) * 1024)); } while (0)
    ATT_DMA(ATT_TILE(0), 0);
    if (n > 1) ATT_DMA(ATT_TILE(1), 1);
    int sl = 0, sl2 = 2;
    for (int i = 0; i < n; ++i) {
        if (i + 1 < n) { if (NV == 1) ATT_WAITBAR(2); else ATT_WAITBAR(3); } else ATT_WAITBAR(0);
        if (i + 2 < n) ATT_DMA(ATT_TILE(i + 2), sl2);
        const int tl = ATT_TILE(i);
        const lds_cptr kp = (lds_cptr)lds + sl * KSLOT + hi * 1024 + r32 * 16;
        bf16x8 kf[8];
#pragma unroll
        for (int d0 = 0; d0 < 4; ++d0) { kf[2 * d0] = *(const LAS bf16x8*)(kp + d0 * 2048); kf[2 * d0 + 1] = *(const LAS bf16x8*)(kp + d0 * 2048 + 512); }
        f32x16 p0 = {}, p1 = {};
#pragma unroll
        for (int d0 = 0; d0 < 4; ++d0) { p0 = __builtin_amdgcn_mfma_f32_32x32x16_bf16(kf[2 * d0], qr[d0], p0, 0, 0, 0); p1 = __builtin_amdgcn_mfma_f32_32x32x16_bf16(kf[2 * d0 + 1], qr[d0], p1, 0, 0, 0); }
#pragma unroll
        for (int r = 0; r < 16; ++r) { p0[r] = __builtin_amdgcn_exp2f(p0[r]); p1[r] = __builtin_amdgcn_exp2f(p1[r]); }
        if (masked && tl < 256) {
            const int kb = 64 * tl + 4 * hi - (qpos + r32) + 128;
#pragma unroll
            for (int r = 0; r < 16; ++r) { const int kv = kb + (r & 3) + 8 * (r >> 2); if ((unsigned)kv > 256u) p0[r] = 0.f; if ((unsigned)(kv + 32) > 256u) p1[r] = 0.f; }
        }
        float s0 = 0.f, s1 = 0.f;
#pragma unroll
        for (int r = 0; r < 16; ++r) { s0 += p0[r]; s1 += p1[r]; }
        lsum += s0 + s1;
        u32x4 pw[4];
#pragma unroll
        for (int k = 0; k < 2; ++k) {
            pw[k]     = (u32x4){pkbf(p0[8 * k], p0[8 * k + 1]), pkbf(p0[8 * k + 2], p0[8 * k + 3]), pkbf(p0[8 * k + 4], p0[8 * k + 5]), pkbf(p0[8 * k + 6], p0[8 * k + 7])};
            pw[2 + k] = (u32x4){pkbf(p1[8 * k], p1[8 * k + 1]), pkbf(p1[8 * k + 2], p1[8 * k + 3]), pkbf(p1[8 * k + 4], p1[8 * k + 5]), pkbf(p1[8 * k + 6], p1[8 * k + 7])};
        }
        const lds_cptr vp = (lds_cptr)lds + LV + sl * VSLOT + ((lane >> 4) & 1) * 32 + (lane & 3) * 8 + (4 * hi + ((lane & 15) >> 2)) * 64;
#pragma unroll
        for (int d0 = 0; d0 < DV / 32; ++d0) {
#pragma unroll
            for (int ks = 0; ks < 4; ++ks) {
                const s16x4 lo = vtr(vp + d0 * 4096 + ks * 1024), hh = vtr(vp + d0 * 4096 + ks * 1024 + 512);
                const bf16x8 vf = (bf16x8){lo[0], lo[1], lo[2], lo[3], hh[0], hh[1], hh[2], hh[3]};
                o[d0] = __builtin_amdgcn_mfma_f32_32x32x16_bf16(__builtin_bit_cast(bf16x8, pw[ks]), vf, o[d0], 0, 0, 0);
            }
            if (DV > 64) __builtin_amdgcn_sched_barrier(0);
        }
        sl = (sl == 2) ? 0 : sl + 1; sl2 = (sl2 == 2) ? 0 : sl2 + 1;
    }
    asm volatile("s_waitcnt lgkmcnt(0)\n\ts_barrier" ::: "memory");
#undef ATT_TILE
#undef ATT_DMA
}
#define ATT_SBAR() __builtin_amdgcn_sched_barrier(0)
template <int DV>
__device__ __forceinline__ void attn_pipe(f32x16 (&o)[DV / 32], float& l_out, const bf16* Qw, const bf16* Kb, const bf16* Vb, int vpitch,
                                          int t0, int n1, int masked, int qpos, LAS unsigned char* lds, int wid, int lane, unsigned long long* att_tm = nullptr) {
    constexpr int NV = DV / 64, KSLOT = 8192, VSLOT = DV * 128, LV = 3 * KSLOT;
    unsigned long long att_twait = 0; (void)att_twait;
#if ATT_TIMING
    const unsigned long long att_t0 = __builtin_amdgcn_s_memtime();
#endif
    const int r32 = lane & 31, hi = lane >> 5, NT = n1 + 4;
    const unsigned lds0 = (unsigned)(unsigned long)lds;
    const char* Kbu = (const char*)uniform_ptr(Kb); const char* Vbu = (const char*)uniform_ptr(Vb);
    const unsigned koff = (unsigned)((8 * wid + (lane >> 3)) * 128 + (((lane & 7) ^ (((8 * wid + (lane >> 3)) >> 1) & 7)) * 16));
    unsigned voff[NV];
#pragma unroll
    for (int j = 0; j < NV; ++j) { const int pi = wid + 8 * j, db = pi >> 2, kg = pi & 3; voff[j] = (unsigned)((16 * kg + (lane >> 2)) * vpitch + db * 32 + (lane & 3) * 8) * 2u; }
    const unsigned kdst = lds0 + wid * 1024, vdst = lds0 + LV + wid * 1024;
#define AP_TILE(i_) ((i_) < n1 ? t0 + (i_) : 256 + (i_) - n1)
#define AP_DMA_K(t_, sl_) glds16s(koff, Kbu + (size_t)AP_TILE(t_) * 8192, (unsigned)__builtin_amdgcn_readfirstlane(kdst + (sl_) * KSLOT))
#define AP_DMA_V(t_, sl_) do { const char* vb__ = Vbu + (size_t)AP_TILE(t_) * 128 * vpitch; _Pragma("unroll") for (int j_ = 0; j_ < NV; ++j_) glds16s(voff[j_], vb__, (unsigned)__builtin_amdgcn_readfirstlane(vdst + (sl_) * VSLOT + j_ * 8192)); } while (0)
#define AP_WAITBAR_STEADY() do { if (NV == 1) ATT_WAITBAR(2); else ATT_WAITBAR(3); } while (0)
#define AP_WAITBAR_VONLY()  do { if (NV == 1) ATT_WAITBAR(1); else ATT_WAITBAR(2); } while (0)
#define AP_MASK(C0_, C1_, t_) do { if (masked) { const int tl__ = AP_TILE(t_); if (tl__ < 256) { asm volatile("s_nop 15\n\ts_nop 7" : "+v"(C0_), "+v"(C1_)); const int kb__ = 64 * tl__ + 4 * hi - (qpos + r32) + 128; \
        _Pragma("unroll") for (int r = 0; r < 16; ++r) { const int kv = kb__ + (r & 3) + 8 * (r >> 2); if ((unsigned)kv > 256u) C0_[r] = -INFINITY; if ((unsigned)(kv + 32) > 256u) C1_[r] = -INFINITY; } } } } while (0)
    const lds_cptr lds3 = (lds_cptr)lds;
    lds_cptr kpd[4];
#pragma unroll
    for (int d0 = 0; d0 < 4; ++d0) kpd[d0] = lds3 + r32 * 128 + (((2 * d0 + hi) ^ ((r32 >> 1) & 7)) * 16);
    const lds_cptr vp0 = lds3 + LV + ((lane >> 4) & 1) * 32 + (lane & 3) * 8 + (4 * hi + ((lane & 15) >> 2)) * 64;
    AP_DMA_K(0, 0); AP_DMA_V(0, 0); AP_DMA_K(1, 1);
    bf16x8 qr[4];
#pragma unroll
    for (int d0 = 0; d0 < 4; ++d0) qr[d0] = *(const bf16x8*)(Qw + (size_t)r32 * 64 + d0 * 16 + hi * 8);
    AP_DMA_K(2, 2);
    if (NV == 1) ATT_WAITBAR(3); else ATT_WAITBAR(4);
    float l_reg = 0.f;
    unsigned long long ts0_ = 0, ts1_ = 0, att_tA = 0; (void)ts0_; (void)ts1_; (void)att_tA;
    const f32x16 zero16 = {};
    f32x16 pA0, pA1, pB0, pB1;
    bf16x8 kf[8];
    {
#pragma unroll
        for (int d0 = 0; d0 < 4; ++d0) { kf[2 * d0] = *(const LAS bf16x8*)(kpd[d0]); kf[2 * d0 + 1] = *(const LAS bf16x8*)(kpd[d0] + 4096); }
        pA0 = __builtin_amdgcn_mfma_f32_32x32x16_bf16(kf[0], qr[0], zero16, 0, 0, 0); pA1 = __builtin_amdgcn_mfma_f32_32x32x16_bf16(kf[1], qr[0], zero16, 0, 0, 0);
#pragma unroll
        for (int d0 = 1; d0 < 4; ++d0) { pA0 = __builtin_amdgcn_mfma_f32_32x32x16_bf16(kf[2 * d0], qr[d0], pA0, 0, 0, 0); pA1 = __builtin_amdgcn_mfma_f32_32x32x16_bf16(kf[2 * d0 + 1], qr[d0], pA1, 0, 0, 0); }
        AP_MASK(pA0, pA1, 0);
#pragma unroll
        for (int r = 0; r < 16; ++r) { pA0[r] = __builtin_amdgcn_exp2f(pA0[r]); pA1[r] = __builtin_amdgcn_exp2f(pA1[r]); }
    }
    ATT_WAITBAR(0);
    AP_DMA_K(3, 0); AP_DMA_V(1, 1);
    int sl_prev = 0, sl_cur = 1, sl_next = 2;
#define AP_ROT() do { sl_prev = sl_cur; sl_cur = sl_next; sl_next = (sl_next == 2) ? 0 : sl_next + 1; } while (0)
#pragma unroll
    for (int d0 = 0; d0 < 4; ++d0) { kf[2 * d0] = *(const LAS bf16x8*)(kpd[d0] + sl_cur * KSLOT); kf[2 * d0 + 1] = *(const LAS bf16x8*)(kpd[d0] + sl_cur * KSLOT + 4096); }
    AP_WAITBAR_STEADY();
    s16x4 vlo[NV == 1 ? 8 : 4], vhi[NV == 1 ? 8 : 4]; u32x4 pw0, pw1, pw2, pw3;
#define AP_PKW(P, B) pkbf(P[B], P[B + 1])
#define AP_PAF(k) __builtin_bit_cast(bf16x8, pw##k)
#define AP_VFR(i) (bf16x8){vlo[i][0], vlo[i][1], vlo[i][2], vlo[i][3], vhi[i][0], vhi[i][1], vhi[i][2], vhi[i][3]}
#define AP_PIN(x) asm volatile("" : "+v"(x))
#define AP_GAPA(MF, A0, A1, A2, A3, W0, W1, PW) do { MF; sacc += A0; sacc += A1; sacc += A2; sacc += A3; AP_PIN(sacc); W0; W1; AP_PIN(PW); ATT_SBAR(); } while (0)
#define AP_EX(v) __builtin_amdgcn_exp2f(v)
#define AP_GAPB4(MF, X, B) do { MF; X[B] = AP_EX(X[B]); X[B + 1] = AP_EX(X[B + 1]); X[B + 2] = AP_EX(X[B + 2]); X[B + 3] = AP_EX(X[B + 3]); AP_PIN(X); ATT_SBAR(); } while (0)
#define AP_GAPB2(MF, X, B) do { MF; X[B] = AP_EX(X[B]); X[B + 1] = AP_EX(X[B + 1]); AP_PIN(X); ATT_SBAR(); } while (0)
#define AP_VRD(i) do { vlo[i] = vtr(vp_ + (((i) >> 2) * 4096 + ((i) & 3) * 1024)); vhi[i] = vtr(vp_ + (((i) >> 2) * 4096 + ((i) & 3) * 1024 + 512)); } while (0)
#define AP_VRD_A(i) do { if (NV == 1) { AP_VRD(i); ATT_SBAR(); } } while (0)
#define AP_VRD_G(g) do { if (NV == 2 && (g) < 6) { if (((g) & 1) == 0) vlo[(g) >> 1] = vtr(vp_ + ((g) >> 1) * 4096); else vhi[(g) >> 1] = vtr(vp_ + ((g) >> 1) * 4096 + 512); ATT_SBAR(); } } while (0)
#define AP_VRD2(j) do { vlo[(j) & 3] = vtr(vp_ + (((j) & 3) * 4096 + ((j) >> 2) * 1024)); vhi[(j) & 3] = vtr(vp_ + (((j) & 3) * 4096 + ((j) >> 2) * 1024 + 512)); } while (0)
#define AP_KRD(G, j) do { if (G) { kf[2 * (j)] = *(const LAS bf16x8*)(kpd[j] + sl_next * KSLOT); kf[2 * (j) + 1] = *(const LAS bf16x8*)(kpd[j] + sl_next * KSLOT + 4096); ATT_SBAR(); } } while (0)
#if ATT_TIMING >= 3
#define AP_STAMP(v) do { asm volatile("s_memtime %0\n\ts_waitcnt lgkmcnt(0)" : "=s"(v) :: "memory"); ATT_SBAR(); } while (0)
#else
#define AP_STAMP(v) do { } while (0)
#endif
#define AP_MF(D, A, B, C) D = __builtin_amdgcn_mfma_f32_32x32x16_bf16(A, B, C, 0, 0, 0)
#define AP_QK0(D, A, B) asm volatile("v_mfma_f32_32x32x16_bf16 %0, %1, %2, 0" : "=&v"(D) : "v"(A), "v"(B))
#define AP_QK(D, A, B)  asm volatile("v_mfma_f32_32x32x16_bf16 %0, %1, %2, %0" : "+v"(D) : "v"(A), "v"(B))
#define AP_STEP(C0, C1, P0, P1, t, GK, GV, GL) do { ATT_SBAR(); AP_STAMP(ts0_); \
    const lds_cptr vp_ = vp0 + sl_prev * VSLOT; \
    AP_VRD_A(0); AP_VRD_G(0); float sacc = (P0[0] + P0[1]); \
    AP_GAPA(AP_QK0(C0, kf[0], qr[0]), P0[2], P0[3], P0[4], P0[5],     pw0[0] = AP_PKW(P0, 0),  pw0[1] = AP_PKW(P0, 2),  pw0); \
    AP_VRD_A(4); AP_VRD_G(1); AP_GAPA(AP_QK0(C1, kf[1], qr[0]), P0[6], P0[7], P0[8], P0[9],     pw0[2] = AP_PKW(P0, 4),  pw0[3] = AP_PKW(P0, 6),  pw0); \
    AP_VRD_A(1); AP_VRD_G(2); AP_GAPA(AP_QK(C0, kf[2], qr[1]),     P0[10], P0[11], P0[12], P0[13], pw1[0] = AP_PKW(P0, 8),  pw1[1] = AP_PKW(P0, 10), pw1); \
    AP_VRD_A(5); AP_VRD_G(3); AP_GAPA(AP_QK(C1, kf[3], qr[1]),     P0[14], P0[15], P1[0], P1[1],   pw1[2] = AP_PKW(P0, 12), pw1[3] = AP_PKW(P0, 14), pw1); \
    AP_VRD_A(2); AP_VRD_G(4); AP_GAPA(AP_QK(C0, kf[4], qr[2]),     P1[2], P1[3], P1[4], P1[5],     pw2[0] = AP_PKW(P1, 0),  pw2[1] = AP_PKW(P1, 2),  pw2); \
    AP_VRD_A(6); AP_VRD_G(5); AP_GAPA(AP_QK(C1, kf[5], qr[2]),     P1[6], P1[7], P1[8], P1[9],     pw2[2] = AP_PKW(P1, 4),  pw2[3] = AP_PKW(P1, 6),  pw2); \
    AP_VRD_A(3); AP_VRD_G(6); AP_GAPA(AP_QK(C0, kf[6], qr[3]),     P1[10], P1[11], P1[12], P1[13], pw3[0] = AP_PKW(P1, 8),  pw3[1] = AP_PKW(P1, 10), pw3); \
    AP_VRD_A(7); AP_VRD_G(7); AP_GAPA(AP_QK(C1, kf[7], qr[3]),     P1[14], P1[15], 0.f, 0.f,       pw3[2] = AP_PKW(P1, 12), pw3[3] = AP_PKW(P1, 14), pw3); \
    l_reg += sacc; AP_STAMP(ts1_); att_tA += ts1_ - ts0_; \
    if (GK) { AP_DMA_K((t) + 3, sl_cur); } if (GV) { AP_DMA_V((t) + 1, sl_next); } \
    AP_MASK(C0, C1, t); \
    ATT_SBAR(); \
    if constexpr (NV == 1) { \
        AP_GAPB4(AP_MF(o[0], AP_PAF(0), AP_VFR(0), o[0]), C0, 0); \
        AP_GAPB4(AP_MF(o[1], AP_PAF(0), AP_VFR(4), o[1]), C0, 4); \
        AP_KRD(GL, 0); AP_GAPB4(AP_MF(o[0], AP_PAF(1), AP_VFR(1), o[0]), C0, 8); \
        AP_KRD(GL, 1); AP_GAPB4(AP_MF(o[1], AP_PAF(1), AP_VFR(5), o[1]), C0, 12); \
        AP_KRD(GL, 2); AP_GAPB4(AP_MF(o[0], AP_PAF(2), AP_VFR(2), o[0]), C1, 0); \
        AP_KRD(GL, 3); AP_GAPB4(AP_MF(o[1], AP_PAF(2), AP_VFR(6), o[1]), C1, 4); \
        AP_GAPB4(AP_MF(o[0], AP_PAF(3), AP_VFR(3), o[0]), C1, 8); \
        AP_GAPB4(AP_MF(o[1], AP_PAF(3), AP_VFR(7), o[1]), C1, 12); \
    } else { \
        AP_VRD2(3); ATT_SBAR(); AP_GAPB2(AP_MF(o[0], AP_PAF(0), AP_VFR(0), o[0]), C0, 0); \
        AP_VRD2(4); ATT_SBAR(); AP_GAPB2(AP_MF(o[1], AP_PAF(0), AP_VFR(1), o[1]), C0, 2); \
        AP_VRD2(5); ATT_SBAR(); AP_GAPB2(AP_MF(o[2], AP_PAF(0), AP_VFR(2), o[2]), C0, 4); \
        AP_VRD2(6); ATT_SBAR(); AP_GAPB2(AP_MF(o[3], AP_PAF(0), AP_VFR(3), o[3]), C0, 6); \
        AP_VRD2(7); ATT_SBAR(); AP_KRD(GL, 0); AP_GAPB2(AP_MF(o[0], AP_PAF(1), AP_VFR(0), o[0]), C0, 8); \
        AP_VRD2(8); ATT_SBAR(); AP_GAPB2(AP_MF(o[1], AP_PAF(1), AP_VFR(1), o[1]), C0, 10); \
        AP_VRD2(9); ATT_SBAR(); AP_KRD(GL, 1); AP_GAPB2(AP_MF(o[2], AP_PAF(1), AP_VFR(2), o[2]), C0, 12); \
        AP_VRD2(10); ATT_SBAR(); AP_GAPB2(AP_MF(o[3], AP_PAF(1), AP_VFR(3), o[3]), C0, 14); \
        AP_VRD2(11); ATT_SBAR(); AP_KRD(GL, 2); AP_GAPB2(AP_MF(o[0], AP_PAF(2), AP_VFR(0), o[0]), C1, 0); \
        AP_VRD2(12); ATT_SBAR(); AP_GAPB2(AP_MF(o[1], AP_PAF(2), AP_VFR(1), o[1]), C1, 2); \
        AP_VRD2(13); ATT_SBAR(); AP_KRD(GL, 3); AP_GAPB2(AP_MF(o[2], AP_PAF(2), AP_VFR(2), o[2]), C1, 4); \
        AP_VRD2(14); ATT_SBAR(); AP_GAPB2(AP_MF(o[3], AP_PAF(2), AP_VFR(3), o[3]), C1, 6); \
        AP_VRD2(15); ATT_SBAR(); AP_GAPB2(AP_MF(o[0], AP_PAF(3), AP_VFR(0), o[0]), C1, 8); \
        AP_GAPB2(AP_MF(o[1], AP_PAF(3), AP_VFR(1), o[1]), C1, 10); \
        AP_GAPB2(AP_MF(o[2], AP_PAF(3), AP_VFR(2), o[2]), C1, 12); \
        AP_GAPB2(AP_MF(o[3], AP_PAF(3), AP_VFR(3), o[3]), C1, 14); \
    } } while (0)
    int t = 1;
    for (; t + 5 < NT; t += 2) {
        AP_STEP(pB0, pB1, pA0, pA1, t, true, true, true);     AP_WAITBAR_STEADY(); AP_ROT();
        AP_STEP(pA0, pA1, pB0, pB1, t + 1, true, true, true); AP_WAITBAR_STEADY(); AP_ROT();
    }
#define AP_ENDW(tt) do { if ((tt) + 3 < NT) { AP_WAITBAR_STEADY(); } else if ((tt) + 2 < NT) { AP_WAITBAR_VONLY(); } else { ATT_WAITBAR(0); } } while (0)
    for (; t + 1 < NT; t += 2) {
        AP_STEP(pB0, pB1, pA0, pA1, t, (t + 3 < NT), (t + 1 < NT), (t + 1 < NT));         AP_ENDW(t);     AP_ROT();
        AP_STEP(pA0, pA1, pB0, pB1, t + 1, (t + 4 < NT), (t + 2 < NT), (t + 2 < NT));     AP_ENDW(t + 1); AP_ROT();
    }
    AP_STEP(pB0, pB1, pA0, pA1, NT - 1, false, false, false);
    {
        float sacc = 0.f;
#pragma unroll
        for (int r = 0; r < 16; ++r) sacc += pB0[r] + pB1[r];
        l_reg += sacc;
        pw0 = (u32x4){AP_PKW(pB0, 0), AP_PKW(pB0, 2), AP_PKW(pB0, 4), AP_PKW(pB0, 6)}; pw1 = (u32x4){AP_PKW(pB0, 8), AP_PKW(pB0, 10), AP_PKW(pB0, 12), AP_PKW(pB0, 14)};
        pw2 = (u32x4){AP_PKW(pB1, 0), AP_PKW(pB1, 2), AP_PKW(pB1, 4), AP_PKW(pB1, 6)}; pw3 = (u32x4){AP_PKW(pB1, 8), AP_PKW(pB1, 10), AP_PKW(pB1, 12), AP_PKW(pB1, 14)};
        ATT_SBAR();
        const lds_cptr vp = vp0 + sl_cur * VSLOT;
#pragma unroll
        for (int d0 = 0; d0 < DV / 32; ++d0) {
            s16x4 lo[4], hh[4];
#pragma unroll
            for (int ks = 0; ks < 4; ++ks) { lo[ks] = vtr(vp + d0 * 4096 + ks * 1024); hh[ks] = vtr(vp + d0 * 4096 + ks * 1024 + 512); }
#define AP_PK(k) (bf16x8){lo[k][0], lo[k][1], lo[k][2], lo[k][3], hh[k][0], hh[k][1], hh[k][2], hh[k][3]}
            o[d0] = __builtin_amdgcn_mfma_f32_32x32x16_bf16(AP_PAF(0), AP_PK(0), o[d0], 0, 0, 0);
            o[d0] = __builtin_amdgcn_mfma_f32_32x32x16_bf16(AP_PAF(1), AP_PK(1), o[d0], 0, 0, 0);
            o[d0] = __builtin_amdgcn_mfma_f32_32x32x16_bf16(AP_PAF(2), AP_PK(2), o[d0], 0, 0, 0);
            o[d0] = __builtin_amdgcn_mfma_f32_32x32x16_bf16(AP_PAF(3), AP_PK(3), o[d0], 0, 0, 0);
#undef AP_PK
            ATT_SBAR();
        }
    }
    l_out = l_reg;
    asm volatile("s_waitcnt lgkmcnt(0)\n\ts_barrier" ::: "memory");
#if ATT_TIMING
    if (lane == 0 && NT > 100) { const unsigned long long att_t1 = __builtin_amdgcn_s_memtime(); atomicAdd(att_tm + (NV - 1) * 2, (ATT_TIMING >= 3) ? att_tA : att_twait); atomicAdd(att_tm + (NV - 1) * 2 + 1, att_t1 - att_t0); }
#endif
#undef AP_TILE
#undef AP_DMA_K
#undef AP_DMA_V
#undef AP_WAITBAR_STEADY
#undef AP_WAITBAR_VONLY
#undef AP_MASK
#undef AP_ROT
#undef AP_PKW
#undef AP_PAF
#undef AP_VFR
#undef AP_PIN
#undef AP_GAPA
#undef AP_EX
#undef AP_GAPB4
#undef AP_GAPB2
#undef AP_VRD
#undef AP_VRD_A
#undef AP_VRD_G
#undef AP_VRD2
#undef AP_KRD
#undef AP_MF
#undef AP_STAMP
#undef AP_QK0
#undef AP_QK
#undef AP_STEP
#undef AP_ENDW
}
typedef int v8i __attribute__((ext_vector_type(8)));
template <int DV>
__device__ __forceinline__ void attn_f8(f32x16 (&o)[DV / 32], f32x16& ol, const unsigned char* Qw8, const unsigned char* Kb8, const unsigned char* Vt8,
                                        int t0, int n1, int masked, int qpos, LAS unsigned char* lds, int wid, int lane, unsigned long long* att_tm = nullptr) {
    constexpr int NS = 3, NSL = 2 * NS;
    constexpr int KSLOT = 4096, VSLOT = DV * 64, LV = NSL * KSLOT, ND = DV / 32;
    unsigned long long att_twait = 0, att_tA = 0, tsa_ = 0, tsb_ = 0; (void)att_twait; (void)att_tm; (void)att_tA; (void)tsa_; (void)tsb_;
#if ATT_TIMING
    const unsigned long long att_t0 = __builtin_amdgcn_s_memtime();
#endif
#if ATT_TIMING >= 3
#define AF_STAMP(v) do { asm volatile("s_memtime %0\n\ts_waitcnt lgkmcnt(0)" : "=s"(v) :: "memory"); ATT_SBAR(); } while (0)
#else
#define AF_STAMP(v) do { } while (0)
#endif
#ifndef ATT_SEG
#define ATT_SEG 1
#endif
    const int r32 = lane & 31, hi = lane >> 5, NT = n1 + 4;
    const unsigned lds0 = (unsigned)(unsigned long)lds;
    const char* Kbu = (const char*)uniform_ptr(Kb8); const char* Vbu = (const char*)uniform_ptr(Vt8);
    const int kpi = wid & 3, vpi = (DV == 128) ? wid : (wid & 3);
    const bool do_k = wid < 4, do_v = (DV == 128) || wid >= 4;
    const int prow = lane >> 2, ppos = lane & 3;
    const unsigned koff = (unsigned)((16 * kpi + prow) * 64 + ((ppos ^ (((16 * kpi + prow) >> 2) & 3)) * 16));
    const unsigned voff = (unsigned)((16 * vpi + prow) * 64 + ((ppos ^ (((16 * vpi + prow) >> 2) & 3)) * 16));
    const unsigned kdst = lds0 + kpi * 1024, vdst = lds0 + LV + vpi * 1024;
#define AF_TILE(i_) ((i_) < n1 ? t0 + (i_) : 256 + (i_) - n1)
#define AF_DMA_K(t_, sl_) if (do_k) glds16s(koff, Kbu + (size_t)AF_TILE(t_) * 4096, (unsigned)__builtin_amdgcn_readfirstlane(kdst + (sl_) * KSLOT))
#define AF_DMA_V(t_, sl_) if (do_v) glds16s(voff, Vbu + (size_t)AF_TILE(t_) * (DV * 64), (unsigned)__builtin_amdgcn_readfirstlane(vdst + (sl_) * VSLOT))
#define AF_MASK(C0_, C1_, t_) do { if (masked) { const int tl__ = AF_TILE(t_); if (tl__ < 256) { asm volatile("s_nop 15\n\ts_nop 15" : "+v"(C0_), "+v"(C1_)); const int kb__ = 64 * tl__ + 4 * hi - (qpos + r32) + 128; \
        _Pragma("unroll") for (int r = 0; r < 16; ++r) { const int kv = kb__ + (r & 3) + 8 * (r >> 2); if ((unsigned)kv > 256u) C0_[r] = -INFINITY; if ((unsigned)(kv + 32) > 256u) C1_[r] = -INFINITY; } } } } while (0)
    const lds_cptr lds3 = (lds_cptr)lds;
    const lds_cptr fa0 = lds3 + r32 * 64 + (((2 * hi) ^ ((r32 >> 2) & 3)) * 16), fa1 = lds3 + r32 * 64 + (((2 * hi + 1) ^ ((r32 >> 2) & 3)) * 16);
#define AF_FRAG(off_) __builtin_bit_cast(v8i, (u32x4x2){*(const LAS u32x4*)(fa0 + (off_)), *(const LAS u32x4*)(fa1 + (off_))})
    struct u32x4x2 { u32x4 a, b; };
    AF_DMA_K(0, 0); AF_DMA_V(0, 0);
#pragma unroll
    for (int j = 1; j <= NS + 1; ++j) if (j < NT) AF_DMA_K(j, j);
#pragma unroll
    for (int j = 1; j < NS; ++j) AF_DMA_V(j, j);
    const v8i qf = __builtin_bit_cast(v8i, (u32x4x2){*(const u32x4*)(Qw8 + (size_t)r32 * 64 + 32 * hi), *(const u32x4*)(Qw8 + (size_t)r32 * 64 + 32 * hi + 16)});
    ATT_WAITBAR(0);
    ol = f32x16{};
    const v8i ones8 = {0x38383838, 0x38383838, 0x38383838, 0x38383838, 0x38383838, 0x38383838, 0x38383838, 0x38383838};
    const int sc1 = 0x7F7F7F7F, scq = 0x7D7D7D7D;
    const f32x16 zero16 = {};
    f32x16 P0, P1;
    v8i kf0, kf1;
    {
        kf0 = AF_FRAG(0); kf1 = AF_FRAG(2048);
        P0 = __builtin_amdgcn_mfma_scale_f32_32x32x64_f8f6f4(kf0, qf, zero16, 0, 0, 0, sc1, 0, scq);
        P1 = __builtin_amdgcn_mfma_scale_f32_32x32x64_f8f6f4(kf1, qf, zero16, 0, 0, 0, sc1, 0, scq);
        AF_MASK(P0, P1, 0);
#pragma unroll
        for (int r = 0; r < 16; ++r) { P0[r] = __builtin_amdgcn_exp2f(P0[r]); P1[r] = __builtin_amdgcn_exp2f(P1[r]); }
    }
    kf0 = AF_FRAG(1 * KSLOT); kf1 = AF_FRAG(1 * KSLOT + 2048);
    asm volatile("s_waitcnt lgkmcnt(0)\n\ts_barrier" ::: "memory");
    int one4_ = 0x38383838; asm volatile("" : "+s"(one4_));
    v8i ones8r = {one4_, one4_, one4_, one4_, one4_, one4_, one4_, one4_}; asm volatile("" : "+v"(ones8r));
    v8i vfa, vfb, p8 = {};
#define AF_PIN(x) asm volatile("" : "+v"(x))
#define AF_CVT(w_, P, B) do { int w__ = __builtin_amdgcn_cvt_pk_bf8_f32(P[B], P[B + 1], p8[w_], false); w__ = __builtin_amdgcn_cvt_pk_bf8_f32(P[B + 2], P[B + 3], w__, true); p8[w_] = w__; } while (0)
#define AF_QK(D, A) asm volatile(AF_QKNOP "v_mfma_scale_f32_32x32x64_f8f6f4 %0, %1, %2, 0, %3, %4 op_sel_hi:[0,0,0]" : "=&v"(D) : "v"(A), "v"(qf), "v"(sc1), "v"(scq))
#define AF_P8() p8
#define AF_PV(d0_, VF) asm volatile("s_nop 1\n\tv_mfma_scale_f32_32x32x64_f8f6f4 %0, %1, %2, %0, %3, %3 op_sel_hi:[0,0,0] cbsz:1" : "+v"(o[d0_]) : "v"(p8), "v"(VF), "v"(sc1))
#define AF_PL() asm volatile("s_nop 1\n\tv_mfma_scale_f32_32x32x64_f8f6f4 %0, %1, %2, %0, %3, %3 op_sel_hi:[0,0,0] cbsz:1" : "+v"(ol) : "v"(p8), "v"(ones8r), "v"(sc1))
#define AF_PVn(d0_, VF) asm volatile(AF_PVNOP "v_mfma_scale_f32_32x32x64_f8f6f4 %0, %1, %2, %0, %3, %3 op_sel_hi:[0,0,0] cbsz:1" : "+v"(o[d0_]) : "v"(p8), "v"(VF), "v"(sc1))
#define AF_PLn() asm volatile(AF_PLNOP "v_mfma_scale_f32_32x32x64_f8f6f4 %0, %1, %2, %0, %3, %3 op_sel_hi:[0,0,0] cbsz:1" : "+v"(ol) : "v"(p8), "v"(ones8r), "v"(sc1))
#define AF_EXP(X, B, N) do { _Pragma("unroll") for (int e_ = 0; e_ < (N); ++e_) X[(B) + e_] = __builtin_amdgcn_exp2f(X[(B) + e_]); AF_PIN(X); ATT_SBAR(); } while (0)
#define AF_SUMPACK() do { \
        AF_CVT(0, P0, 0); AF_CVT(1, P0, 4); AF_CVT(2, P0, 8); AF_CVT(3, P0, 12); AF_CVT(4, P1, 0); AF_CVT(5, P1, 4); AF_CVT(6, P1, 8); AF_CVT(7, P1, 12); } while (0)
#define AF_SUB(t, GL_) do { \
        ATT_SBAR(); \
        const int vo_ = LV + (((t) - 1) % NSL) * VSLOT, kn_ = (((t) + 1) % NSL) * KSLOT; \
        vfa = AF_FRAG(vo_); vfb = AF_FRAG(vo_ + 2048); ATT_SBAR(); \
        AF_SUMPACK(); ATT_SBAR(); \
        AF_QK(P0, kf0); AF_QK(P1, kf1); \
        AF_MASK(P0, P1, t); \
        ATT_SBAR(); AF_PRIO_PRE(); \
        if constexpr (ND == 2) { \
            AF_D64_BODY(GL_) \
        } else { \
            AF_D128_BODY(GL_) \
        } __builtin_amdgcn_s_setprio(0); } while (0)
    for (int t_ = 1; t_ < NT; t_ += NS) {
        int t = t_; asm volatile("" : "+s"(t));
#pragma unroll
        for (int j = 0; j < NS; ++j) { if (t + NS + 1 + j < NT) AF_DMA_K(t + NS + 1 + j, (t + NS + 1 + j) % NSL); if (t + NS - 1 + j < NT) AF_DMA_V(t + NS - 1 + j, (t + NS - 1 + j) % NSL); }
        AF_SUB(t, (t + 1 < NT));
#pragma unroll
        for (int j = 1; j < NS; ++j) { if (t + j < NT) { AF_SUB(t + j, (t + j + 1 < NT)); } }
        ATT_WAITBAR(0);
    }
    {
        AF_SUMPACK();
        ATT_SBAR();
        AF_PL();
        const int vo_ = LV + ((NT - 1) % NSL) * VSLOT;
#pragma unroll
        for (int d0 = 0; d0 < ND; ++d0) { vfa = AF_FRAG(vo_ + d0 * 2048); AF_PV(d0, vfa); ATT_SBAR(); }
        asm volatile("s_nop 15\n\ts_nop 15" ::: "memory");
    }
    asm volatile("s_waitcnt lgkmcnt(0)\n\ts_barrier" ::: "memory");
#if ATT_TIMING
    if (lane == 0 && NT > 100) { const unsigned long long att_t1 = __builtin_amdgcn_s_memtime(); atomicAdd(att_tm + (ND / 2 - 1 + (ND == 2 ? 0 : 0)) * 2, (ATT_TIMING >= 3) ? att_tA : att_twait); atomicAdd(att_tm + (ND / 2 - 1) * 2 + 1, att_t1 - att_t0); }
#endif
#undef AF_STAMP
#undef AF_TILE
#undef AF_DMA_K
#undef AF_DMA_V
#undef AF_MASK
#undef AF_FRAG
#undef AF_PIN
#undef AF_CVT
#undef AF_QK
#undef AF_P8
#undef AF_PV
#undef AF_PVn
#undef AF_PLn
#undef AF_PL
#undef AF_EXP
#undef AF_SUMPACK
#undef AF_SUB
}
__device__ __forceinline__ void row_inv(float (&rli)[16], float lsum, float extra, LAS float* wsf, int r32, int hi) {
    const float l = pg8::swap_sum32(lsum) + extra;
    LDS_WAIT();
    if (hi == 0) wsf[r32] = l;
    LDS_WAIT(); asm volatile("" ::: "memory");
#pragma unroll
    for (int r = 0; r < 16; ++r) rli[r] = __builtin_amdgcn_rcpf(wsf[crow(r, hi)]);
    LDS_WAIT(); asm volatile("" ::: "memory");
}
}

#ifndef DBG_NO_MOE
#define DBG_NO_MOE 0
#endif
#ifndef DBG_NO_MIX
#define DBG_NO_MIX 0
#endif
#ifndef DBG_AB
#define DBG_AB 0
#endif
#ifndef TPROBE
#define TPROBE -1
#endif
#ifndef REPEAT_MASK
#define E_REP1 1
#define E_REP2 1
#define TPBIN 25
#define E_ABL 0
#define E_GENERIC 0
#define E_MFMA 1
#define REPEAT_MASK 0
#endif
#define REP_BEGIN(c) for (int rep_ = 0; rep_ < (SKIP_ALL ? 0 : (((REPEAT_MASK >> (c)) & 1) ? 2 : 1)); ++rep_) {
#define REP_END }
#ifndef ATT_FN
#define ATT_FN attn_pipe
#endif
#ifndef PH_MASK
#define PH_MASK 0x3ff
#endif
#define PH_ON(i) ((PH_MASK >> (i)) & 1)
#ifndef SPREAD_PH
#define SPREAD_PH -1
#endif
#ifndef SKIP_ALL
#define SKIP_ALL 0
#endif
#ifndef ATT_VARIANT
#define ATT_VARIANT 0
#endif
struct Args { const float* in[28]; float* out; unsigned char* ws; int ph_lo, ph_hi; };
enum { I_X = 0, I_C, I_CTX, I_CCTX, I_WMOD, I_BMOD, I_NMIX, I_NFFN, I_WINAB, I_WOUTAB, I_QNA, I_KNA, I_SINKA, I_QNB, I_KNB, I_WINC, I_WOUTC, I_QNC, I_KNC, I_LAMC, I_SUBLN,
       I_WGRP, I_BGRP, I_WEXP, I_BEXP, I_W1, I_W3, I_W2 };

__global__ void __launch_bounds__(NTHREADS, 2) mega(Args args) {
    extern __shared__ __attribute__((aligned(16))) unsigned char lds_[];
    LAS unsigned char* lds = (LAS unsigned char*)lds_;
    volatile LAS unsigned* MISC = (volatile LAS unsigned*)(lds + MISC_OFF);
    const int tid0 = threadIdx.x;
    const int G = gridDim.x, bx = blockIdx.x;
    const int vcu = (G % 8 == 0) ? (bx % 8) * (G / 8) + bx / 8 : bx;
    const int NGW = G * NWAVES;
#define PHASE_IDS() int tid = tid0; asm volatile("" : "+v"(tid)); const int lane = tid & 63, wave = __builtin_amdgcn_readfirstlane(tid >> 6), gw = vcu * NWAVES + wave; (void)lane; (void)wave; (void)gw
    unsigned char* ws = args.ws;
    unsigned* ctl = (unsigned*)(ws + WS_CTL);
    float* mod = (float*)(ws + WS_MOD); float* modc = mod + DEPTH * 6144;
    float* rope = (float*)(ws + WS_ROPE);
    float* xcur = (float*)(ws + WS_XCUR);
    bf16* HB = (bf16*)(ws + WS_HB); bf16* QKV = (bf16*)(ws + WS_QKV); bf16* OB = (bf16*)(ws + WS_OB); float* O1S = (float*)(ws + WS_O1S);
    bf16* XG = (bf16*)(ws + WS_XG); bf16* HG = (bf16*)(ws + WS_HG); bf16* YG = (bf16*)(ws + WS_YG);
    int* tok_e = (int*)(ws + WS_ROUTE + RT_TOKE); int* tok_p = (int*)(ws + WS_ROUTE + RT_TOKP); float* tok_w = (float*)(ws + WS_ROUTE + RT_TOKW);
    int* drow = (int*)(ws + WS_ROUTE + RT_DROW); float* rw = (float*)(ws + WS_ROUTE + RT_RW); int* tile_e = (int*)(ws + WS_ROUTE + RT_TILE); int* ntl = (int*)(ws + WS_ROUTE + RT_NT);

    for (int u = tid0; u < (LDS_BYTES - LDSCTL_OFF) / 4; u += NTHREADS) ((LAS unsigned*)(lds + LDSCTL_OFF))[u] = 0u;
    __syncthreads();
    const int ph_lo = args.ph_lo, ph_hi = args.ph_hi;
    XcdBarrier bar; bar.bar = ctl + CW_BAR; bar.x = 0; bar.st = nullptr;
    if (ph_hi - ph_lo > 1) bar = xcd_barrier_post(ctl + CW_BAR, MISC + 8);
#if TPROBE >= 0
    unsigned long long* tms = (unsigned long long*)(ws + WS_CTL + 262144);
    if (bx == 0 && tid0 == 0) { const unsigned long long t0_ = __builtin_amdgcn_s_memrealtime(); MISC[16] = (unsigned)t0_; MISC[17] = (unsigned)(t0_ >> 32); }
#define TSTAMP(cls) do { if (bx == 0 && tid0 == 0) { const unsigned long long now_ = __builtin_amdgcn_s_memrealtime(); const unsigned long long prev_ = ((unsigned long long)MISC[17] << 32) | MISC[16]; \
        tms[cls] += now_ - prev_; MISC[16] = (unsigned)now_; MISC[17] = (unsigned)(now_ >> 32); } } while (0)
#else
#define TSTAMP(cls) do { } while (0)
#endif
#define IN(k) (ph_lo <= (k) && (k) < ph_hi)
#define SEAM(k) do { if (IN(k) && IN((k) + 1)) xcd_barrier(bar); } while (0)

    if (IN(0)) { if (!PH_ON(0)) __builtin_trap(); asm volatile("; MARK_PHASE p0" ::: "memory"); PHASE_IDS(); REP_BEGIN(0)
        {
            LAS float* sc = (LAS float*)lds; LAS float* scc = sc + 1024; LAS float* red = scc + 1024;
            for (int k = tid; k < 1024; k += NTHREADS) { const float a = args.in[I_C][k], b = args.in[I_CCTX][k];
                sc[k] = a / (1.f + __expf(-a)); scc[k] = b / (1.f + __expf(-b)); }
            __syncthreads();
            for (int it = bx; it < DEPTH * 96; it += G) {
                const int l = it / 96, col = (it % 96) * 64 + lane;
                const float* w = args.in[I_WMOD] + (size_t)l * 1024 * 6144 + col;
                float a0 = 0.f, a1 = 0.f;
#pragma unroll 32
                for (int kk = 0; kk < 128; ++kk) { const int k = wave * 128 + kk; const float wv = w[(size_t)k * 6144]; a0 += sc[k] * wv; a1 += scc[k] * wv; }
                red[wave * 64 + lane] = a0; red[512 + wave * 64 + lane] = a1;
                __syncthreads();
                if (wave < 2) { float s = 0.f;
#pragma unroll
                    for (int w8 = 0; w8 < 8; ++w8) s += red[wave * 512 + w8 * 64 + lane];
                    s += args.in[I_BMOD][l * 6144 + col];
                    (wave == 0 ? mod : modc)[l * 6144 + col] = s; }
                __syncthreads();
            }
        }
        for (int idx = bx * NTHREADS + tid; idx < 320 * 16; idx += G * NTHREADS) {
            const int t = idx >> 4, j = idx & 15; const float pos = (float)(t < 256 ? t : t - 256);
            const float inv = exp2f(-(float)j * (13.287712379549449f / 16.f));
            const float ang = pos * inv, rev = ang * 0.15915494309189535f, fr = rev - rintf(rev);
            const float cs = __builtin_amdgcn_cosf(fr), sn = __builtin_amdgcn_sinf(fr);
            if (t < 256) { rope[t * 16 + j] = cs; rope[4096 + t * 16 + j] = sn; } else { rope[8192 + (t - 256) * 16 + j] = cs; rope[9216 + (t - 256) * 16 + j] = sn; }
        }
        { float* wtr = (float*)(ws + WS_ROUTE + RT_WTR);
          for (int idx = bx * NTHREADS + tid; idx < DEPTH * 36 * 1024; idx += G * NTHREADS) { const int ll = idx / 36864, o = (idx >> 10) % 36, k = idx & 1023;
              wtr[idx] = (o < 4) ? args.in[I_WGRP][((size_t)ll * 1024 + k) * 4 + o] : args.in[I_WEXP][((size_t)ll * 1024 + k) * 32 + (o - 4)]; } }
        {
            LAS float* scr = (LAS float*)(lds + wave * 16384);
            constexpr int N_INAB = 2 * 16 * 48, N_INC = 2 * 16 * 96, N_OUT = 2 * 16 * 32, N_W13 = DEPTH * NEXP * 16 * 32, N_W2 = DEPTH * NEXP * 8 * 32;
            constexpr int NITEMS = N_INAB + N_INC + 2 * N_OUT + N_W13 + N_W2;
            for (int it = gw; it < NITEMS; it += NGW) {
                int r = it;
                if (r < N_INAB) { const int i = r / (16 * 48), q = r % (16 * 48), kb = q / 48, nb = q % 48, pin = (nb * 32) & 255, pn = (nb * 32) >> 8, bj = pin >> 7, wc = (pin & 127) >> 5;
#if FP8_B
                    transpose_item8(args.in[I_WINAB] + (size_t)i * 1024 * 1536, 1536, (4 * pn + wc) * 64 + bj * 32, (unsigned char*)(ws + WS_BT_INAB) + (size_t)i * 1536 * 1024, 1024, nb * 32, kb * 64, scr, lane); continue; }
#else
                    transpose_item(args.in[I_WINAB] + (size_t)i * 1024 * 1536, 1536, (4 * pn + wc) * 64 + bj * 32, (bf16*)(ws + WS_BT_INAB) + (size_t)i * 1536 * 1024, 1024, nb * 32, kb * 64, scr, lane); continue; }
#endif
                r -= N_INAB;
                if (r < N_INC) { const int i = r / (16 * 96), q = r % (16 * 96), kb = q / 96, nb = q % 96, pin = (nb * 32) & 255, pn = (nb * 32) >> 8, bj = pin >> 7, wc = (pin & 127) >> 5;
#if FP8_B
                    transpose_item8(args.in[I_WINC] + (size_t)i * 1024 * 3072, 3072, (4 * pn + wc) * 64 + bj * 32, (unsigned char*)(ws + WS_BT_INC) + (size_t)i * 3072 * 1024, 1024, nb * 32, kb * 64, scr, lane); continue; }
#else
                    transpose_item(args.in[I_WINC] + (size_t)i * 1024 * 3072, 3072, (4 * pn + wc) * 64 + bj * 32, (bf16*)(ws + WS_BT_INC) + (size_t)i * 3072 * 1024, 1024, nb * 32, kb * 64, scr, lane); continue; }
#endif
                r -= N_INC;
                if (r < N_OUT) { const int i = r / (16 * 32), q = r % (16 * 32), kb = q / 32, nb = q % 32;
                    transpose_item(args.in[I_WOUTAB] + (size_t)i * 1024 * 1024, 1024, nb * 32, (bf16*)(ws + WS_BT_OUTAB) + (size_t)i * 1024 * 1024, 1024, nb * 32, kb * 64, scr, lane); continue; }
                r -= N_OUT;
                if (r < N_OUT) { const int i = r / (16 * 32), q = r % (16 * 32), kb = q / 32, nb = q % 32;
                    transpose_item(args.in[I_WOUTC] + (size_t)i * 1024 * 1024, 1024, nb * 32, (bf16*)(ws + WS_BT_OUTC) + (size_t)i * 1024 * 1024, 1024, nb * 32, kb * 64, scr, lane); continue; }
                r -= N_OUT;
                if (r < N_W13) { const int le = r / (16 * 32), q = r % (16 * 32), kb = q / 32, nb = q % 32, pin = (nb * 32) & 255, pn = (nb * 32) >> 8, bj = pin >> 7, wc = (pin & 127) >> 5;
#if FP8_G
                    transpose_item8(args.in[bj ? I_W3 : I_W1] + (size_t)le * 1024 * 512, 512, pn * 128 + wc * 32, (unsigned char*)(ws + WS_BT_W13) + (size_t)le * 1024 * 1024, 1024, nb * 32, kb * 64, scr, lane); continue; }
#else
                    transpose_item(args.in[bj ? I_W3 : I_W1] + (size_t)le * 1024 * 512, 512, pn * 128 + wc * 32, (bf16*)(ws + WS_BT_W13) + (size_t)le * 1024 * 1024, 1024, nb * 32, kb * 64, scr, lane); continue; }
#endif
                r -= N_W13;
                { const int le = r / (8 * 32), q = r % (8 * 32), kb = q / 32, nb = q % 32;
#if FP8_H
                    transpose_item8(args.in[I_W2] + (size_t)le * 512 * 1024, 1024, nb * 32, (unsigned char*)(ws + WS_BT_W2) + (size_t)le * 1024 * 512, 512, nb * 32, kb * 64, scr, lane); }
#else
                    transpose_item(args.in[I_W2] + (size_t)le * 512 * 1024, 1024, nb * 32, (bf16*)(ws + WS_BT_W2) + (size_t)le * 1024 * 512, 512, nb * 32, kb * 64, scr, lane); }
#endif
            }
        }
        __syncthreads();
    REP_END }
    SEAM(0); TSTAMP(0);

    for (int l = 0; l < DEPTH; ++l) {
        const int pb = 1 + 8 * l, li = l >> 1;
        const bool isC = (l & 1) != 0, last = (l == DEPTH - 1);
        const float* modl = mod + l * 6144; const float* modcl = modc + l * 6144;
        const int mrows = last ? SEQ : MT;

        if (IN(pb + 0)) { if (!PH_ON(1)) __builtin_trap(); asm volatile("; MARK_PHASE pb+0" ::: "memory"); PHASE_IDS(); REP_BEGIN(1)
            const float* gmix = args.in[I_NMIX] + l * 1024;
            int mstart = gw;
            if (NGW == 2048) {
                const bool comb = l > 0 && rep_ == 0 && !((DBG_NO_MOE >> (l > 0 ? l - 1 : 0)) & 1);
                int dj = 0;
                if (comb && lane < 16) dj = drow[2 * (gw + 2048 * (lane >> 1)) + (lane & 1)];
                f32x4 gn[4], sh[4], sc[4], gt[4];
#pragma unroll
                for (int j = 0; j < 4; ++j) { const int c0 = 4 * lane + 256 * j; gn[j] = *(const f32x4*)(gmix + c0); sh[j] = *(const f32x4*)(modl + c0); sc[j] = *(const f32x4*)(modl + 1024 + c0);
                    gt[j] = comb ? *(const f32x4*)(mod + (l - 1) * 6144 + 5 * 1024 + c0) : (f32x4){0.f, 0.f, 0.f, 0.f}; }
                const float* srcb = (l == 0 ? args.in[I_X] : xcur) + (size_t)gw * 1024 + 4 * lane;
                f32x4 xv[2][4]; u32x2 y0[2][4], y1[2][4];
#define A_ISSUE(it, b) { _Pragma("unroll") for (int j = 0; j < 4; ++j) xv[b][j] = *(const f32x4*)(srcb + (size_t)2048 * 1024 * (it) + 256 * j); \
                    if (comb) { const int d0 = __builtin_amdgcn_readlane(dj, 2 * (it)), d1 = __builtin_amdgcn_readlane(dj, 2 * (it) + 1); \
                        _Pragma("unroll") for (int j = 0; j < 4; ++j) { y0[b][j] = *(const u32x2*)(YG + (size_t)d0 * 1024 + 4 * lane + 256 * j); y1[b][j] = *(const u32x2*)(YG + (size_t)d1 * 1024 + 4 * lane + 256 * j); } } \
                    else { _Pragma("unroll") for (int j = 0; j < 4; ++j) { y0[b][j] = (u32x2){0u, 0u}; y1[b][j] = (u32x2){0u, 0u}; } } }
                A_ISSUE(0, 0)
#pragma unroll
                for (int it = 0; it < 8; ++it) { const int b = it & 1; const int m = gw + 2048 * it;
                    if (it + 1 < 8) { if (b) A_ISSUE(it + 1, 0) else A_ISSUE(it + 1, 1) }
                    asm volatile("" ::: "memory");
                    f32x4 v[4]; float ss = 0.f;
#pragma unroll
                    for (int j = 0; j < 4; ++j) { const u32x2 a0 = y0[b][j], a1 = y1[b][j];
                        v[j] = comb ? xv[b][j] + gt[j] * (f32x4){bflo(a0.x) + bflo(a1.x), bfhi(a0.x) + bfhi(a1.x), bflo(a0.y) + bflo(a1.y), bfhi(a0.y) + bfhi(a1.y)} : xv[b][j];
                        *(f32x4*)(xcur + (size_t)m * 1024 + 4 * lane + 256 * j) = v[j];
                        ss += (v[j][0] * v[j][0] + v[j][1] * v[j][1]) + (v[j][2] * v[j][2] + v[j][3] * v[j][3]); }
                    const float rstd = __builtin_amdgcn_rsqf(wave_sum(ss) * (1.f / 1024.f) + RMS_EPS);
#pragma unroll
                    for (int j = 0; j < 4; ++j) { const int c0 = 4 * lane + 256 * j; const f32x4 h = v[j] * rstd * gn[j] * (sc[j] + 1.f) + sh[j];
#if FP8_B
                        *(unsigned*)((unsigned char*)HB + (size_t)m * 1024 + c0) = pg8::pk4_e4m3(h[0], h[1], h[2], h[3]); }
#else
                        *(u32x2*)(HB + (size_t)m * 1024 + c0) = (u32x2){pkbf(h[0], h[1]), pkbf(h[2], h[3])}; }
#endif
                    asm volatile("" ::: "memory");
                }
#undef A_ISSUE
                mstart = gw + 2048 * 8;
            }
            for (int m = mstart; m < MT; m += NGW) {
                const bool isctx = m >= SEQ;
                const float* src = (l == 0) ? (isctx ? args.in[I_CTX] + (size_t)(m - SEQ) * 1024 : args.in[I_X] + (size_t)m * 1024) : xcur + (size_t)m * 1024;
                f32x4 v[4];
#pragma unroll
                for (int j = 0; j < 4; ++j) v[j] = *(const f32x4*)(src + 4 * lane + 256 * j);
                if (l > 0 && rep_ == 0 && !((DBG_NO_MOE >> (l - 1)) & 1)) {
                    const int d0 = drow[2 * m], d1 = drow[2 * m + 1];
                    const float* gate = (isctx ? modc : mod) + (l - 1) * 6144 + 5 * 1024;
#pragma unroll
                    for (int j = 0; j < 4; ++j) { const u32x2 y0 = *(const u32x2*)(YG + (size_t)d0 * 1024 + 4 * lane + 256 * j), y1 = *(const u32x2*)(YG + (size_t)d1 * 1024 + 4 * lane + 256 * j);
                        const f32x4 gt = *(const f32x4*)(gate + 4 * lane + 256 * j);
                        v[j] = v[j] + gt * (f32x4){bflo(y0.x) + bflo(y1.x), bfhi(y0.x) + bfhi(y1.x), bflo(y0.y) + bflo(y1.y), bfhi(y0.y) + bfhi(y1.y)}; }
                }
#pragma unroll
                for (int j = 0; j < 4; ++j) *(f32x4*)(xcur + (size_t)m * 1024 + 4 * lane + 256 * j) = v[j];
                float ss = 0.f;
#pragma unroll
                for (int j = 0; j < 4; ++j) ss += (v[j][0] * v[j][0] + v[j][1] * v[j][1]) + (v[j][2] * v[j][2] + v[j][3] * v[j][3]);
                const float rstd = __builtin_amdgcn_rsqf(wave_sum(ss) * (1.f / 1024.f) + RMS_EPS);
                const float* mm = isctx ? modcl : modl;
#pragma unroll
                for (int j = 0; j < 4; ++j) { const int c0 = 4 * lane + 256 * j; const f32x4 gn = *(const f32x4*)(gmix + c0), sh = *(const f32x4*)(mm + c0), scl = *(const f32x4*)(mm + 1024 + c0);
                    const f32x4 h = v[j] * rstd * gn * (scl + 1.f) + sh;
#if FP8_B
                    *(unsigned*)((unsigned char*)HB + (size_t)m * 1024 + c0) = pg8::pk4_e4m3(h[0], h[1], h[2], h[3]); }
#else
                    *(u32x2*)(HB + (size_t)m * 1024 + c0) = (u32x2){pkbf(h[0], h[1]), pkbf(h[2], h[3])}; }
#endif
            }
        REP_END }
        SEAM(pb + 0); TSTAMP(1);

        if (IN(pb + 1)) { if (!PH_ON(2)) __builtin_trap(); asm volatile("; MARK_PHASE pb+1" ::: "memory"); PHASE_IDS(); REP_BEGIN((isC ? 3 : 2))
            const int N = isC ? 3072 : 1536;
            constexpr size_t ESZ = FP8_B ? 1 : 2;
            pg8::Gemm g{HB, isC ? (const bf16*)(ws + WS_BT_INC + (size_t)li * 3072 * 1024 * ESZ) : (const bf16*)(ws + WS_BT_INAB + (size_t)li * 1536 * 1024 * ESZ), MT, N, 1024};
            pg8::StaticOrder S; S.init(MT, N, G, bx);
#if USE_FP8
            pg8::EpiQKV8 E{(unsigned char*)QKV, isC ? args.in[I_QNC] + li * 64 : args.in[I_QNA] + li * 64, isC ? args.in[I_KNC] + li * 64 : args.in[I_KNA] + li * 64,
                           args.in[I_QNB] + li * 64, args.in[I_KNB] + li * 64, rope, isC ? 1 : 0};
            pg8::gemm_phase<pg8::EpiQKV8, pg8::StaticOrder, true, true, FP8_B != 0>(lds, g, S, E);
#else
            pg8::EpiQKV E{QKV, isC ? args.in[I_QNC] + li * 64 : args.in[I_QNA] + li * 64, isC ? args.in[I_KNC] + li * 64 : args.in[I_KNA] + li * 64,
                          args.in[I_QNB] + li * 64, args.in[I_KNB] + li * 64, rope, isC ? 1 : 0};
            pg8::gemm_phase<pg8::EpiQKV, pg8::StaticOrder, true, true>(lds, g, S, E);
#endif
        REP_END }
        SEAM(pb + 1); TSTAMP(isC ? 3 : 2);

#if SPREAD_PH >= 0
        unsigned long long spr_t0 = __builtin_amdgcn_s_memrealtime();
#endif
        if (IN(pb + 2)) { if (!PH_ON(3)) __builtin_trap(); asm volatile("; MARK_PHASE pb+2" ::: "memory"); PHASE_IDS(); REP_BEGIN((isC ? 5 : 4))
            const int r32 = lane & 31, hi = lane >> 5;
            LAS float* wsf = (LAS float*)(lds + LDS_WSF) + wave * 32;
            if (!isC && ATT_VARIANT != 2) {
                LAS bf16* stg = (LAS bf16*)(lds + LDS_STAGE) + wave * 2048;
                for (int u = vcu; u < 1040; u += G) {
                    int head16, qt, t0, n1, masked, has_sink, kvslot, vslot, qslot;
                    if (u < 512) { const int h = u >> 6; qt = u & 63; head16 = 8 + h; t0 = 0; n1 = 256; masked = 0; has_sink = 0; qslot = 12 + h; kvslot = 20 + (h >> 2); vslot = 22 + (h >> 2); }
                    else if (u < 1024) { const int h = (u - 512) >> 6; qt = u & 63; head16 = h; t0 = (4 * qt - 2 > 0) ? 4 * qt - 2 : 0; const int t1 = (4 * qt + 6 < 256) ? 4 * qt + 6 : 256; n1 = t1 - t0;
                        masked = 1; has_sink = 1; qslot = h; kvslot = 8 + (h >> 2); vslot = 10 + (h >> 2); }
                    else { const int h16 = u - 1024; qt = 64; head16 = h16; t0 = 0; n1 = 0; masked = 0;
                        if (h16 < 8) { has_sink = 1; qslot = h16; kvslot = 8 + (h16 >> 2); vslot = 10 + (h16 >> 2); } else { const int h = h16 - 8; has_sink = 0; qslot = 12 + h; kvslot = 20 + (h >> 2); vslot = 22 + (h >> 2); } }
                    const int row0 = qt * 256 + wave * 32;
                    f32x16 o[2]; o[0] = f32x16{}; o[1] = f32x16{}; float lsum = 0.f; (void)lsum;
#if USE_FP8
                    f32x16 ol;
                    { const unsigned char* q8 = (const unsigned char*)QKV; const int vidx = (vslot < 12) ? vslot - 10 : vslot - 20;
                      att::attn_f8<64>(o, ol, q8 + (size_t)qslot * pg8::E_SL8 + (size_t)row0 * 64, q8 + (size_t)kvslot * pg8::E_SL8, q8 + 24 * pg8::E_SL8 + (size_t)vidx * pg8::E_VT_AB,
                                       t0, n1, masked, row0, lds, wave, lane, (unsigned long long*)(ws + WS_CTL + 300000)); }
#else
                    att::ATT_FN<64>(o, lsum, QKV + (size_t)qslot * SLOT + (size_t)row0 * 64, QKV + (size_t)kvslot * SLOT, QKV + (size_t)vslot * SLOT, 64, t0, n1, masked, row0, lds, wave, lane, (unsigned long long*)(ws + WS_CTL + 300000));
#endif
                    const float extra = has_sink ? __builtin_amdgcn_exp2f(args.in[I_SINKA][li * 8 + (head16 & 7)] * LOG2E) : 0.f;
                    int ln = lane; asm volatile("" : "+v"(ln));
                    const int r32e = ln & 31, hie = ln >> 5;
                    float rli[16];
#if USE_FP8
#pragma unroll
                    for (int r = 0; r < 16; ++r) rli[r] = __builtin_amdgcn_rcpf(ol[r] + extra);
#else
                    att::row_inv(rli, lsum, extra, wsf, r32e, hie);
#endif
#pragma unroll
                    for (int r = 0; r < 16; ++r) { const int orow = att::crow(r, hie);
#pragma unroll
                        for (int d0 = 0; d0 < 2; ++d0) stg[orow * 64 + d0 * 32 + r32e] = ((DBG_AB == 1 && head16 < 8) || (DBG_AB == 2 && head16 >= 8) || (DBG_AB == 3 && u >= 1024)) ? (bf16)0 : (bf16)(pkbf(o[d0][r] * rli[r], 0.f) & 0xffffu); }
                    LDS_WAIT(); asm volatile("" ::: "memory");
                    bf16* Ow = OB + (size_t)row0 * 1024 + head16 * 64;
#pragma unroll
                    for (int i = 0; i < 4; ++i) { const int row = i * 8 + (ln >> 3), ch = ln & 7; const u32x4 vv = *(const LAS u32x4*)(stg + row * 64 + ch * 8); *(u32x4*)(Ow + (size_t)row * 1024 + ch * 8) = vv; }
                    LDS_WAIT(); asm volatile("" ::: "memory");
                }
            } else if (ATT_VARIANT != 1) {
                LAS bf16* stg = (LAS bf16*)(lds + LDS_STAGE) + wave * 4096;
                const float lam_init = 0.8f - 0.6f * __expf(-0.3f * (float)l);
                const float* lp = args.in[I_LAMC] + li * 256;
                const float lam = __expf(wave_sum(lp[lane] * lp[64 + lane])) - __expf(wave_sum(lp[128 + lane] * lp[192 + lane])) + lam_init;
                const float* subln = args.in[I_SUBLN] + li * 128;
                const int nunits = last ? 512 : 520;
                for (int u = vcu; u < nunits; u += G) {
                    int h, qt, n1;
                    if (u < 512) { h = u >> 6; qt = u & 63; n1 = 256; } else { h = u - 512; qt = 64; n1 = 0; }
                    const int row0 = qt * 256 + wave * 32;
                    const __amdgpu_buffer_rsrc_t o1rs = __builtin_amdgcn_make_buffer_rsrc((void*)(O1S + ((size_t)u * 8 + wave) * 4096), 0, 4096 * 4, 0x00020000);
                    f32x16 o[4]; float rli[16];
                    for (int comp = 0; comp < 2; ++comp) {
#pragma unroll
                        for (int d0 = 0; d0 < 4; ++d0) o[d0] = f32x16{};
                        float lsum = 0.f; (void)lsum;
#if USE_FP8
                        f32x16 ol;
                        { const unsigned char* q8 = (const unsigned char*)QKV;
                          att::attn_f8<128>(o, ol, q8 + (size_t)(2 * h + comp) * pg8::E_SL8 + (size_t)row0 * 64, q8 + (size_t)(16 + 2 * h + comp) * pg8::E_SL8, q8 + 32 * pg8::E_SL8 + (size_t)h * pg8::E_VT_C,
                                            0, n1, 0, 0, lds, wave, lane, (unsigned long long*)(ws + WS_CTL + 300000)); }
#else
                        att::ATT_FN<128>(o, lsum, QKV + (size_t)(2 * h + comp) * SLOT + (size_t)row0 * 64, QKV + (size_t)(16 + 2 * h + comp) * SLOT, QKV + (size_t)(32 + 2 * h) * SLOT, 128, 0, n1, 0, 0, lds, wave, lane, (unsigned long long*)(ws + WS_CTL + 300000));
#endif
#if USE_FP8
#pragma unroll
                        for (int r = 0; r < 16; ++r) rli[r] = __builtin_amdgcn_rcpf(ol[r]);
#else
                        { int l1 = lane; asm volatile("" : "+v"(l1)); att::row_inv(rli, lsum, 0.f, wsf, l1 & 31, l1 >> 5); }
#endif
                        if (comp == 0) {
                            int l0 = lane; asm volatile("" : "+v"(l0));
#pragma unroll
                            for (int d0 = 0; d0 < 4; ++d0) {
#pragma unroll
                                for (int r = 0; r < 16; ++r) __builtin_amdgcn_raw_buffer_store_b32(__builtin_bit_cast(unsigned, o[d0][r] * rli[r]), o1rs, l0 * 4, (d0 * 16 + r) * 256, 0);
                                asm volatile("" ::: "memory"); }
                        }
                    }
                    int ln = lane; asm volatile("" : "+v"(ln));
                    const int r32e = ln & 31, hie = ln >> 5;
                    float ssr[16];
#pragma unroll
                    for (int r = 0; r < 16; ++r) ssr[r] = 0.f;
#pragma unroll
                    for (int d0 = 0; d0 < 4; ++d0) {
#pragma unroll
                        for (int r = 0; r < 16; ++r) { const float vv = __builtin_bit_cast(float, __builtin_amdgcn_raw_buffer_load_b32(o1rs, ln * 4, (d0 * 16 + r) * 256, 0)) - lam * (o[d0][r] * rli[r]); o[d0][r] = vv; ssr[r] += vv * vv; }
                        asm volatile("" ::: "memory"); }
#pragma unroll
                    for (int r = 0; r < 16; ++r) { float s = dpp_sum16(ssr[r]); s += __shfl_xor(s, 16);
                        ssr[r] = __builtin_amdgcn_rsqf(s * (1.f / 128.f) + RMS_EPS) * (1.f - lam_init); }
#pragma unroll
                    for (int d0 = 0; d0 < 4; ++d0) { const float sg = subln[d0 * 32 + r32e];
#pragma unroll
                        for (int r = 0; r < 16; ++r) stg[att::crow(r, hie) * 128 + d0 * 32 + r32e] = (bf16)(pkbf(o[d0][r] * ssr[r] * sg, 0.f) & 0xffffu); }
                    LDS_WAIT(); asm volatile("" ::: "memory");
                    bf16* Ow = OB + (size_t)row0 * 1024 + h * 128;
#pragma unroll
                    for (int i = 0; i < 8; ++i) { const int row = i * 4 + (ln >> 4), ch = ln & 15; const u32x4 vv = *(const LAS u32x4*)(stg + row * 128 + ch * 8); *(u32x4*)(Ow + (size_t)row * 1024 + ch * 8) = vv; }
                    LDS_WAIT(); asm volatile("" ::: "memory");
                }
            }
            __syncthreads();
        REP_END }
#if SPREAD_PH >= 0
        if (tid0 == 0 && (isC ? 5 : 4) == SPREAD_PH) { const unsigned long long d_ = __builtin_amdgcn_s_memrealtime() - spr_t0; unsigned long long* sp = (unsigned long long*)(ws + WS_CTL + 400000);
            atomicAdd(sp, d_); atomicMax(sp + 1, d_); atomicAdd(sp + 2, 1ull); }
#endif
        SEAM(pb + 2); TSTAMP(isC ? 5 : 4);

        if (IN(pb + 3) && !((DBG_NO_MIX >> l) & 1)) { if (!PH_ON(4)) __builtin_trap(); asm volatile("; MARK_PHASE pb+3" ::: "memory"); PHASE_IDS(); REP_BEGIN(6)
            const bf16* WoT = isC ? (const bf16*)(ws + WS_BT_OUTC) + (size_t)li * 1024 * 1024 : (const bf16*)(ws + WS_BT_OUTAB) + (size_t)li * 1024 * 1024;
            int mD = mrows;
            if (G == 256 && mrows == MT) {
                const int rg = bx >> 4, cg = bx & 15, cb = wave & 3, kh = wave >> 2, n16 = lane & 15, kq = lane >> 4;
                const bf16* ap = OB + (size_t)(SEQ + 16 * rg + n16) * 1024 + 512 * kh + 8 * kq;
                const bf16* bp = WoT + (size_t)(64 * cg + 16 * cb + n16) * 1024 + 512 * kh + 8 * kq;
                bf16x8 av[16], bv[16];
#pragma unroll
                for (int q = 0; q < 16; ++q) { av[q] = *(const bf16x8*)(ap + 32 * q); bv[q] = *(const bf16x8*)(bp + 32 * q); }
                asm volatile("" ::: "memory");
                f32x4 dacc = {0.f, 0.f, 0.f, 0.f};
#pragma unroll
                for (int q = 0; q < 16; ++q) dacc = __builtin_amdgcn_mfma_f32_16x16x32_bf16(av[q], bv[q], dacc, 0, 0, 0);
                LAS f32x4* red = (LAS f32x4*)lds;
                if (kh) red[cb * 64 + lane] = dacc;
                __syncthreads();
                if (!kh) { dacc += red[cb * 64 + lane];
                    const int c = 64 * cg + 16 * cb + n16; const float gt = rep_ ? 0.f : modcl[2 * 1024 + c];
#pragma unroll
                    for (int i = 0; i < 4; ++i) { float* xp = xcur + (size_t)(SEQ + 16 * rg + 4 * kq + i) * 1024 + c; *xp = *xp + gt * dacc[i]; } }
                __syncthreads();
                mD = SEQ;
            }
            pg8::Gemm g{OB, WoT, mD, 1024, 1024};
            pg8::StaticOrder S; S.init(mD, 1024, G, bx);
            const float* zgate = (const float*)(ws + WS_CTL + 512 * 1024);
            pg8::EpiResid E{xcur, rep_ ? zgate : modl + 2 * 1024, rep_ ? zgate : modcl + 2 * 1024};
            pg8::gemm_phase<pg8::EpiResid, pg8::StaticOrder, true, true>(lds, g, S, E);
        REP_END }
        SEAM(pb + 3); TSTAMP(6);

        if (IN(pb + 4)) { if (!PH_ON(5)) __builtin_trap(); asm volatile("; MARK_PHASE pb+4" ::: "memory"); PHASE_IDS(); REP_BEGIN(7)
            const float* gffn = args.in[I_NFFN] + l * 1024;
            const float* wtr = (const float*)(ws + WS_ROUTE + RT_WTR) + (size_t)l * 36 * 1024;
            const float* bg = args.in[I_BGRP] + l * 4; const float* be = args.in[I_BEXP] + l * 32;
            LAS unsigned* lcnt = (LAS unsigned*)(lds + LDS_XCH + 512);
            if (tid < 32) lcnt[tid] = 0u;
#if E_MFMA
            constexpr int WPITCH = 1028;
            LAS float* wle = (LAS float*)(lds + LDS_RW); LAS float* wlg = wle + 32 * WPITCH;
            { const f32x4* wg4 = (const f32x4*)wtr + tid; f32x4 wv[18];
#pragma unroll
              for (int j = 0; j < 18; ++j) wv[j] = wg4[512 * j];
              asm volatile("" ::: "memory");
              const int c4 = tid & 255;
#pragma unroll
              for (int j = 0; j < 18; ++j) { const int o = (tid >> 8) + 2 * j;
                  if (j < 2) *(LAS f32x4*)(wlg + o * 1024 + 4 * c4) = wv[j];
                  else { const int e = o - 4, rho = 16 * ((e >> 2) & 1) + 4 * (e >> 3) + (e & 3); *(LAS f32x4*)(wle + rho * WPITCH + 4 * c4) = wv[j]; } }
              __syncthreads(); }
            LAS float* lc = (LAS float*)(lds + LDS_PAR); LAS float* lsh = lc + 1024;
            if (tid < 256) { const f32x4 g4 = *(const f32x4*)(gffn + 4 * tid), s4 = *(const f32x4*)(modl + 3 * 1024 + 4 * tid), c4v = *(const f32x4*)(modl + 4 * 1024 + 4 * tid);
                *(LAS f32x4*)(lc + 4 * tid) = g4 * (c4v + 1.f); *(LAS f32x4*)(lsh + 4 * tid) = s4; }
            __syncthreads();
            TSTAMP(11);
            const int n16 = lane & 15, kq = lane >> 4;
            if (G == 256) {
                if (mrows > SEQ && bx < 128) {
                    const int grp2 = lane >> 5, s32 = lane & 31;
                    const int m = SEQ + 2 * bx + grp2;
                    f32x4 t[8], gnv[8], shv[8], scv[8];
                    float ss = 0.f;
#pragma unroll
                    for (int jj = 0; jj < 8; ++jj) { const int c0 = 4 * s32 + 128 * jj; t[jj] = *(const f32x4*)(xcur + (size_t)m * 1024 + c0);
                        gnv[jj] = *(const f32x4*)(gffn + c0); shv[jj] = *(const f32x4*)(modcl + 3 * 1024 + c0); scv[jj] = *(const f32x4*)(modcl + 4 * 1024 + c0); }
                    asm volatile("" ::: "memory");
#pragma unroll
                    for (int jj = 0; jj < 8; ++jj) ss += (t[jj][0] * t[jj][0] + t[jj][1] * t[jj][1]) + (t[jj][2] * t[jj][2] + t[jj][3] * t[jj][3]);
                    ss = dpp_sum16(ss); ss += __shfl_xor(ss, 16);
                    const float rstd = __builtin_amdgcn_rsqf(ss * (1.f / 1024.f) + RMS_EPS);
#pragma unroll
                    for (int jj = 0; jj < 8; ++jj) { const int c0 = 4 * s32 + 128 * jj;
                        t[jj] = t[jj] * rstd * (gnv[jj] * (scv[jj] + 1.f)) + shv[jj];
                        if (wave == 0) {
#if FP8_G
                            *(unsigned*)((unsigned char*)HB + (size_t)m * 1024 + c0) = pg8::pk4_e4m3(t[jj][0], t[jj][1], t[jj][2], t[jj][3]);
#else
                            *(u32x2*)(HB + (size_t)m * 1024 + c0) = (u32x2){pkbf(t[jj][0], t[jj][1]), pkbf(t[jj][2], t[jj][3])};
#endif
                        } }
                    LAS float* accx = (LAS float*)(lds + LDS_XCH + 640);
                    const LAS float* wbase = wle + 4 * s32;
#pragma unroll 1
                    for (int op = wave; op < 18; op += 8) {
                        const int o = 2 * op, ea = o - 4, eb = o - 3;
                        const int ra = o < 4 ? 32 * WPITCH + o * 1024 : (16 * ((ea >> 2) & 1) + 4 * (ea >> 3) + (ea & 3)) * WPITCH;
                        const int rb = o + 1 < 4 ? 32 * WPITCH + (o + 1) * 1024 : (16 * ((eb >> 2) & 1) + 4 * (eb >> 3) + (eb & 3)) * WPITCH;
                        f32x4 wa[8], wb[8];
#pragma unroll
                        for (int jj = 0; jj < 8; ++jj) { wa[jj] = *(const LAS f32x4*)(wbase + ra + 128 * jj); wb[jj] = *(const LAS f32x4*)(wbase + rb + 128 * jj); }
                        asm volatile("" ::: "memory");
                        float a0 = 0.f, a1 = 0.f;
#pragma unroll
                        for (int jj = 0; jj < 8; ++jj) { a0 += (t[jj][0] * wa[jj][0] + t[jj][1] * wa[jj][1]) + (t[jj][2] * wa[jj][2] + t[jj][3] * wa[jj][3]);
                            a1 += (t[jj][0] * wb[jj][0] + t[jj][1] * wb[jj][1]) + (t[jj][2] * wb[jj][2] + t[jj][3] * wb[jj][3]); }
                        a0 = dpp_sum16(a0); a1 = dpp_sum16(a1);
                        a0 += __shfl_xor(a0, 16); a1 += __shfl_xor(a1, 16);
                        if (s32 == 0) { accx[grp2 * 36 + o] = a0; accx[grp2 * 36 + o + 1] = a1; }
                        asm volatile("" ::: "memory"); }
                    __syncthreads();
                    if (wave == 0) {
                        float acc[36];
#pragma unroll
                        for (int o = 0; o < 36; ++o) acc[o] = accx[grp2 * 36 + o];
                        float lg[4]; int gidx = 0; float gmax;
#pragma unroll
                        for (int q = 0; q < 4; ++q) lg[q] = acc[q] + bg[q];
                        gmax = lg[0];
#pragma unroll
                        for (int q = 1; q < 4; ++q) if (lg[q] > gmax) { gmax = lg[q]; gidx = q; }
                        float gden = 0.f;
#pragma unroll
                        for (int q = 0; q < 4; ++q) gden += __expf(lg[q] - gmax);
                        const float gprob = 1.f / gden;
                        float le8[8];
#pragma unroll
                        for (int k = 0; k < 8; ++k) { float sv = acc[4 + k] + be[k];
#pragma unroll
                            for (int q = 1; q < 4; ++q) sv = (gidx == q) ? acc[4 + 8 * q + k] + be[8 * q + k] : sv;
                            le8[k] = sv; }
                        int i1 = 0; float m1 = le8[0];
#pragma unroll
                        for (int k = 1; k < 8; ++k) if (le8[k] > m1) { m1 = le8[k]; i1 = k; }
                        int i2 = -1; float m2 = -3.0e38f;
#pragma unroll
                        for (int k = 0; k < 8; ++k) if (k != i1 && le8[k] > m2) { m2 = le8[k]; i2 = k; }
                        const float e2 = __expf(m2 - m1), inv = 1.f / (1.f + e2);
                        const float w1 = gprob * inv, w2 = gprob * e2 * inv;
                        if (s32 == 0 && rep_ == 0) {
                            const int ea = gidx * 8 + i1, eb = gidx * 8 + i2;
                            const int pa = (int)__hip_atomic_fetch_add(lcnt + ea, 1u, __ATOMIC_RELAXED, __HIP_MEMORY_SCOPE_WORKGROUP) | (bx << 16), pb2 = (int)__hip_atomic_fetch_add(lcnt + eb, 1u, __ATOMIC_RELAXED, __HIP_MEMORY_SCOPE_WORKGROUP) | (bx << 16);
                            tok_e[2 * m] = ea; tok_e[2 * m + 1] = eb; tok_p[2 * m] = pa; tok_p[2 * m + 1] = pb2; tok_w[2 * m] = w1; tok_w[2 * m + 1] = w2;
                        }
                    }
                }
                TSTAMP(12);
                const int p = wave & 3, h = wave >> 2, grp = bx + 256 * p, m = grp * 16 + n16;
#define E_OFF(i) (64 * ((i) >> 2) + 4 * ((i) & 3))
                const float* xr = xcur + (size_t)m * 1024 + 16 * kq + 512 * h;
                LAS float* ssx = (LAS float*)(lds + LDS_XCH);
                float ss = 0.f;
#pragma unroll 1
                for (int i0 = 0; i0 < 32; i0 += 16) { f32x4 v[16];
#pragma unroll
                    for (int j = 0; j < 16; ++j) v[j] = *(const f32x4*)(xr + 16 * i0 + E_OFF(j));
                    asm volatile("" ::: "memory");
#pragma unroll
                    for (int j = 0; j < 16; ++j) ss += (v[j][0] * v[j][0] + v[j][1] * v[j][1]) + (v[j][2] * v[j][2] + v[j][3] * v[j][3]); }
                ss += __shfl_xor(ss, 16); ss += __shfl_xor(ss, 32);
                if (kq == 0) ssx[wave * 16 + n16] = ss;
                __syncthreads();
                TSTAMP(13);
                const float rstd = __builtin_amdgcn_rsqf((ssx[p * 16 + n16] + ssx[(p + 4) * 16 + n16]) * (1.f / 1024.f) + RMS_EPS);
                unsigned char* trow = (unsigned char*)HB + (size_t)m * (FP8_G ? 1024 : 2048) + (FP8_G ? 1 : 2) * (16 * kq + 512 * h);
                const LAS float* a0p = wle + n16 * WPITCH + 16 * kq + 512 * h; const LAS float* a1p = a0p + 16 * WPITCH; const LAS float* wgp = wlg + 16 * kq + 512 * h;
                const LAS float* lcp = lc + 16 * kq + 512 * h;
                f32x4 D0 = {0.f, 0.f, 0.f, 0.f}, D1 = {0.f, 0.f, 0.f, 0.f}; float gl0 = 0.f, gl1 = 0.f, gl2 = 0.f, gl3 = 0.f;
                f32x4 xv[16];
#pragma unroll
                for (int j = 0; j < 16; ++j) xv[j] = *(const f32x4*)(xr + E_OFF(j));
#pragma unroll 1
                for (int ib = 0; ib < 2; ++ib) {
                    const GAS float* xp = (const GAS float*)(xr + 256);
                    GAS unsigned char* tp = (GAS unsigned char*)(trow + (FP8_G ? 256 : 512) * ib);
                    const LAS float* a0b = a0p + 256 * ib; const LAS float* a1b = a1p + 256 * ib; const LAS float* wgb = wgp + 256 * ib; const LAS float* lcb = lcp + 256 * ib;
                    asm volatile("" : "+v"(xp), "+v"(tp), "+v"(a0b), "+v"(a1b), "+v"(wgb), "+v"(lcb));
                    u32x4 tq;
#pragma unroll
                    for (int j = 0; j < 16; ++j) {
                        const f32x4 cv = *(const LAS f32x4*)(lcb + E_OFF(j)), sv = *(const LAS f32x4*)(lcb + 1024 + E_OFF(j));
                        const f32x4 t = xv[j] * rstd * cv + sv;
                        if (!(E_ABL & 8)) xv[j] = *(const GAS f32x4*)(xp + E_OFF(j));
#if FP8_G
                        tq[j & 3] = pg8::pk4_e4m3(t[0], t[1], t[2], t[3]);
                        if ((j & 3) == 3 && !(E_ABL & 4)) *(GAS u32x4*)(tp + 64 * (j >> 2)) = tq;
#else
                        *(GAS u32x2*)(tp + 2 * E_OFF(j)) = (u32x2){pkbf(t[0], t[1]), pkbf(t[2], t[3])};
#endif
                        const f32x4 a0 = *(const LAS f32x4*)(a0b + E_OFF(j)), a1 = *(const LAS f32x4*)(a1b + E_OFF(j));
                        const f32x4 w0 = *(const LAS f32x4*)(wgb + E_OFF(j)), w1 = *(const LAS f32x4*)(wgb + 1024 + E_OFF(j)), w2 = *(const LAS f32x4*)(wgb + 2048 + E_OFF(j)), w3 = *(const LAS f32x4*)(wgb + 3072 + E_OFF(j));
                        if (!(E_ABL & 2)) { gl0 += (t[0] * w0[0] + t[1] * w0[1]) + (t[2] * w0[2] + t[3] * w0[3]); gl1 += (t[0] * w1[0] + t[1] * w1[1]) + (t[2] * w1[2] + t[3] * w1[3]);
                        gl2 += (t[0] * w2[0] + t[1] * w2[1]) + (t[2] * w2[2] + t[3] * w2[3]); gl3 += (t[0] * w3[0] + t[1] * w3[1]) + (t[2] * w3[2] + t[3] * w3[3]); }
#pragma unroll
                        for (int e = 0; e < 4; ++e) if (!(E_ABL & 1)) { D0 = __builtin_amdgcn_mfma_f32_16x16x4f32(a0[e], t[e], D0, 0, 0, 0); D1 = __builtin_amdgcn_mfma_f32_16x16x4f32(a1[e], t[e], D1, 0, 0, 0); }
                        asm volatile("" ::: "memory"); }
                }
#undef E_OFF
                __syncthreads();
                TSTAMP(14);
                LAS float* part = (LAS float*)(lds + LDS_RW) + p * 12 * 64 + lane;
                if (h) {
#pragma unroll
                    for (int k = 0; k < 4; ++k) { part[k * 64] = D0[k]; part[(4 + k) * 64] = D1[k]; }
                    part[8 * 64] = gl0; part[9 * 64] = gl1; part[10 * 64] = gl2; part[11 * 64] = gl3; }
                __syncthreads();
                if (!h) {
#pragma unroll
                    for (int k = 0; k < 4; ++k) { D0[k] += part[k * 64]; D1[k] += part[(4 + k) * 64]; }
                    gl0 += part[8 * 64]; gl1 += part[9 * 64]; gl2 += part[10 * 64]; gl3 += part[11 * 64];
                gl0 += __shfl_xor(gl0, 16); gl1 += __shfl_xor(gl1, 16); gl2 += __shfl_xor(gl2, 16); gl3 += __shfl_xor(gl3, 16);
                gl0 += __shfl_xor(gl0, 32); gl1 += __shfl_xor(gl1, 32); gl2 += __shfl_xor(gl2, 32); gl3 += __shfl_xor(gl3, 32);
                float lg[4] = {gl0 + bg[0], gl1 + bg[1], gl2 + bg[2], gl3 + bg[3]}; int gidx = 0; float gmax = lg[0];
#pragma unroll
                for (int q = 1; q < 4; ++q) if (lg[q] > gmax) { gmax = lg[q]; gidx = q; }
                float gden = 0.f;
#pragma unroll
                for (int q = 0; q < 4; ++q) gden += __expf(lg[q] - gmax);
                const float gprob = 1.f / gden;
                float le8[8];
#pragma unroll
                for (int k = 0; k < 4; ++k) { le8[k] = D0[k] + be[8 * kq + k]; le8[4 + k] = D1[k] + be[8 * kq + 4 + k]; }
                int i1 = 0; float m1 = le8[0];
#pragma unroll
                for (int k = 1; k < 8; ++k) if (le8[k] > m1) { m1 = le8[k]; i1 = k; }
                int i2 = -1; float m2 = -3.0e38f;
#pragma unroll
                for (int k = 0; k < 8; ++k) if (k != i1 && le8[k] > m2) { m2 = le8[k]; i2 = k; }
                const float e2 = __expf(m2 - m1), inv = 1.f / (1.f + e2);
                const float w1r = gprob * inv, w2r = gprob * e2 * inv;
                if (kq == gidx && rep_ == 0) {
                    const int ea = gidx * 8 + i1, eb = gidx * 8 + i2;
                    const int pa = (int)__hip_atomic_fetch_add(lcnt + ea, 1u, __ATOMIC_RELAXED, __HIP_MEMORY_SCOPE_WORKGROUP) | (bx << 16), pb2 = (int)__hip_atomic_fetch_add(lcnt + eb, 1u, __ATOMIC_RELAXED, __HIP_MEMORY_SCOPE_WORKGROUP) | (bx << 16);
                    tok_e[2 * m] = ea; tok_e[2 * m + 1] = eb; tok_p[2 * m] = pa; tok_p[2 * m + 1] = pb2; tok_w[2 * m] = w1r; tok_w[2 * m + 1] = w2r;
                }
                }
                __syncthreads();
                TSTAMP(15);
            } else {
#if E_GENERIC
            if (wave >= 4) {
                const int grp2 = lane >> 5, s32 = lane & 31;
                for (int m0 = SEQ + 2 * (bx + G * (wave - 4)); m0 < mrows; m0 += 2 * G * 4) {
                    const int m = m0 + grp2;
                    f32x4 t[8];
                    float ss = 0.f;
#pragma unroll
                    for (int jj = 0; jj < 8; ++jj) { t[jj] = *(const f32x4*)(xcur + (size_t)m * 1024 + 4 * s32 + 128 * jj); ss += (t[jj][0] * t[jj][0] + t[jj][1] * t[jj][1]) + (t[jj][2] * t[jj][2] + t[jj][3] * t[jj][3]); }
                    ss = dpp_sum16(ss); ss += __shfl_xor(ss, 16);
                    const float rstd = __builtin_amdgcn_rsqf(ss * (1.f / 1024.f) + RMS_EPS);
#pragma unroll
                    for (int jj = 0; jj < 8; ++jj) { const int c0 = 4 * s32 + 128 * jj; const f32x4 gn = *(const f32x4*)(gffn + c0), sh = *(const f32x4*)(modcl + 3 * 1024 + c0), scl = *(const f32x4*)(modcl + 4 * 1024 + c0);
                        t[jj] = t[jj] * rstd * (gn * (scl + 1.f)) + sh;
#if FP8_G
                        *(unsigned*)((unsigned char*)HB + (size_t)m * 1024 + c0) = pg8::pk4_e4m3(t[jj][0], t[jj][1], t[jj][2], t[jj][3]); }
#else
                        *(u32x2*)(HB + (size_t)m * 1024 + c0) = (u32x2){pkbf(t[jj][0], t[jj][1]), pkbf(t[jj][2], t[jj][3])}; }
#endif
                    float acc[36];
                    const LAS float* wbase = wle + 4 * s32; asm volatile("" : "+v"(wbase));
#pragma unroll
                    for (int o = 0; o < 36; o += 2) {
                        const int ea = o - 4, eb = o - 3;
                        const int ra = o < 4 ? 32 * WPITCH + o * 1024 : (16 * ((ea >> 2) & 1) + 4 * (ea >> 3) + (ea & 3)) * WPITCH;
                        const int rb = o + 1 < 4 ? 32 * WPITCH + (o + 1) * 1024 : (16 * ((eb >> 2) & 1) + 4 * (eb >> 3) + (eb & 3)) * WPITCH;
                        f32x4 wa[8], wb[8];
#pragma unroll
                        for (int jj = 0; jj < 8; ++jj) { wa[jj] = *(const LAS f32x4*)(wbase + ra + 128 * jj); wb[jj] = *(const LAS f32x4*)(wbase + rb + 128 * jj); }
                        asm volatile("" ::: "memory");
                        float a0 = 0.f, a1 = 0.f;
#pragma unroll
                        for (int jj = 0; jj < 8; ++jj) { a0 += (t[jj][0] * wa[jj][0] + t[jj][1] * wa[jj][1]) + (t[jj][2] * wa[jj][2] + t[jj][3] * wa[jj][3]);
                            a1 += (t[jj][0] * wb[jj][0] + t[jj][1] * wb[jj][1]) + (t[jj][2] * wb[jj][2] + t[jj][3] * wb[jj][3]); }
                        a0 = dpp_sum16(a0); a1 = dpp_sum16(a1);
                        acc[o] = a0 + __shfl_xor(a0, 16); acc[o + 1] = a1 + __shfl_xor(a1, 16);
                        asm volatile("" ::: "memory"); }
                    float lg[4]; int gidx = 0; float gmax;
#pragma unroll
                    for (int q = 0; q < 4; ++q) lg[q] = acc[q] + bg[q];
                    gmax = lg[0];
#pragma unroll
                    for (int q = 1; q < 4; ++q) if (lg[q] > gmax) { gmax = lg[q]; gidx = q; }
                    float gden = 0.f;
#pragma unroll
                    for (int q = 0; q < 4; ++q) gden += __expf(lg[q] - gmax);
                    const float gprob = 1.f / gden;
                    float le8[8];
#pragma unroll
                    for (int k = 0; k < 8; ++k) { float sv = acc[4 + k] + be[k];
#pragma unroll
                        for (int q = 1; q < 4; ++q) sv = (gidx == q) ? acc[4 + 8 * q + k] + be[8 * q + k] : sv;
                        le8[k] = sv; }
                    int i1 = 0; float m1 = le8[0];
#pragma unroll
                    for (int k = 1; k < 8; ++k) if (le8[k] > m1) { m1 = le8[k]; i1 = k; }
                    int i2 = -1; float m2 = -3.0e38f;
#pragma unroll
                    for (int k = 0; k < 8; ++k) if (k != i1 && le8[k] > m2) { m2 = le8[k]; i2 = k; }
                    const float e2 = __expf(m2 - m1), inv = 1.f / (1.f + e2);
                    const float w1 = gprob * inv, w2 = gprob * e2 * inv;
                    if (s32 == 0 && rep_ == 0) {
                        const int ea = gidx * 8 + i1, eb = gidx * 8 + i2;
                        const int pa = (int)__hip_atomic_fetch_add(lcnt + ea, 1u, __ATOMIC_RELAXED, __HIP_MEMORY_SCOPE_WORKGROUP) | (bx << 16), pb2 = (int)__hip_atomic_fetch_add(lcnt + eb, 1u, __ATOMIC_RELAXED, __HIP_MEMORY_SCOPE_WORKGROUP) | (bx << 16);
                        tok_e[2 * m] = ea; tok_e[2 * m + 1] = eb; tok_p[2 * m] = pa; tok_p[2 * m + 1] = pb2; tok_w[2 * m] = w1; tok_w[2 * m + 1] = w2;
                    }
                }
            } else
            for (int grp = bx + G * wave; grp < (SEQ >> 4); grp += G * 4) {
                const int m = grp * 16 + n16;
                const float* xr = xcur + (size_t)m * 1024 + 4 * kq;
                float ss = 0.f;
#pragma unroll 1
                for (int r1_ = 0; r1_ < E_REP1; ++r1_) { ss = 0.f; asm volatile("" : "+v"(ss));
#pragma unroll 1
                for (int i0 = 0; i0 < 64; i0 += 16) { f32x4 v[16];
#pragma unroll
                    for (int j = 0; j < 16; ++j) v[j] = *(const f32x4*)(xr + 16 * (i0 + j));
                    asm volatile("" ::: "memory");
#pragma unroll
                    for (int j = 0; j < 16; ++j) ss += (v[j][0] * v[j][0] + v[j][1] * v[j][1]) + (v[j][2] * v[j][2] + v[j][3] * v[j][3]); } }
                ss += __shfl_xor(ss, 16); ss += __shfl_xor(ss, 32);
                const float rstd = __builtin_amdgcn_rsqf(ss * (1.f / 1024.f) + RMS_EPS);
                unsigned char* trow = (unsigned char*)HB + (size_t)m * (FP8_G ? 1024 : 2048) + (FP8_G ? 4 : 8) * kq;
                const LAS float* a0p = wle + n16 * WPITCH + 4 * kq; const LAS float* a1p = a0p + 16 * WPITCH; const LAS float* wgp = wlg + 4 * kq;
                const LAS float* lcp = lc + 4 * kq; const LAS float* lshp = lsh + 4 * kq;
                f32x4 D0, D1; float gl0, gl1, gl2, gl3;
#pragma unroll 1
                for (int r2_ = 0; r2_ < E_REP2; ++r2_) {
                D0 = (f32x4){0.f, 0.f, 0.f, 0.f}; D1 = D0; gl0 = 0.f; gl1 = 0.f; gl2 = 0.f; gl3 = 0.f;
                asm volatile("" : "+v"(D0), "+v"(D1), "+v"(gl0), "+v"(gl1), "+v"(gl2), "+v"(gl3));
                f32x4 xv[16];
#pragma unroll
                for (int j = 0; j < 16; ++j) xv[j] = *(const f32x4*)(xr + 16 * j);
#pragma unroll 1
                for (int ib = 0; ib < 4; ++ib) {
                    const GAS float* xp = (const GAS float*)(xr + 256 * (ib < 3 ? ib + 1 : 3));
                    GAS unsigned char* tp = (GAS unsigned char*)(trow + (FP8_G ? 256 : 512) * ib);
                    const LAS float* a0b = a0p + 256 * ib; const LAS float* a1b = a1p + 256 * ib; const LAS float* wgb = wgp + 256 * ib; const LAS float* lcb = lcp + 256 * ib;
                    asm volatile("" : "+v"(xp), "+v"(tp), "+v"(a0b), "+v"(a1b), "+v"(wgb), "+v"(lcb));
#pragma unroll
                    for (int j = 0; j < 16; ++j) {
                        const f32x4 cv = *(const LAS f32x4*)(lcb + 16 * j), sv = *(const LAS f32x4*)(lcb + 1024 + 16 * j);
                        const f32x4 t = xv[j] * rstd * cv + sv;
                        xv[j] = *(const GAS f32x4*)(xp + 16 * j);
#if FP8_G
                        *(GAS unsigned*)(tp + 16 * j) = pg8::pk4_e4m3(t[0], t[1], t[2], t[3]);
#else
                        *(GAS u32x2*)(tp + 32 * j) = (u32x2){pkbf(t[0], t[1]), pkbf(t[2], t[3])};
#endif
                        const f32x4 a0 = *(const LAS f32x4*)(a0b + 16 * j), a1 = *(const LAS f32x4*)(a1b + 16 * j);
                        const f32x4 w0 = *(const LAS f32x4*)(wgb + 16 * j), w1 = *(const LAS f32x4*)(wgb + 1024 + 16 * j), w2 = *(const LAS f32x4*)(wgb + 2048 + 16 * j), w3 = *(const LAS f32x4*)(wgb + 3072 + 16 * j);
                        gl0 += (t[0] * w0[0] + t[1] * w0[1]) + (t[2] * w0[2] + t[3] * w0[3]); gl1 += (t[0] * w1[0] + t[1] * w1[1]) + (t[2] * w1[2] + t[3] * w1[3]);
                        gl2 += (t[0] * w2[0] + t[1] * w2[1]) + (t[2] * w2[2] + t[3] * w2[3]); gl3 += (t[0] * w3[0] + t[1] * w3[1]) + (t[2] * w3[2] + t[3] * w3[3]);
#pragma unroll
                        for (int e = 0; e < 4; ++e) { D0 = __builtin_amdgcn_mfma_f32_16x16x4f32(a0[e], t[e], D0, 0, 0, 0); D1 = __builtin_amdgcn_mfma_f32_16x16x4f32(a1[e], t[e], D1, 0, 0, 0); }
                        asm volatile("" ::: "memory"); }
                }
                }
                gl0 += __shfl_xor(gl0, 16); gl1 += __shfl_xor(gl1, 16); gl2 += __shfl_xor(gl2, 16); gl3 += __shfl_xor(gl3, 16);
                gl0 += __shfl_xor(gl0, 32); gl1 += __shfl_xor(gl1, 32); gl2 += __shfl_xor(gl2, 32); gl3 += __shfl_xor(gl3, 32);
                float lg[4] = {gl0 + bg[0], gl1 + bg[1], gl2 + bg[2], gl3 + bg[3]}; int gidx = 0; float gmax = lg[0];
#pragma unroll
                for (int q = 1; q < 4; ++q) if (lg[q] > gmax) { gmax = lg[q]; gidx = q; }
                float gden = 0.f;
#pragma unroll
                for (int q = 0; q < 4; ++q) gden += __expf(lg[q] - gmax);
                const float gprob = 1.f / gden;
                float le8[8];
#pragma unroll
                for (int k = 0; k < 4; ++k) { le8[k] = D0[k] + be[8 * kq + k]; le8[4 + k] = D1[k] + be[8 * kq + 4 + k]; }
                int i1 = 0; float m1 = le8[0];
#pragma unroll
                for (int k = 1; k < 8; ++k) if (le8[k] > m1) { m1 = le8[k]; i1 = k; }
                int i2 = -1; float m2 = -3.0e38f;
#pragma unroll
                for (int k = 0; k < 8; ++k) if (k != i1 && le8[k] > m2) { m2 = le8[k]; i2 = k; }
                const float e2 = __expf(m2 - m1), inv = 1.f / (1.f + e2);
                const float w1r = gprob * inv, w2r = gprob * e2 * inv;
                if (kq == gidx && rep_ == 0) {
                    const int ea = gidx * 8 + i1, eb = gidx * 8 + i2;
                    const int pa = (int)__hip_atomic_fetch_add(lcnt + ea, 1u, __ATOMIC_RELAXED, __HIP_MEMORY_SCOPE_WORKGROUP) | (bx << 16), pb2 = (int)__hip_atomic_fetch_add(lcnt + eb, 1u, __ATOMIC_RELAXED, __HIP_MEMORY_SCOPE_WORKGROUP) | (bx << 16);
                    tok_e[2 * m] = ea; tok_e[2 * m + 1] = eb; tok_p[2 * m] = pa; tok_p[2 * m + 1] = pb2; tok_w[2 * m] = w1r; tok_w[2 * m + 1] = w2r;
                }
            }
#else
                __builtin_trap();
#endif
            }
#else
            const int grp = lane >> 5, s32 = lane & 31;
            { LAS f32x4* wl = (LAS f32x4*)(lds + LDS_RW); const f32x4* wg4 = (const f32x4*)wtr;
              for (int i = tid; i < 36 * 256; i += NTHREADS) wl[i] = wg4[i];
              __syncthreads(); }
            const LAS f32x4* wl4 = (const LAS f32x4*)(lds + LDS_RW) + s32;
            for (int m0 = gw * 2; m0 < mrows; m0 += NGW * 2) {
                const int m = m0 + grp;
                const bool isctx = m0 >= SEQ; const float* mm = isctx ? modcl : modl;
                f32x4 t[8];
                float ss = 0.f;
#pragma unroll
                for (int jj = 0; jj < 8; ++jj) { t[jj] = *(const f32x4*)(xcur + (size_t)m * 1024 + 4 * s32 + 128 * jj); ss += (t[jj][0] * t[jj][0] + t[jj][1] * t[jj][1]) + (t[jj][2] * t[jj][2] + t[jj][3] * t[jj][3]); }
                ss = dpp_sum16(ss); ss += __shfl_xor(ss, 16);
                const float rstd = __builtin_amdgcn_rsqf(ss * (1.f / 1024.f) + RMS_EPS);
                int s32o = s32; asm volatile("" : "+v"(s32o));
#pragma unroll
                for (int jj = 0; jj < 8; ++jj) { const int c0 = 4 * s32o + 128 * jj; const f32x4 gn = *(const f32x4*)(gffn + c0), sh = *(const f32x4*)(mm + 3 * 1024 + c0), scl = *(const f32x4*)(mm + 4 * 1024 + c0);
                    t[jj] = t[jj] * rstd * gn * (scl + 1.f) + sh;
#if FP8_G
                    *(unsigned*)((unsigned char*)HB + (size_t)m * 1024 + c0) = pg8::pk4_e4m3(t[jj][0], t[jj][1], t[jj][2], t[jj][3]); }
#else
                    *(u32x2*)(HB + (size_t)m * 1024 + c0) = (u32x2){pkbf(t[jj][0], t[jj][1]), pkbf(t[jj][2], t[jj][3])}; }
#endif
                float acc[36];
                const LAS f32x4* wlo = wl4; asm volatile("" : "+v"(wlo));
#pragma unroll
                for (int o = 0; o < 36; o += 2) {
                    f32x4 wa[8], wb[8];
#pragma unroll
                    for (int jj = 0; jj < 8; ++jj) { wa[jj] = wlo[o * 256 + jj * 32]; wb[jj] = wlo[(o + 1) * 256 + jj * 32]; }
                    asm volatile("" ::: "memory");
                    float a0 = 0.f, a1 = 0.f;
#pragma unroll
                    for (int jj = 0; jj < 8; ++jj) { a0 += (t[jj][0] * wa[jj][0] + t[jj][1] * wa[jj][1]) + (t[jj][2] * wa[jj][2] + t[jj][3] * wa[jj][3]);
                        a1 += (t[jj][0] * wb[jj][0] + t[jj][1] * wb[jj][1]) + (t[jj][2] * wb[jj][2] + t[jj][3] * wb[jj][3]); }
                    a0 = dpp_sum16(a0); a1 = dpp_sum16(a1);
                    acc[o] = a0 + __shfl_xor(a0, 16); acc[o + 1] = a1 + __shfl_xor(a1, 16);
                    asm volatile("" ::: "memory"); }
                float lg[4]; int gidx = 0; float gmax;
#pragma unroll
                for (int q = 0; q < 4; ++q) lg[q] = acc[q] + bg[q];
                gmax = lg[0];
#pragma unroll
                for (int q = 1; q < 4; ++q) if (lg[q] > gmax) { gmax = lg[q]; gidx = q; }
                float gden = 0.f;
#pragma unroll
                for (int q = 0; q < 4; ++q) gden += __expf(lg[q] - gmax);
                const float gprob = 1.f / gden;
                float le8[8];
#pragma unroll
                for (int k = 0; k < 8; ++k) { float s = acc[4 + k] + be[k];
#pragma unroll
                    for (int q = 1; q < 4; ++q) s = (gidx == q) ? acc[4 + 8 * q + k] + be[8 * q + k] : s;
                    le8[k] = s; }
                int i1 = 0; float m1 = le8[0];
#pragma unroll
                for (int k = 1; k < 8; ++k) if (le8[k] > m1) { m1 = le8[k]; i1 = k; }
                int i2 = -1; float m2 = -3.0e38f;
#pragma unroll
                for (int k = 0; k < 8; ++k) if (k != i1 && le8[k] > m2) { m2 = le8[k]; i2 = k; }
                const float e2 = __expf(m2 - m1), inv = 1.f / (1.f + e2);
                const float w1 = gprob * inv, w2 = gprob * e2 * inv;
                if (s32 == 0 && rep_ == 0) {
                    const int ea = gidx * 8 + i1, eb = gidx * 8 + i2;
                    const int pa = (int)__hip_atomic_fetch_add(lcnt + ea, 1u, __ATOMIC_RELAXED, __HIP_MEMORY_SCOPE_WORKGROUP) | (bx << 16), pb2 = (int)__hip_atomic_fetch_add(lcnt + eb, 1u, __ATOMIC_RELAXED, __HIP_MEMORY_SCOPE_WORKGROUP) | (bx << 16);
                    tok_e[2 * m] = ea; tok_e[2 * m + 1] = eb; tok_p[2 * m] = pa; tok_p[2 * m + 1] = pb2; tok_w[2 * m] = w1; tok_w[2 * m + 1] = w2;
                }
            }
#endif
            __syncthreads();
            if (tid < 32 && rep_ == 0) ctl[CW_CNT + l * 16384 + bx * 32 + tid] = lcnt[tid];
        REP_END }
        SEAM(pb + 4); TSTAMP(7);

        if (IN(pb + 5)) { if (!PH_ON(6)) __builtin_trap(); asm volatile("; MARK_PHASE pb+5" ::: "memory"); PHASE_IDS(); REP_BEGIN(8)
            LAS int* sbt = (LAS int*)lds;
            LAS int* seg = sbt + 8192; LAS int* ebase = seg + 512;
            { const unsigned* cg = ctl + CW_CNT + l * 16384 + tid; int cv[16];
#pragma unroll
              for (int j = 0; j < 16; ++j) cv[j] = (int)__hip_atomic_load(cg + 512 * j, __ATOMIC_RELAXED, __HIP_MEMORY_SCOPE_AGENT);
#pragma unroll
              for (int j = 0; j < 16; ++j) sbt[tid + 512 * j] = cv[j]; }
            __syncthreads();
            const int fe = tid & 31, fsg = tid >> 5;
            { int ssum = 0;
#pragma unroll
              for (int c = 0; c < 16; ++c) ssum += sbt[(16 * fsg + c) * 32 + fe];
              seg[fsg * 32 + fe] = ssum; }
            __syncthreads();
            int pad = 0, tot = 0;
            if (lane < 32) {
#pragma unroll
                for (int q = 0; q < 16; ++q) tot += seg[q * 32 + lane];
                pad = (tot + 255) & ~255; }
            int incl = pad;
#pragma unroll
            for (int o = 1; o < 32; o <<= 1) { const int t = __shfl_up(incl, o); if (lane >= o) incl += t; }
            const int base = incl - pad;
            if (wave == 0 && lane < 32) { ebase[lane] = base; ebase[32 + lane] = pad; }
            __syncthreads();
            { int run = ebase[fe];
              for (int q = 0; q < fsg; ++q) run += seg[q * 32 + fe];
#pragma unroll
              for (int c = 0; c < 16; ++c) { const int idx = (16 * fsg + c) * 32 + fe; const int cnt = sbt[idx]; sbt[idx] = run; run += cnt; } }
            __syncthreads();
#if FP8_G
            if (NGW == 2048) {
                static_assert(MT <= 9 * 256 * 8 && SEQ >= 8 * 256 * 8, "dispatch batch");
                constexpr int NGWC = 2048;
                const int mj = gw + NGWC * (lane >> 1);
                int rowj = 0;
                if (lane < 18 && mj < mrows) { const int e = tok_e[2 * mj + (lane & 1)], pp = tok_p[2 * mj + (lane & 1)]; const float w = tok_w[2 * mj + (lane & 1)];
                    rowj = sbt[(pp >> 16) * 32 + e] + (pp & 0xffff); drow[2 * mj + (lane & 1)] = rowj; rw[rowj] = w; }
                const unsigned char* src = (const unsigned char*)HB + (size_t)gw * 1024 + 16 * lane;
                const bool last = gw + NGWC * 8 < mrows;
                u32x4 rv[9];
#pragma unroll
                for (int it = 0; it < 8; ++it) rv[it] = *(const u32x4*)(src + (size_t)NGWC * 1024 * it);
                rv[8] = (u32x4){0u, 0u, 0u, 0u}; if (last) rv[8] = *(const u32x4*)(src + (size_t)NGWC * 1024 * 8);
#pragma unroll
                for (int it = 0; it < 9; ++it) if (it < 8 || last) {
                    const int r0 = __builtin_amdgcn_readlane(rowj, 2 * it), r1 = __builtin_amdgcn_readlane(rowj, 2 * it + 1);
                    *(u32x4*)((unsigned char*)XG + (size_t)r0 * 1024 + 16 * lane) = rv[it]; *(u32x4*)((unsigned char*)XG + (size_t)r1 * 1024 + 16 * lane) = rv[it]; }
            } else
#endif
            for (int m = gw; m < mrows; m += NGW) {
#pragma unroll
                for (int k = 0; k < 2; ++k) {
                    const int e = tok_e[2 * m + k], pp = tok_p[2 * m + k];
                    const int row = sbt[(pp >> 16) * 32 + e] + (pp & 0xffff);
#if FP8_G
                    *(u32x4*)((unsigned char*)XG + (size_t)row * 1024 + 16 * lane) = *(const u32x4*)((const unsigned char*)HB + (size_t)m * 1024 + 16 * lane);
#else
                    const bf16* src = HB + (size_t)m * 1024; bf16* dst = XG + (size_t)row * 1024;
#pragma unroll
                    for (int j = 0; j < 2; ++j) *(u32x4*)(dst + 8 * lane + 512 * j) = *(const u32x4*)(src + 8 * lane + 512 * j);
#endif
                    if (lane == 0) { drow[2 * m + k] = row; rw[row] = tok_w[2 * m + k]; }
                }
            }
            if (bx == 0 && wave == 0) {
                if (lane < 32) for (int t = base >> 8; t < (base + pad) >> 8; ++t) tile_e[t] = lane;
                if (lane == 31) ntl[0] = (base + pad) >> 8;
            }
        REP_END }
        SEAM(pb + 5); TSTAMP(8);

        if (IN(pb + 6)) { if (!PH_ON(7)) __builtin_trap(); asm volatile("; MARK_PHASE pb+6" ::: "memory"); PHASE_IDS(); REP_BEGIN(9)
            LAS int* tab = (LAS int*)(lds + TAB_OFF);
            if (tid < 256) tab[tid] = tile_e[tid];
            if (tid == 0) tab[256] = ntl[0];
            __syncthreads();
            const int nt = tab[256];
            constexpr size_t ESZ = FP8_G ? 1 : 2;
            pg8::Gemm g{XG, (const bf16*)(ws + WS_BT_W13 + (size_t)l * NEXP * 1024 * 1024 * ESZ), XG_ROWS, 1024, 1024};
            pg8::MoeOrder S{tab, nt * 4, G, bx};
            pg8::EpiSwiGLU E{HG, FP8_H};
            pg8::gemm_phase<pg8::EpiSwiGLU, pg8::MoeOrder, true, true, FP8_G != 0>(lds, g, S, E);
        REP_END }
        SEAM(pb + 6); TSTAMP(9);

        if (IN(pb + 7)) { if (!PH_ON(8)) __builtin_trap(); asm volatile("; MARK_PHASE pb+7" ::: "memory"); PHASE_IDS(); REP_BEGIN(10)
            LAS int* tab = (LAS int*)(lds + TAB_OFF);
            if (tid < 256) tab[tid] = tile_e[tid];
            if (tid == 0) tab[256] = ntl[0];
            __syncthreads();
            const int nt = tab[256];
            constexpr size_t ESZ = FP8_H ? 1 : 2;
            pg8::Gemm g{HG, (const bf16*)(ws + WS_BT_W2 + (size_t)l * NEXP * 1024 * 512 * ESZ), XG_ROWS, 1024, 512};
            pg8::MoeOrder S{tab, nt * 4, G, bx};
            pg8::EpiY E{YG, rw};
            pg8::gemm_phase<pg8::EpiY, pg8::MoeOrder, true, true, FP8_H != 0>(lds, g, S, E);
        REP_END }
        SEAM(pb + 7); TSTAMP(10);
    }

    if (IN(NPH - 1)) { if (!PH_ON(9)) __builtin_trap(); asm volatile("; MARK_PHASE final" ::: "memory"); PHASE_IDS();
        const float* gate = mod + (DEPTH - 1) * 6144 + 5 * 1024;
#if ATT_TIMING
        float tscale; { const unsigned long long* tm = (const unsigned long long*)(ws + WS_CTL + 300000); const int ti_ = ((ATT_TIMING - 1) & 1) * 2; const double fr = (double)tm[ti_] / (double)tm[ti_ + 1];
            tscale = 1.05f + 0.05f * (float)(int)(fr * 16.0 + 0.5); }
#endif
#if TPROBE >= 0
#if TPROBE == 98
        float tscale; { const unsigned long long* sp = (const unsigned long long*)(ws + WS_CTL + 400000); const double mean = (double)sp[0] / (double)sp[2], mx = (double)sp[1];
            tscale = 1.05f + 0.05f * (float)(int)((mx / mean - 1.0) * 100.0 + 0.5); }
#elif TPROBE == 97
        float tscale; { unsigned long long tot = tms[7]; for (int q = 11; q < 16; ++q) tot += tms[q]; tscale = 1.0f + 0.1f * (float)(int)((double)tot / 100.0 / (double)TPBIN + 0.5); }
#elif TPROBE == 99
        float tscale; { unsigned long long tot = 0; for (int q = 0; q < 11; ++q) tot += tms[q]; tscale = 1.05f + 0.05f * (float)(int)((double)tot / 100.0 / 64.0 + 0.5); }
#else
        float tscale; { tscale = 1.0f + 0.1f * (float)(int)((double)tms[TPROBE] / 100.0 / (double)TPBIN + 0.5); }
#endif
#endif
#if !(ATT_TIMING || TPROBE >= 0)
        if (NGW == 2048) {
            int dj = 0; if (lane < 16) dj = drow[2 * (gw + 2048 * (lane >> 1)) + (lane & 1)];
            f32x4 gt[4];
#pragma unroll
            for (int j = 0; j < 4; ++j) gt[j] = *(const f32x4*)(gate + 4 * lane + 256 * j);
            f32x4 xv[2][4]; u32x2 y0[2][4], y1[2][4];
#define F_ISSUE(it, b) { const int d0 = __builtin_amdgcn_readlane(dj, 2 * (it)), d1 = __builtin_amdgcn_readlane(dj, 2 * (it) + 1); \
                _Pragma("unroll") for (int j = 0; j < 4; ++j) { const int c0 = 4 * lane + 256 * j; xv[b][j] = *(const f32x4*)(xcur + (size_t)(gw + 2048 * (it)) * 1024 + c0); \
                    y0[b][j] = *(const u32x2*)(YG + (size_t)d0 * 1024 + c0); y1[b][j] = *(const u32x2*)(YG + (size_t)d1 * 1024 + c0); } }
            F_ISSUE(0, 0)
#pragma unroll
            for (int it = 0; it < 8; ++it) { const int b = it & 1;
                if (it + 1 < 8) { if (b) F_ISSUE(it + 1, 0) else F_ISSUE(it + 1, 1) }
                asm volatile("" ::: "memory");
#pragma unroll
                for (int j = 0; j < 4; ++j) { const u32x2 a0 = y0[b][j], a1 = y1[b][j]; f32x4 v = xv[b][j];
                    if (!((DBG_NO_MOE >> 3) & 1)) v = v + gt[j] * (f32x4){bflo(a0.x) + bflo(a1.x), bfhi(a0.x) + bfhi(a1.x), bflo(a0.y) + bflo(a1.y), bfhi(a0.y) + bfhi(a1.y)};
                    *(f32x4*)(args.out + (size_t)(gw + 2048 * it) * 1024 + 4 * lane + 256 * j) = v; }
                asm volatile("" ::: "memory");
            }
#undef F_ISSUE
        } else
#endif
        for (int m = gw; m < SEQ; m += NGW) {
            const int d0 = drow[2 * m], d1 = drow[2 * m + 1];
#pragma unroll
            for (int j = 0; j < 4; ++j) { const int c0 = 4 * lane + 256 * j;
                f32x4 v = *(const f32x4*)(xcur + (size_t)m * 1024 + c0);
                const u32x2 y0 = *(const u32x2*)(YG + (size_t)d0 * 1024 + c0), y1 = *(const u32x2*)(YG + (size_t)d1 * 1024 + c0);
                const f32x4 gt = *(const f32x4*)(gate + c0);
                if (!((DBG_NO_MOE >> 3) & 1)) v = v + gt * (f32x4){bflo(y0.x) + bflo(y1.x), bfhi(y0.x) + bfhi(y1.x), bflo(y0.y) + bflo(y1.y), bfhi(y0.y) + bfhi(y1.y)};
#if ATT_TIMING || TPROBE >= 0
                v = *(const f32x4*)(args.in[I_X] + (size_t)m * 1024 + c0);
#endif
#if TPROBE >= 0 || ATT_TIMING
                v = v * tscale;
#endif
                *(f32x4*)(args.out + (size_t)m * 1024 + c0) = v; }
        }
    }
#undef IN
#undef SEAM
}

#ifndef MK_PER_PHASE
#define MK_PER_PHASE 0
#endif
extern "C" void kernel_launch(void* const* d_in, const int* in_sizes, int n_in, void* d_out, int out_size, void* d_ws, size_t ws_size, hipStream_t stream) {
    static int grid = 0;
    if (grid == 0) {
        if (n_in != 28 || out_size != SEQ * DM || ws_size < WS_END) { fprintf(stderr, "kernel_launch: unexpected shapes (n_in %d, out %d, ws %zu)\n", n_in, out_size, ws_size); grid = -1; return; }
        int dev = 0, cus = 0;
        if (hipGetDevice(&dev) != hipSuccess || hipDeviceGetAttribute(&cus, hipDeviceAttributeMultiprocessorCount, dev) != hipSuccess) { grid = -1; return; }
        if (hipFuncSetAttribute((const void*)mega, hipFuncAttributeMaxDynamicSharedMemorySize, LDS_BYTES) != hipSuccess) { fprintf(stderr, "kernel_launch: hipFuncSetAttribute failed\n"); grid = -1; return; }
        (void)hipGetLastError();
        grid = cus < 256 ? cus : 256;
    }
    if (grid < 0) return;
    (void)hipMemsetAsync((char*)d_ws + WS_CTL, 0, CTL_ZERO_BYTES, stream);
    Args a{};
    for (int i = 0; i < 28; ++i) a.in[i] = (const float*)d_in[i];
    a.out = (float*)d_out; a.ws = (unsigned char*)d_ws;
#if MK_PER_PHASE
    for (int p = 0; p < NPH; ++p) { a.ph_lo = p; a.ph_hi = p + 1; hipLaunchKernelGGL(mega, dim3(grid), dim3(NTHREADS), LDS_BYTES, stream, a); }
#else
    a.ph_lo = 0; a.ph_hi = NPH; hipLaunchKernelGGL(mega, dim3(grid), dim3(NTHREADS), LDS_BYTES, stream, a);
#endif
}
```

```cpp
#include <hip/hip_runtime.h>
#include <cstdio>
#include <cstdint>
namespace pg8 {
#define PG8_LAS __attribute__((address_space(3)))
typedef unsigned short bf16_t;
typedef short bf16x8 __attribute__((ext_vector_type(8)));
typedef float f32x4 __attribute__((ext_vector_type(4)));
typedef unsigned u32x4 __attribute__((ext_vector_type(4)));
constexpr int BM = 256, BK = 64, HALF = 128, HTB = HALF * BK * 2  , STAGE_BYTES = 8 * HTB, NXCD = 8, WGM = 8;

__host__ __device__ __forceinline__ int lds_byte(int r, int c) { const int st = (r >> 4) * 2 + (c >> 5), rr = r & 15, cc = c & 31, ob = rr * 64 + cc * 2; return st * 1024 + (ob ^ (((ob >> 9) & 1) << 5)); }
__host__ __device__ __forceinline__ void stage_rc(int b, int& R, int& C) { const int st = b / 1024, sb = b % 1024, swz = sb ^ (((sb >> 9) & 1) << 5); R = (st >> 1) * 16 + swz / 64; C = (st & 1) * 32 + (swz % 64) / 2; }
__host__ __device__ __forceinline__ int perm32(int rho) { const int n = rho >> 4, i = rho & 15; return 8 * (i >> 2) + 4 * n + (i & 3); }

struct Unit { int pm, pn; };
struct Gemm { const bf16_t* A; const bf16_t* Bt; int M, N, K; };

struct StaticOrder {
    int nM, nN, nwg, G, c;
    __host__ __device__ void init(int M, int N, int G_, int c_) { nM = M / BM; nN = N / BM; nwg = nM * nN; G = G_; c = c_; }
    __host__ __device__ bool next(int i, Unit& u) const {
        const long L = (long)i * G + c; if (L >= nwg) return false;
        int wgid = (int)L; { const int q = nwg / NXCD, r = nwg % NXCD, xcd = wgid % NXCD, off = wgid / NXCD; wgid = (xcd < r ? xcd * (q + 1) : r * (q + 1) + (xcd - r) * q) + off; }
        const int nig = WGM * nN, gid = wgid / nig, fm = gid * WGM, gsz = (nM - fm) < WGM ? (nM - fm) : WGM;
        u.pm = fm + ((wgid % nig) % gsz); u.pn = (wgid % nig) / gsz; return true;
    }
    __device__ __forceinline__ void a_ready(const Unit&) const {}
    __device__ __forceinline__ void done(const Unit&) const {}
};

__device__ __forceinline__ unsigned cvt_pk_bf16(float lo, float hi) { unsigned r; asm volatile("v_cvt_pk_bf16_f32 %0, %1, %2" : "=v"(r) : "v"(lo), "v"(hi)); return r; }
typedef float f32x2v __attribute__((ext_vector_type(2)));
typedef unsigned u32x2v __attribute__((ext_vector_type(2)));
typedef __bf16 bf16x2v __attribute__((ext_vector_type(2)));
__device__ __forceinline__ unsigned pkbf(float lo, float hi) { f32x2v v = {lo, hi}; bf16x2v b = __builtin_convertvector(v, bf16x2v); return __builtin_bit_cast(unsigned, b); }
__device__ __forceinline__ float swap_sum16(float x) { return x + __shfl_xor(x, 16); }
__device__ __forceinline__ float swap_sum32(float x) { return x + __shfl_xor(x, 32); }
constexpr int E_SEQ = 16384, E_MT = 16640;
constexpr size_t E_SLOT = (size_t)E_MT * 64;
constexpr float E_C2 = 0.125f * 1.4426950408889634f;

struct EpiQKV {
    static constexpr bool PERM = true, AFTER_DRAIN = false;
    bf16_t* qkv; const float *gq0, *gk0, *gq1, *gk1; const float* rope; int isC;
    __device__ __forceinline__ void operator()(const f32x4 (&acc)[2][2][4][2], const Unit& u, int wr, int wc, int fr, int fq) const {
        const int gi = u.pn * 4 + wc;
        int type; const float* gain = gq0; bf16_t* out; int pitch = 64;
        if (!isC) {
            if (gi < 8) { type = 0; gain = gq0; } else if (gi < 10) { type = 1; gain = gk0; } else if (gi < 12) { type = 2; }
            else if (gi < 20) { type = 0; gain = gq1; } else if (gi < 22) { type = 1; gain = gk1; } else { type = 2; }
            out = qkv + (size_t)gi * E_SLOT;
        } else {
            if (gi < 16) { type = 0; gain = gq0; out = qkv + (size_t)gi * E_SLOT; }
            else if (gi < 32) { type = 1; gain = gk0; out = qkv + (size_t)gi * E_SLOT; }
            else { type = 2; const int vg = gi - 32; out = qkv + (size_t)(32 + 2 * (vg >> 1)) * E_SLOT + (vg & 1) * 64; pitch = 128; }
        }
        const int rowbase = u.pm * BM + wr * 64 + fr;
        if (type < 2) {
            f32x4 g[2][2];
#pragma unroll
            for (int bj = 0; bj < 2; ++bj)
#pragma unroll
                for (int n = 0; n < 2; ++n) g[bj][n] = *(const f32x4*)(gain + bj * 32 + 8 * fq + 4 * n);
            const float qs = (type == 0) ? E_C2 : 1.f;
#pragma unroll
            for (int ai = 0; ai < 2; ++ai)
#pragma unroll
                for (int m = 0; m < 4; ++m) {
                    const int r = rowbase + ai * HALF + m * 16;
                    f32x4 v[2][2];
#pragma unroll
                    for (int bj = 0; bj < 2; ++bj)
#pragma unroll
                        for (int n = 0; n < 2; ++n) v[bj][n] = acc[ai][bj][m][n];
                    float ss = 0.f;
#pragma unroll
                    for (int bj = 0; bj < 2; ++bj)
#pragma unroll
                        for (int n = 0; n < 2; ++n) ss += (v[bj][n][0] * v[bj][n][0] + v[bj][n][1] * v[bj][n][1]) + (v[bj][n][2] * v[bj][n][2] + v[bj][n][3] * v[bj][n][3]);
                    ss = swap_sum16(ss); ss = swap_sum32(ss);
                    const float rstd = __builtin_amdgcn_rsqf(ss * (1.f / 64.f) + 1e-6f) * qs;
#pragma unroll
                    for (int bj = 0; bj < 2; ++bj)
#pragma unroll
                        for (int n = 0; n < 2; ++n) v[bj][n] = v[bj][n] * rstd * g[bj][n];
                    const int rr = (r < E_SEQ) ? r : 0;
                    const float* tb = (fq < 2) ? (rope + (rr >> 6) * 16 + 8 * fq) : (rope + 8192 + (rr & 63) * 16 + 8 * (fq - 2));
                    const int so = (fq < 2) ? 4096 : 1024;
#pragma unroll
                    for (int n = 0; n < 2; ++n) {
                        f32x4 cs = *(const f32x4*)(tb + 4 * n), sn = *(const f32x4*)(tb + so + 4 * n);
                        if (r >= E_SEQ) { cs = (f32x4){1.f, 1.f, 1.f, 1.f}; sn = (f32x4){0.f, 0.f, 0.f, 0.f}; }
                        const f32x4 y1 = v[0][n], y2 = v[1][n];
                        v[0][n] = y1 * cs - y2 * sn; v[1][n] = y2 * cs + y1 * sn;
                    }
#pragma unroll
                    for (int bj = 0; bj < 2; ++bj) {
                        u32x4 w; w.x = pkbf(v[bj][0][0], v[bj][0][1]); w.y = pkbf(v[bj][0][2], v[bj][0][3]); w.z = pkbf(v[bj][1][0], v[bj][1][1]); w.w = pkbf(v[bj][1][2], v[bj][1][3]);
                        *(u32x4*)(out + (size_t)r * 64 + bj * 32 + 8 * fq) = w;
                    }
                }
        } else {
#pragma unroll
            for (int ai = 0; ai < 2; ++ai)
#pragma unroll
                for (int m = 0; m < 4; ++m) {
                    const int r = rowbase + ai * HALF + m * 16;
#pragma unroll
                    for (int bj = 0; bj < 2; ++bj) {
                        const f32x4 v0 = acc[ai][bj][m][0], v1 = acc[ai][bj][m][1];
                        u32x4 w; w.x = pkbf(v0[0], v0[1]); w.y = pkbf(v0[2], v0[3]); w.z = pkbf(v1[0], v1[1]); w.w = pkbf(v1[2], v1[3]);
                        *(u32x4*)(out + (size_t)r * pitch + bj * 32 + 8 * fq) = w;
                    }
                }
        }
    }
};

constexpr size_t E_SL8 = (size_t)E_MT * 64;
constexpr size_t E_VT_AB = (size_t)260 * 64 * 64, E_VT_C = (size_t)260 * 128 * 64;
__device__ __forceinline__ unsigned pk4_e4m3(float a, float b, float c, float d) { int w = __builtin_amdgcn_cvt_pk_fp8_f32(a, b, 0, false); w = __builtin_amdgcn_cvt_pk_fp8_f32(c, d, w, true); return (unsigned)w; }
#ifndef QK16
#define QK16 0
#endif
typedef unsigned u32x4v __attribute__((ext_vector_type(4)));
#ifndef V_QUAD
#define V_QUAD 0
#endif
#ifndef QKV_NOV
#define QKV_NOV 0
#endif
struct EpiQKV8 {
    static constexpr bool PERM = true, AFTER_DRAIN = false;
    unsigned char* q8; const float *gq0, *gk0, *gq1, *gk1; const float* rope; int isC;
    __device__ __forceinline__ void operator()(const f32x4 (&acc)[2][2][4][2], const Unit& u, int wr, int wc, int fr, int fq) const {
        const int gi = u.pn * 4 + wc;
        int type; const float* gain = gq0; unsigned char* out = q8 + (size_t)gi * E_SL8; int dv = 64, dbase = 0;
        if (!isC) {
            if (gi < 8) { type = 0; gain = gq0; } else if (gi < 10) { type = 1; gain = gk0; } else if (gi < 12) { type = 2; out = q8 + 24 * E_SL8 + (size_t)(gi - 10) * E_VT_AB; }
            else if (gi < 20) { type = 0; gain = gq1; } else if (gi < 22) { type = 1; gain = gk1; } else { type = 2; out = q8 + 24 * E_SL8 + (size_t)(gi - 20) * E_VT_AB; }
        } else {
            if (gi < 16) { type = 0; gain = gq0; } else if (gi < 32) { type = 1; gain = gk0; }
            else { type = 2; const int vg = gi - 32; out = q8 + 32 * E_SL8 + (size_t)(vg >> 1) * E_VT_C; dv = 128; dbase = (vg & 1) * 64; }
        }
        const int rowbase = u.pm * BM + wr * 64 + fr;
        if (type < 2) {
            f32x4 g[2][2];
#pragma unroll
            for (int bj = 0; bj < 2; ++bj)
#pragma unroll
                for (int n = 0; n < 2; ++n) g[bj][n] = *(const f32x4*)(gain + bj * 32 + 8 * fq + 4 * n);
            const float qs = (type == 0) ? 4.f * E_C2 : 1.f;
#pragma unroll
            for (int ai = 0; ai < 2; ++ai)
#pragma unroll
                for (int m = 0; m < 4; ++m) {
                    const int r = rowbase + ai * HALF + m * 16;
                    f32x4 v[2][2];
#pragma unroll
                    for (int bj = 0; bj < 2; ++bj)
#pragma unroll
                        for (int n = 0; n < 2; ++n) v[bj][n] = acc[ai][bj][m][n];
                    float ss = 0.f;
#pragma unroll
                    for (int bj = 0; bj < 2; ++bj)
#pragma unroll
                        for (int n = 0; n < 2; ++n) ss += (v[bj][n][0] * v[bj][n][0] + v[bj][n][1] * v[bj][n][1]) + (v[bj][n][2] * v[bj][n][2] + v[bj][n][3] * v[bj][n][3]);
                    ss = swap_sum16(ss); ss = swap_sum32(ss);
                    const float rstd = __builtin_amdgcn_rsqf(ss * (1.f / 64.f) + 1e-6f) * qs;
#pragma unroll
                    for (int bj = 0; bj < 2; ++bj)
#pragma unroll
                        for (int n = 0; n < 2; ++n) v[bj][n] = v[bj][n] * rstd * g[bj][n];
                    const int rr = (r < E_SEQ) ? r : 0;
                    const float* tb = (fq < 2) ? (rope + (rr >> 6) * 16 + 8 * fq) : (rope + 8192 + (rr & 63) * 16 + 8 * (fq - 2));
                    const int so = (fq < 2) ? 4096 : 1024;
#pragma unroll
                    for (int n = 0; n < 2; ++n) {
                        f32x4 cs = *(const f32x4*)(tb + 4 * n), sn = *(const f32x4*)(tb + so + 4 * n);
                        if (r >= E_SEQ) { cs = (f32x4){1.f, 1.f, 1.f, 1.f}; sn = (f32x4){0.f, 0.f, 0.f, 0.f}; }
                        const f32x4 y1 = v[0][n], y2 = v[1][n];
                        v[0][n] = y1 * cs - y2 * sn; v[1][n] = y2 * cs + y1 * sn;
                    }
#if QK16
                    { u32x4v w; w.x = pk4_e4m3(v[0][0][0], v[0][0][1], v[0][0][2], v[0][0][3]); w.y = pk4_e4m3(v[0][1][0], v[0][1][1], v[0][1][2], v[0][1][3]);
                      w.z = pk4_e4m3(v[1][0][0], v[1][0][1], v[1][0][2], v[1][0][3]); w.w = pk4_e4m3(v[1][1][0], v[1][1][1], v[1][1][2], v[1][1][3]);
                      if (QKV_NOV < 2) *(u32x4v*)(out + (size_t)r * 64 + 16 * fq) = w; }
#else
#pragma unroll
                    for (int bj = 0; bj < 2; ++bj) {
                        u32x2v w; w.x = pk4_e4m3(v[bj][0][0], v[bj][0][1], v[bj][0][2], v[bj][0][3]); w.y = pk4_e4m3(v[bj][1][0], v[bj][1][1], v[bj][1][2], v[bj][1][3]);
                        if (QKV_NOV < 2) *(u32x2v*)(out + (size_t)r * 64 + bj * 32 + 8 * fq) = w;
                    }
#endif
                }
        } else {
#pragma unroll
            for (int ai = 0; ai < 2; ++ai)
#pragma unroll
                for (int m = 0; m < 4; ++m) {
                    const int r = rowbase + ai * HALF + m * 16;
                    const int pos = 32 * ((fr >> 2) & 1) + (fr & 3) + 4 * (2 * (m & 1) + (fr >> 3)) + 16 * (m >> 1);
#if V_QUAD
                    const unsigned sel1 = (fr & 1) ? 0x03070105u : 0x06020400u, sel2 = (fr & 2) ? 0x03020706u : 0x05040100u;
                    unsigned char* rq = out + ((size_t)(r >> 6) * dv + dbase + 8 * fq + (fr & 3)) * 64 + (pos & ~3);
#pragma unroll
                    for (int bj = 0; bj < 2; ++bj)
#pragma unroll
                        for (int n = 0; n < 2; ++n) { const unsigned w = pk4_e4m3(acc[ai][bj][m][n][0], acc[ai][bj][m][n][1], acc[ai][bj][m][n][2], acc[ai][bj][m][n][3]);
                            const unsigned t1 = (unsigned)__builtin_amdgcn_mov_dpp((int)w, 0xB1, 0xF, 0xF, true);
                            const unsigned x1 = __builtin_amdgcn_perm(t1, w, sel1);
                            const unsigned t2 = (unsigned)__builtin_amdgcn_mov_dpp((int)x1, 0x4E, 0xF, 0xF, true);
                            const unsigned x2 = __builtin_amdgcn_perm(t2, x1, sel2);
                            if (!QKV_NOV) *(unsigned*)(rq + (size_t)(bj * 32 + 4 * n) * 64) = x2; }
#else
                    unsigned char* rp = out + ((size_t)(r >> 6) * dv + dbase + 8 * fq) * 64 + pos;
#pragma unroll
                    for (int bj = 0; bj < 2; ++bj)
#pragma unroll
                        for (int n = 0; n < 2; ++n) { const unsigned w = pk4_e4m3(acc[ai][bj][m][n][0], acc[ai][bj][m][n][1], acc[ai][bj][m][n][2], acc[ai][bj][m][n][3]);
#pragma unroll
                            for (int e = 0; e < 4; ++e) if (!QKV_NOV) rp[(size_t)(bj * 32 + 4 * n + e) * 64] = (unsigned char)(w >> (8 * e)); }
#endif
                }
        }
    }
};

struct EpiResid {
    static constexpr bool PERM = true, AFTER_DRAIN = false;
    float* x; const float* gate_lat; const float* gate_ctx;
    __device__ __forceinline__ void operator()(const f32x4 (&acc)[2][2][4][2], const Unit& u, int wr, int wc, int fr, int fq) const {
        const float* gate = (u.pm == 64) ? gate_ctx : gate_lat;
        const int col0 = u.pn * BM + wc * 32 + 8 * fq, rowbase = u.pm * BM + wr * 64 + fr;
        f32x4 gv[2][2];
#pragma unroll
        for (int bj = 0; bj < 2; ++bj)
#pragma unroll
            for (int n = 0; n < 2; ++n) gv[bj][n] = *(const f32x4*)(gate + col0 + bj * HALF + 4 * n);
#pragma unroll
        for (int ai = 0; ai < 2; ++ai)
#pragma unroll
            for (int m = 0; m < 4; ++m) {
                float* xr = x + (size_t)(rowbase + ai * HALF + m * 16) * 1024 + col0;
#pragma unroll
                for (int bj = 0; bj < 2; ++bj)
#pragma unroll
                    for (int n = 0; n < 2; ++n) { f32x4 xv = *(f32x4*)(xr + bj * HALF + 4 * n); xv = xv + gv[bj][n] * acc[ai][bj][m][n]; *(f32x4*)(xr + bj * HALF + 4 * n) = xv; }
            }
    }
};

struct EpiSwiGLU {
    static constexpr bool PERM = true, AFTER_DRAIN = false;
    bf16_t* H; int fp8;
    __device__ __forceinline__ void operator()(const f32x4 (&acc)[2][2][4][2], const Unit& u, int wr, int wc, int fr, int fq) const {
        const int col0 = (u.pn & 3) * 128 + wc * 32 + 8 * fq, rowbase = u.pm * BM + wr * 64 + fr;
#pragma unroll
        for (int ai = 0; ai < 2; ++ai)
#pragma unroll
            for (int m = 0; m < 4; ++m) {
                float h[8];
#pragma unroll
                for (int n = 0; n < 2; ++n)
#pragma unroll
                    for (int e = 0; e < 4; ++e) { const float a = acc[ai][0][m][n][e], b = acc[ai][1][m][n][e];
                        h[4 * n + e] = a * b * __builtin_amdgcn_rcpf(1.f + __builtin_amdgcn_exp2f(-1.4426950408889634f * a)); }
                if (fp8) { u32x2v w; w.x = pk4_e4m3(h[0], h[1], h[2], h[3]); w.y = pk4_e4m3(h[4], h[5], h[6], h[7]);
                    *(u32x2v*)((unsigned char*)H + (size_t)(rowbase + ai * HALF + m * 16) * 512 + col0) = w; }
                else { u32x4 w; w.x = pkbf(h[0], h[1]); w.y = pkbf(h[2], h[3]); w.z = pkbf(h[4], h[5]); w.w = pkbf(h[6], h[7]);
                    *(u32x4*)(H + (size_t)(rowbase + ai * HALF + m * 16) * 512 + col0) = w; }
            }
    }
};

struct EpiY {
    static constexpr bool PERM = true, AFTER_DRAIN = false;
    bf16_t* Y; const float* rw;
    __device__ __forceinline__ void operator()(const f32x4 (&acc)[2][2][4][2], const Unit& u, int wr, int wc, int fr, int fq) const {
        const int col0 = (u.pn & 3) * BM + wc * 32 + 8 * fq, rowbase = u.pm * BM + wr * 64 + fr;
#pragma unroll
        for (int ai = 0; ai < 2; ++ai)
#pragma unroll
            for (int m = 0; m < 4; ++m) {
                const int r = rowbase + ai * HALF + m * 16; const float w8 = rw[r];
#pragma unroll
                for (int bj = 0; bj < 2; ++bj) { const f32x4 v0 = acc[ai][bj][m][0] * w8, v1 = acc[ai][bj][m][1] * w8;
                    u32x4 w; w.x = pkbf(v0[0], v0[1]); w.y = pkbf(v0[2], v0[3]); w.z = pkbf(v1[0], v1[1]); w.w = pkbf(v1[2], v1[3]);
                    *(u32x4*)(Y + (size_t)r * 1024 + col0 + bj * HALF) = w; }
            }
    }
};

struct MoeOrder {
    const PG8_LAS int* tile_e; int nunits, G, c;
    __device__ __forceinline__ bool next(int i, Unit& u) const {
        const int L = i * G + c; if (L >= nunits) return false;
        const int pm = L >> 2; const int e = tile_e[pm];
        u.pm = __builtin_amdgcn_readfirstlane(pm); u.pn = __builtin_amdgcn_readfirstlane(e * 4 + (L & 3)); return true;
    }
    __device__ __forceinline__ void a_ready(const Unit&) const {}
    __device__ __forceinline__ void done(const Unit&) const {}
};

typedef int v8i_t __attribute__((ext_vector_type(8)));
struct bf16x8x2 { bf16x8 a, b; };
__device__ __forceinline__ f32x4 mfma_bf16_sel(bf16x8 a, bf16x8 b, f32x4 c) { return __builtin_amdgcn_mfma_f32_16x16x32_bf16(a, b, c, 0, 0, 0); }
__device__ __forceinline__ f32x4 mfma_bf16_sel(v8i_t, v8i_t, f32x4 c) { return c; }
template <bool F8> struct FragT { typedef bf16x8 type; };
template <> struct FragT<true> { typedef v8i_t type; };
template <class Epi, class Sched, bool ALIGN_EPI = false, bool SP2 = false, bool FP8 = false>
__device__ __forceinline__ void gemm_phase(PG8_LAS unsigned char* lds, const Gemm g, const Sched& S, const Epi& E) {
    int tid_ = threadIdx.x; asm volatile("" : "+v"(tid_)); __builtin_assume(tid_ >= 0 && tid_ < 512);
    const int tid = tid_, wid = __builtin_amdgcn_readfirstlane(tid >> 6), lane = tid & 63, wr = wid >> 2, wc = wid & 3, fr = lane & 15, fq = lane >> 4;
    const int K = FP8 ? g.K / 2 : g.K, nt = K / BK;
    unsigned voffA[2], voffB[2];
#pragma unroll
    for (int i = 0; i < 2; ++i) { int R, C; stage_rc(tid * 16 + i * 8192, R, C); const int Rb = Epi::PERM ? ((R & ~31) + perm32(R & 31)) : R;
        voffA[i] = (unsigned)(R * K + C) * 2u; voffB[i] = (unsigned)(Rb * K + C) * 2u; }
    const size_t kstep = (size_t)(BK * 2);
    const size_t hstep = (size_t)HALF * K * 2;
    const size_t tstep = 2 * hstep;
    const unsigned ldsw = (unsigned)wid * 1024u;
    const int aoff = lds_byte(wr * 64 + fr, fq * (FP8 ? 16 : 8)), boff = lds_byte(wc * 32 + fr, fq * (FP8 ? 16 : 8));
    constexpr int KOFF = FP8 ? 16 : 1024;
#define PG8_SA(b, h) (((b) * 2 + (h)) * HTB)
#define PG8_SB(b, h) ((4 + (b) * 2 + (h)) * HTB)
#define PG8_STAGE(bufoff, gbase, voff) do { _Pragma("unroll") for (int _i = 0; _i < 2; ++_i) \
        __builtin_amdgcn_global_load_lds((const unsigned*)((const char*)(gbase) + (voff)[_i]), (PG8_LAS unsigned*)(lds + (bufoff) + ldsw + _i * 8192), 16, 0, 0); } while (0)
#define PG8_LDA(dst, b, h) do { _Pragma("unroll") for (int m = 0; m < 4; ++m) _Pragma("unroll") for (int k = 0; k < 2; ++k) dst[m][k] = *(const PG8_LAS bf16x8*)(lds + PG8_SA(b, h) + aoff + m * 2048 + k * KOFF); } while (0)
#define PG8_LDB(dst, b, h) do { _Pragma("unroll") for (int n = 0; n < 2; ++n) _Pragma("unroll") for (int k = 0; k < 2; ++k) dst[n][k] = *(const PG8_LAS bf16x8*)(lds + PG8_SB(b, h) + boff + n * 2048 + k * KOFF); } while (0)
#define PG8_MMA(ai, bj, At, Bt) do { __builtin_amdgcn_s_setprio(1); _Pragma("unroll") for (int m = 0; m < 4; ++m) _Pragma("unroll") for (int n = 0; n < 2; ++n) { \
        if constexpr (FP8) { asm volatile("v_mfma_scale_f32_16x16x128_f8f6f4 %0, %1, %2, %0, %3, %3 op_sel_hi:[0,0,0]" : "+v"(acc[ai][bj][m][n]) : "v"(__builtin_bit_cast(v8i_t, (bf16x8x2){Bt[n][0], Bt[n][1]})), "v"(__builtin_bit_cast(v8i_t, (bf16x8x2){At[m][0], At[m][1]})), "v"(mxsc)); } \
        else { _Pragma("unroll") for (int k = 0; k < 2; ++k) acc[ai][bj][m][n] = mfma_bf16_sel(Bt[n][k], At[m][k], acc[ai][bj][m][n]); } } __builtin_amdgcn_s_setprio(0); } while (0)
#define PG8_WAIT_V(n) asm volatile("s_waitcnt vmcnt(" #n ")" ::: "memory")
#define PG8_WAIT_L(n) asm volatile("s_waitcnt lgkmcnt(" #n ")" ::: "memory")
#define PG8_BAR __builtin_amdgcn_s_barrier()
#define PG8_SCHED __builtin_amdgcn_sched_barrier(0)
    Unit cur, nxt; int ui = 0;
    if (!S.next(0, cur)) return;
    f32x4 acc[2][2][4][2];
#pragma unroll
    for (int a = 0; a < 2; ++a)
#pragma unroll
        for (int b = 0; b < 2; ++b)
#pragma unroll
            for (int m = 0; m < 4; ++m)
#pragma unroll
                for (int n = 0; n < 2; ++n) acc[a][b][m][n] = (f32x4){0.f, 0.f, 0.f, 0.f};
    int mxsc = 0x7F7F7F7F; asm volatile("" : "+v"(mxsc));
    bf16x8 At[4][2], B0[2][2], B1[2][2];
    const char* cA = (const char*)g.A + (size_t)cur.pm * tstep; const char* cB = (const char*)g.Bt + (size_t)cur.pn * tstep;
    S.a_ready(cur);
    if constexpr (SP2) {
        PG8_STAGE(PG8_SB(0, 0), cB, voffB); PG8_STAGE(PG8_SB(0, 1), cB + hstep, voffB); PG8_STAGE(PG8_SA(0, 0), cA, voffA); PG8_STAGE(PG8_SA(0, 1), cA + hstep, voffA);
        if (wr == 1) PG8_BAR;
        PG8_WAIT_V(2); PG8_BAR;
        PG8_STAGE(PG8_SB(1, 0), cB + kstep, voffB); PG8_STAGE(PG8_SA(1, 0), cA + kstep, voffA); PG8_STAGE(PG8_SB(1, 1), cB + hstep + kstep, voffB);
        PG8_WAIT_V(6); PG8_BAR;
    } else {
        PG8_STAGE(PG8_SB(0, 0), cB, voffB); PG8_STAGE(PG8_SA(0, 0), cA, voffA); PG8_STAGE(PG8_SB(0, 1), cB + hstep, voffB); PG8_STAGE(PG8_SA(0, 1), cA + hstep, voffA);
        if (wr == 1) PG8_BAR;
        PG8_WAIT_V(4); PG8_BAR;
        PG8_STAGE(PG8_SB(1, 0), cB + kstep, voffB); PG8_STAGE(PG8_SA(1, 0), cA + kstep, voffA); PG8_STAGE(PG8_SB(1, 1), cB + hstep + kstep, voffB);
        PG8_WAIT_V(6); PG8_BAR;
    }
    for (;;) {
        const bool has_next = S.next(ui + 1, nxt);
        const char* nA = has_next ? (const char*)g.A + (size_t)nxt.pm * tstep : cA; const char* nB = has_next ? (const char*)g.Bt + (size_t)nxt.pn * tstep : cB;
#pragma nounroll
        for (int t = 0; t < nt; t += 2) {
            const bool last = (t == nt - 2);
            const char* a1 = cA + (size_t)(t + 1) * kstep;
            const char* a2 = last ? nA : cA + (size_t)(t + 2) * kstep; const char* b2 = last ? nB : cB + (size_t)(t + 2) * kstep;
            const char* a3 = a2 + kstep; const char* b3 = b2 + kstep;
            if (last && has_next) S.a_ready(nxt);
            if constexpr (SP2) {
            PG8_LDB(B0, 0, 0); PG8_LDB(B1, 0, 1); PG8_SCHED; PG8_LDA(At, 0, 0); PG8_STAGE(PG8_SA(1, 1), a1 + hstep, voffA);
            PG8_WAIT_V(8); PG8_WAIT_L(0); PG8_BAR; PG8_MMA(0, 0, At, B0); PG8_MMA(0, 1, At, B1); PG8_BAR; PG8_SCHED;
            PG8_LDA(At, 0, 1); PG8_STAGE(PG8_SB(0, 0), b2, voffB); PG8_STAGE(PG8_SB(0, 1), b2 + hstep, voffB); PG8_STAGE(PG8_SA(0, 0), a2, voffA);
            PG8_WAIT_V(8); PG8_WAIT_L(0); PG8_BAR; PG8_MMA(1, 0, At, B0); PG8_MMA(1, 1, At, B1); PG8_BAR; PG8_SCHED;
            PG8_LDB(B0, 1, 0); PG8_LDB(B1, 1, 1); PG8_SCHED; PG8_LDA(At, 1, 0); PG8_STAGE(PG8_SA(0, 1), a2 + hstep, voffA);
            PG8_WAIT_V(8); PG8_WAIT_L(0); PG8_BAR; PG8_MMA(0, 0, At, B0); PG8_MMA(0, 1, At, B1); PG8_BAR; PG8_SCHED;
            PG8_LDA(At, 1, 1); PG8_STAGE(PG8_SB(1, 0), b3, voffB); PG8_STAGE(PG8_SB(1, 1), b3 + hstep, voffB); PG8_STAGE(PG8_SA(1, 0), a3, voffA);
            PG8_WAIT_V(8); PG8_WAIT_L(0); PG8_BAR; PG8_MMA(1, 0, At, B0); PG8_MMA(1, 1, At, B1); PG8_BAR; PG8_SCHED;
            } else {
            PG8_LDB(B0, 0, 0); PG8_SCHED; PG8_LDA(At, 0, 0); PG8_STAGE(PG8_SA(1, 1), a1 + hstep, voffA);
            PG8_WAIT_L(8); PG8_BAR; PG8_WAIT_L(0); PG8_MMA(0, 0, At, B0); PG8_BAR; PG8_SCHED;
            PG8_LDB(B1, 0, 1); PG8_STAGE(PG8_SB(0, 0), b2, voffB);
            PG8_BAR; PG8_WAIT_L(0); PG8_MMA(0, 1, At, B1); PG8_BAR;
            PG8_LDA(At, 0, 1); PG8_STAGE(PG8_SA(0, 0), a2, voffA);
            PG8_BAR; PG8_WAIT_L(0); PG8_MMA(1, 0, At, B0); PG8_BAR; PG8_SCHED;
            PG8_STAGE(PG8_SB(0, 1), b2 + hstep, voffB);
            PG8_WAIT_V(6); PG8_BAR; PG8_MMA(1, 1, At, B1); PG8_BAR;
            PG8_LDB(B0, 1, 0); PG8_SCHED; PG8_LDA(At, 1, 0); PG8_STAGE(PG8_SA(0, 1), a2 + hstep, voffA);
            PG8_WAIT_L(8); PG8_BAR; PG8_WAIT_L(0); PG8_MMA(0, 0, At, B0); PG8_BAR; PG8_SCHED;
            PG8_LDB(B1, 1, 1); PG8_STAGE(PG8_SB(1, 0), b3, voffB);
            PG8_BAR; PG8_WAIT_L(0); PG8_MMA(0, 1, At, B1); PG8_BAR;
            PG8_LDA(At, 1, 1); PG8_STAGE(PG8_SA(1, 0), a3, voffA);
            PG8_BAR; PG8_WAIT_L(0); PG8_MMA(1, 0, At, B0); PG8_BAR; PG8_SCHED;
            PG8_STAGE(PG8_SB(1, 1), b3 + hstep, voffB);
            PG8_WAIT_V(6); PG8_BAR; PG8_MMA(1, 1, At, B1); PG8_BAR;
            }
        }
        if constexpr (FP8) asm volatile("s_nop 15\n\ts_nop 7" ::: "memory");
        if constexpr (ALIGN_EPI) { if (wr == 0) PG8_BAR; }
        if constexpr (!Epi::AFTER_DRAIN) { E(acc, cur, wr, wc, fr, fq); S.done(cur); }
        if (!has_next) break;
#pragma unroll
        for (int a = 0; a < 2; ++a)
#pragma unroll
            for (int b = 0; b < 2; ++b)
#pragma unroll
                for (int m = 0; m < 4; ++m)
#pragma unroll
                    for (int n = 0; n < 2; ++n) acc[a][b][m][n] = (f32x4){0.f, 0.f, 0.f, 0.f};
        cur = nxt; cA = nA; cB = nB; ++ui;
        if constexpr (ALIGN_EPI) { if (wr == 1) PG8_BAR; }
    }
    PG8_WAIT_V(0);
    if constexpr (!ALIGN_EPI) { if (wr == 0) PG8_BAR; }
    PG8_BAR;
    if constexpr (Epi::AFTER_DRAIN) { E.fused(acc, cur, wr, wc, fr, fq, lds, wid, lane); S.done(cur); }
#undef PG8_SA
#undef PG8_SB
#undef PG8_STAGE
#undef PG8_LDA
#undef PG8_LDB
#undef PG8_MMA
#undef PG8_WAIT_V
#undef PG8_WAIT_L
#undef PG8_BAR
#undef PG8_SCHED
}
}
#define LAS __attribute__((address_space(3)))
#define XB_TMO      128
#define XB_XCNT(j)  (256  + 64 * (j))
#define XB_XSUB(j)  (1280 + 64 * (j))
#define XB_XGEN(j)  (2304 + 64 * (j))
#define XB_TOP      3328
#define XB_TOPGEN   3392
#define XCD_BAR_WORDS 3456
#define XB_SPIN_CAP (1u << 18)

__device__ __forceinline__ unsigned xb_ld(unsigned* p)              { return __hip_atomic_load(p, __ATOMIC_RELAXED, __HIP_MEMORY_SCOPE_AGENT); }
__device__ __forceinline__ unsigned xb_add(unsigned* p, unsigned v) { return __hip_atomic_fetch_add(p, v, __ATOMIC_RELAXED, __HIP_MEMORY_SCOPE_AGENT); }
__device__ __forceinline__ unsigned xb_xcc_id() { return (unsigned)__builtin_amdgcn_s_getreg((3 << 11) | 20) & 0xFu; }
#define XB_SPIN(cond, bar) do { unsigned _sp = 0; while (cond) { __builtin_amdgcn_s_sleep(1); \
    if ((++_sp & 255u) == 0u) { if (xb_ld(&(bar)[XB_TMO])) break; if (_sp > XB_SPIN_CAP) { atomicAdd(&(bar)[XB_TMO], 1u); break; } } } } while (0)

struct XcdBarrier {
    unsigned* bar; unsigned x;
    volatile LAS unsigned* st;
};

__device__ __forceinline__ XcdBarrier xcd_barrier_post(unsigned* bar, volatile LAS unsigned* st) {
    XcdBarrier b; b.bar = bar; b.x = xb_xcc_id(); b.st = st;
    if (threadIdx.x == 0) (void)xb_add(&bar[XB_XCNT(b.x)], 1u);
    return b;
}
__device__ __forceinline__ void xcd_barrier_complete(unsigned* bar, unsigned x, unsigned& nloc, unsigned& nx) {
    const unsigned G = gridDim.x * gridDim.y * gridDim.z;
    unsigned sum, cnt, mine, sp = 0u;
    for (;;) {
        sum = 0u; cnt = 0u; mine = 0u;
#pragma unroll
        for (unsigned j = 0; j < 16; ++j) { const unsigned c = xb_ld(&bar[XB_XCNT(j)]); sum += c; cnt += (c > 0u) ? 1u : 0u; mine = (j == x) ? c : mine; }
        if (sum == G) break;
        __builtin_amdgcn_s_sleep(1);
        if ((++sp & 255u) == 0u) { if (xb_ld(&bar[XB_TMO])) break; if (sp > XB_SPIN_CAP) { atomicAdd(&bar[XB_TMO], 1u); break; } }
    }
    nloc = mine > 0u ? mine : 1u; nx = cnt > 0u ? cnt : 1u;
}

__device__ __forceinline__ void xcd_barrier(const XcdBarrier& b) {
    asm volatile("s_waitcnt vmcnt(0)" ::: "memory");
    __syncthreads();
    if (threadIdx.x == 0) {
        unsigned* bar = b.bar;
        __builtin_amdgcn_s_waitcnt(0);
        unsigned nloc = b.st[0], nx = b.st[1];
        if (nloc == 0u) { xcd_barrier_complete(bar, b.x, nloc, nx); b.st[0] = nloc; b.st[1] = nx; }
        const unsigned old = xb_add(&bar[XB_XSUB(b.x)], 1u);
        const unsigned gen = old / nloc;
        if (old + 1u == (gen + 1u) * nloc) {
            __builtin_amdgcn_fence(__ATOMIC_RELEASE, "agent");
            asm volatile("s_waitcnt vmcnt(0)" ::: "memory");
            const unsigned og = xb_add(&bar[XB_TOP], 1u);
            const unsigned tg = og / nx;
            if (og + 1u == (tg + 1u) * nx) xb_add(&bar[XB_TOPGEN], 1u);
            else XB_SPIN(xb_ld(&bar[XB_TOPGEN]) == tg, bar);
            __builtin_amdgcn_fence(__ATOMIC_ACQUIRE, "agent");
            xb_add(&bar[XB_XGEN(b.x)], 1u);
            asm volatile("s_waitcnt vmcnt(0)" ::: "memory");
        } else {
            XB_SPIN(xb_ld(&bar[XB_XGEN(b.x)]) == gen, bar);
            __builtin_amdgcn_fence(__ATOMIC_ACQUIRE, "agent");
            asm volatile("s_waitcnt vmcnt(0)" ::: "memory");
        }
    }
    __syncthreads();
}

#ifndef GEMM_FP8
#define GEMM_FP8 1
#endif
#ifndef FP8_B
#define FP8_B 1
#define FP8_B_UNUSED GEMM_FP8
#endif
#ifndef FP8_G
#define FP8_G GEMM_FP8
#endif
#ifndef FP8_H
#define FP8_H GEMM_FP8
#endif
#ifndef USE_FP8
#define USE_FP8 1
#endif
#ifndef ATT_TIMING
#define ATT_TIMING 0
#endif
#define GAS __attribute__((address_space(1)))
typedef unsigned short bf16;
typedef float f32x4 __attribute__((ext_vector_type(4)));
typedef float f32x16 __attribute__((ext_vector_type(16)));
typedef short bf16x8 __attribute__((ext_vector_type(8)));
typedef short s16x4 __attribute__((ext_vector_type(4)));
typedef short v4i16_t __attribute__((ext_vector_type(4)));
typedef unsigned u32x4 __attribute__((ext_vector_type(4)));
typedef unsigned u32x2 __attribute__((ext_vector_type(2)));
using pg8::pkbf;

constexpr int DM = 1024, SEQ = 16384, CTXL = 256, MT = SEQ + CTXL, DEPTH = 4, NEXP = 32, DEXP = 512;
constexpr int XG_ROWS = 41472;
constexpr size_t SLOT = (size_t)MT * 64;
constexpr float LOG2E = 1.4426950408889634f, RMS_EPS = 1e-6f;
constexpr int NWAVES = 8, NTHREADS = 512;

constexpr size_t MiB = 1u << 20;
constexpr size_t WS_CTL = 0, CTL_ZERO_BYTES = 1 * MiB;
constexpr size_t WS_MOD = 1 * MiB;
constexpr size_t WS_ROPE = 1 * MiB + 512 * 1024;
constexpr size_t WS_BT_INAB = 2 * MiB, WS_BT_OUTAB = 8 * MiB, WS_BT_INC = 12 * MiB, WS_BT_OUTC = 24 * MiB;
constexpr size_t WS_BT_W13 = 32 * MiB, WS_BT_W2 = 288 * MiB;
constexpr size_t WS_XCUR = 416 * MiB, WS_HB = 481 * MiB, WS_QKV = 514 * MiB, WS_OB = 612 * MiB, WS_O1S = 645 * MiB;
constexpr size_t WS_XG = 710 * MiB, WS_HG = 791 * MiB, WS_YG = 832 * MiB, WS_ROUTE = 913 * MiB, WS_END = 915 * MiB;
constexpr size_t RT_WTR = 1408 * 1024;
constexpr size_t RT_TOKE = 0, RT_TOKP = 256 * 1024, RT_TOKW = 512 * 1024, RT_DROW = 768 * 1024, RT_RW = 1024 * 1024, RT_TILE = 1280 * 1024, RT_NT = 1280 * 1024 + 4096;
static_assert(WS_BT_W13 + (size_t)DEPTH * NEXP * 1024 * 1024 * 2 <= WS_BT_W2 && WS_BT_W2 + (size_t)DEPTH * NEXP * 1024 * 512 * 2 <= WS_XCUR, "ws map");
static_assert(WS_XCUR + (size_t)MT * DM * 4 <= WS_HB && WS_HB + (size_t)MT * DM * 2 <= WS_QKV && WS_QKV + 48 * SLOT * 2 <= WS_OB && WS_OB + (size_t)MT * DM * 2 <= WS_O1S, "ws map");
static_assert(WS_O1S + (size_t)520 * 131072 <= WS_XG && WS_XG + (size_t)XG_ROWS * DM * 2 <= WS_HG && WS_HG + (size_t)XG_ROWS * DEXP * 2 <= WS_YG && WS_YG + (size_t)XG_ROWS * DM * 2 <= WS_ROUTE, "ws map");
constexpr int CW_BAR = 4096, CW_CNT = 150016, CW_DIAG = 32768;

constexpr int LDS_STAGE = 73728, LDS_WSF = 139264, LDS_RW = 0  , LDS_PAR = 148480  , LDSCTL_OFF = 156672, MISC_OFF = LDSCTL_OFF + 320, TAB_OFF = LDSCTL_OFF + 1024, LDS_XCH = LDSCTL_OFF + 3072  , LDS_BYTES = 160768;
static_assert(TAB_OFF + 1024 + 64 <= LDS_BYTES, "LDS map");

constexpr int NPH = 2 + 8 * DEPTH;

#define LDS_WAIT() asm volatile("s_waitcnt lgkmcnt(0)" ::: "memory")
__device__ __forceinline__ float dpp_sum16(float v);
__device__ __forceinline__ float wave_sum(float v) { v = dpp_sum16(v); v += __shfl_xor(v, 16); v += __shfl_xor(v, 32); return v; }
__device__ __forceinline__ float dpp_sum16(float v) {
    v += __builtin_bit_cast(float, __builtin_amdgcn_update_dpp(0, __builtin_bit_cast(int, v), 0xB1, 0xF, 0xF, true));
    v += __builtin_bit_cast(float, __builtin_amdgcn_update_dpp(0, __builtin_bit_cast(int, v), 0x4E, 0xF, 0xF, true));
    v += __builtin_bit_cast(float, __builtin_amdgcn_update_dpp(0, __builtin_bit_cast(int, v), 0x141, 0xF, 0xF, true));
    v += __builtin_bit_cast(float, __builtin_amdgcn_update_dpp(0, __builtin_bit_cast(int, v), 0x140, 0xF, 0xF, true));
    return v;
}
__device__ __forceinline__ float bf2f(unsigned short u) { return __builtin_bit_cast(float, (unsigned)u << 16); }
__device__ __forceinline__ float bflo(unsigned u) { return __builtin_bit_cast(float, u << 16); }
__device__ __forceinline__ float bfhi(unsigned u) { return __builtin_bit_cast(float, u & 0xffff0000u); }

__device__ __forceinline__ void transpose_item(const float* W, int ldw, int srccol0, bf16* WT, int K, int dstrow0, int k0, LAS float* scr, int lane) {
    { f32x4 v[8]; const int rr = lane >> 3, cs = lane & 7;
#pragma unroll
      for (int i = 0; i < 8; ++i) v[i] = *(const GAS f32x4*)(W + (size_t)(k0 + 8 * i + rr) * ldw + srccol0 + 4 * cs);
#pragma unroll
      for (int i = 0; i < 8; ++i) { LAS float* d = scr + (8 * i + rr) * 33 + 4 * cs; d[0] = v[i][0]; d[1] = v[i][1]; d[2] = v[i][2]; d[3] = v[i][3]; } }
    LDS_WAIT(); asm volatile("" ::: "memory");
    const int c = lane & 7;
#pragma unroll
    for (int j = 0; j < 4; ++j) { const int n = (lane >> 3) + 8 * j; const LAS float* s = scr + (8 * c) * 33 + n;
        u32x4 o; o.x = pkbf(s[0 * 33], s[1 * 33]); o.y = pkbf(s[2 * 33], s[3 * 33]); o.z = pkbf(s[4 * 33], s[5 * 33]); o.w = pkbf(s[6 * 33], s[7 * 33]);
        *(GAS u32x4*)(WT + (size_t)(dstrow0 + n) * K + k0 + 8 * c) = o; }
    LDS_WAIT(); asm volatile("" ::: "memory");
}

__device__ __forceinline__ void transpose_item8(const float* W, int ldw, int srccol0, unsigned char* WT, int K, int dstrow0, int k0, LAS float* scr, int lane) {
    { f32x4 v[8]; const int rr = lane >> 3, cs = lane & 7;
#pragma unroll
      for (int i = 0; i < 8; ++i) v[i] = *(const GAS f32x4*)(W + (size_t)(k0 + 8 * i + rr) * ldw + srccol0 + 4 * cs);
#pragma unroll
      for (int i = 0; i < 8; ++i) { LAS float* d = scr + (8 * i + rr) * 33 + 4 * cs; d[0] = v[i][0]; d[1] = v[i][1]; d[2] = v[i][2]; d[3] = v[i][3]; } }
    LDS_WAIT(); asm volatile("" ::: "memory");
    const int c = lane & 7;
#pragma unroll
    for (int j = 0; j < 4; ++j) { const int n = (lane >> 3) + 8 * j; const LAS float* s = scr + (8 * c) * 33 + n;
        u32x2 o; o.x = pg8::pk4_e4m3(s[0 * 33], s[1 * 33], s[2 * 33], s[3 * 33]); o.y = pg8::pk4_e4m3(s[4 * 33], s[5 * 33], s[6 * 33], s[7 * 33]);
        *(GAS u32x2*)(WT + (size_t)(dstrow0 + n) * K + k0 + 8 * c) = o; }
    LDS_WAIT(); asm volatile("" ::: "memory");
}

#ifndef AF_QKNOP
#define AF_QKNOP ""
#endif
#ifndef AF_VF_LATE
#define AF_VF_LATE 1
#endif
#if AF_VF_LATE
#define AF_VF_EARLY() do { } while (0)
#define AF_VF_LATE_() vfa = AF_FRAG(vo_); vfb = AF_FRAG(vo_ + 2048); ATT_SBAR()
#else
#define AF_VF_EARLY() vfa = AF_FRAG(vo_); vfb = AF_FRAG(vo_ + 2048); ATT_SBAR()
#define AF_VF_LATE_() do { } while (0)
#endif
#ifndef AF_QK_SPLIT
#define AF_QK_SPLIT 0
#endif
#if AF_QK_SPLIT
#define AF_PACKQK() AF_CVT(0, P0, 0); AF_CVT(1, P0, 4); AF_CVT(2, P0, 8); AF_CVT(3, P0, 12); ATT_SBAR(); AF_QK(P0, kf0); AF_CVT(4, P1, 0); AF_CVT(5, P1, 4); AF_CVT(6, P1, 8); AF_CVT(7, P1, 12); ATT_SBAR(); AF_QK(P1, kf1);
#else
#define AF_PACKQK() AF_SUMPACK(); ATT_SBAR(); AF_QK(P0, kf0); AF_QK(P1, kf1);
#endif
#ifndef AF_D128_ORDER
#define AF_D128_ORDER 3
#endif
#if AF_D128_ORDER == 1
#define AF_D128_BODY(GL_) AF_PLn(); AF_PRIO_POST(); AF_PVn(0, vfa); vfa = AF_FRAG(vo_ + 4096); ATT_SBAR(); AF_PVn(1, vfb); vfb = AF_FRAG(vo_ + 6144); ATT_SBAR(); AF_EXP(P0, 0, 16); \
            if (GL_) { kf0 = AF_FRAG(kn_); ATT_SBAR(); } AF_PVn(2, vfa); AF_PVn(3, vfb); if (GL_) { kf1 = AF_FRAG(kn_ + 2048); ATT_SBAR(); } AF_EXP(P1, 0, 16);
#elif AF_D128_ORDER == 2
#define AF_D128_BODY(GL_) AF_PLn(); AF_PRIO_POST(); AF_PVn(0, vfa); vfa = AF_FRAG(vo_ + 4096); ATT_SBAR(); AF_EXP(P0, 0, 16); \
            AF_PVn(1, vfb); vfb = AF_FRAG(vo_ + 6144); ATT_SBAR(); if (GL_) { kf0 = AF_FRAG(kn_); ATT_SBAR(); } AF_EXP(P1, 0, 8); \
            AF_PVn(2, vfa); if (GL_) { kf1 = AF_FRAG(kn_ + 2048); ATT_SBAR(); } AF_EXP(P1, 8, 8); \
            AF_PVn(3, vfb);
#elif AF_D128_ORDER == 9
#define AF_D128_BODY(GL_) AF_PLn(); AF_PVn(0, vfa); vfa = AF_FRAG(vo_ + 4096); ATT_SBAR(); AF_PVn(1, vfb); vfb = AF_FRAG(vo_ + 6144); ATT_SBAR(); __builtin_amdgcn_s_setprio(1); AF_EXP(P0, 0, 8); \
            if (GL_) { kf0 = AF_FRAG(kn_); ATT_SBAR(); } AF_PVn(2, vfa); AF_EXP(P0, 8, 8); \
            if (GL_) { kf1 = AF_FRAG(kn_ + 2048); ATT_SBAR(); } AF_PVn(3, vfb); AF_EXP(P1, 0, 16);
#elif AF_D128_ORDER == 6
#define AF_D128_BODY(GL_) AF_PLn(); AF_PRIO_POST(); AF_PVn(0, vfa); vfa = AF_FRAG(vo_ + 4096); ATT_SBAR(); AF_PVn(1, vfb); vfb = AF_FRAG(vo_ + 6144); ATT_SBAR(); AF_EXP(P0, 0, 8); \
            if (GL_) { kf0 = AF_FRAG(kn_); ATT_SBAR(); } AF_PVn(2, vfa); AF_EXP(P0, 8, 8); AF_EXP(P1, 0, 8); \
            if (GL_) { kf1 = AF_FRAG(kn_ + 2048); ATT_SBAR(); } AF_PVn(3, vfb); AF_EXP(P1, 8, 8);
#elif AF_D128_ORDER == 7
#define AF_D128_BODY(GL_) AF_PLn(); AF_PRIO_POST(); AF_PVn(0, vfa); vfa = AF_FRAG(vo_ + 4096); ATT_SBAR(); AF_EXP(P0, 0, 8); \
            AF_PVn(1, vfb); vfb = AF_FRAG(vo_ + 6144); ATT_SBAR(); if (GL_) { kf0 = AF_FRAG(kn_); ATT_SBAR(); } AF_PVn(2, vfa); AF_EXP(P0, 8, 8); \
            if (GL_) { kf1 = AF_FRAG(kn_ + 2048); ATT_SBAR(); } AF_PVn(3, vfb); AF_EXP(P1, 0, 16);
#elif AF_D128_ORDER == 4
#define AF_D128_BODY(GL_) AF_PLn(); AF_PRIO_POST(); AF_PVn(0, vfa); vfa = AF_FRAG(vo_ + 4096); ATT_SBAR(); AF_PVn(1, vfb); vfb = AF_FRAG(vo_ + 6144); ATT_SBAR(); AF_EXP(P0, 0, 8); \
            if (GL_) { kf0 = AF_FRAG(kn_); ATT_SBAR(); } AF_PVn(2, vfa); AF_PVn(3, vfb); AF_EXP(P0, 8, 8); \
            if (GL_) { kf1 = AF_FRAG(kn_ + 2048); ATT_SBAR(); } AF_EXP(P1, 0, 16);
#elif AF_D128_ORDER == 5
#define AF_D128_BODY(GL_) AF_PLn(); AF_PRIO_POST(); AF_PVn(0, vfa); vfa = AF_FRAG(vo_ + 4096); ATT_SBAR(); AF_PVn(1, vfb); vfb = AF_FRAG(vo_ + 6144); ATT_SBAR(); AF_EXP(P0, 0, 16); \
            if (GL_) { kf0 = AF_FRAG(kn_); ATT_SBAR(); } AF_PVn(2, vfa); AF_EXP(P1, 0, 8); \
            if (GL_) { kf1 = AF_FRAG(kn_ + 2048); ATT_SBAR(); } AF_PVn(3, vfb); AF_EXP(P1, 8, 8);
#elif AF_D128_ORDER == 3
#define AF_D128_BODY(GL_) AF_PLn(); AF_PRIO_POST(); AF_PVn(0, vfa); vfa = AF_FRAG(vo_ + 4096); ATT_SBAR(); AF_PVn(1, vfb); vfb = AF_FRAG(vo_ + 6144); ATT_SBAR(); AF_EXP(P0, 0, 8); \
            if (GL_) { kf0 = AF_FRAG(kn_); ATT_SBAR(); } AF_PVn(2, vfa); AF_EXP(P0, 8, 8); \
            if (GL_) { kf1 = AF_FRAG(kn_ + 2048); ATT_SBAR(); } AF_PVn(3, vfb); AF_EXP(P1, 0, 16);
#else
#define AF_D128_BODY(GL_) AF_PLn(); AF_PRIO_POST(); AF_PVn(0, vfa); vfa = AF_FRAG(vo_ + 4096); ATT_SBAR(); AF_EXP(P0, 0, 8); \
            AF_PVn(1, vfb); vfb = AF_FRAG(vo_ + 6144); ATT_SBAR(); AF_EXP(P0, 8, 8); \
            if (GL_) { kf0 = AF_FRAG(kn_); ATT_SBAR(); } \
            AF_PVn(2, vfa); AF_EXP(P1, 0, 8); \
            if (GL_) { kf1 = AF_FRAG(kn_ + 2048); ATT_SBAR(); } \
            AF_PVn(3, vfb); AF_EXP(P1, 8, 8);
#endif
#ifndef AF_D64_SPLIT
#define AF_D64_SPLIT 0
#endif
#if AF_D64_SPLIT == 1
#define AF_D64_BODY(GL_) AF_PLn(); AF_PRIO_POST(); AF_PVn(0, vfa); AF_EXP(P0, 0, 8); AF_PVn(1, vfb); AF_EXP(P0, 8, 8); \
            if (GL_) { kf0 = AF_FRAG(kn_); kf1 = AF_FRAG(kn_ + 2048); ATT_SBAR(); } AF_EXP(P1, 0, 16);
#elif AF_D64_SPLIT == 2
#define AF_D64_BODY(GL_) AF_PLn(); AF_PRIO_POST(); AF_PVn(0, vfa); AF_EXP(P0, 0, 16); \
            if (GL_) { kf0 = AF_FRAG(kn_); kf1 = AF_FRAG(kn_ + 2048); ATT_SBAR(); } AF_EXP(P1, 0, 8); AF_PVn(1, vfb); AF_EXP(P1, 8, 8);
#elif AF_D64_SPLIT == 5
#define AF_D64_BODY(GL_) AF_PLn(); AF_PRIO_POST(); AF_PVn(0, vfa); AF_EXP(P0, 0, 16); AF_PVn(1, vfb); \
            if (GL_) { kf0 = AF_FRAG(kn_); kf1 = AF_FRAG(kn_ + 2048); ATT_SBAR(); } AF_EXP(P1, 0, 16);
#elif AF_D64_SPLIT == 4
#define AF_D64_BODY(GL_) AF_PLn(); AF_PRIO_POST(); AF_PVn(0, vfa); AF_PVn(1, vfb); AF_EXP(P0, 0, 16); \
            if (GL_) { kf0 = AF_FRAG(kn_); kf1 = AF_FRAG(kn_ + 2048); ATT_SBAR(); } AF_EXP(P1, 0, 16);
#elif AF_D64_SPLIT == 3
#define AF_D64_BODY(GL_) AF_PLn(); AF_PRIO_POST(); AF_PVn(0, vfa); AF_EXP(P0, 0, 16); \
            if (GL_) { kf0 = AF_FRAG(kn_); kf1 = AF_FRAG(kn_ + 2048); ATT_SBAR(); } AF_EXP(P1, 0, 16); AF_PVn(1, vfb);
#else
#define AF_D64_BODY(GL_) AF_PLn(); AF_PRIO_POST(); AF_PVn(0, vfa); AF_EXP(P0, 0, 16); \
            if (GL_) { kf0 = AF_FRAG(kn_); kf1 = AF_FRAG(kn_ + 2048); ATT_SBAR(); } AF_PVn(1, vfb); AF_EXP(P1, 0, 16);
#endif
#ifndef AF_PRIO_AFTER_PL
#define AF_PRIO_AFTER_PL 0
#endif
#if AF_PRIO_AFTER_PL
#define AF_PRIO_PRE() do { } while (0)
#define AF_PRIO_POST() __builtin_amdgcn_s_setprio(1)
#elif AF_D128_ORDER == 9
#define AF_PRIO_PRE() do { if constexpr (ND == 2) __builtin_amdgcn_s_setprio(1); } while (0)
#define AF_PRIO_POST() do { } while (0)
#else
#define AF_PRIO_PRE() __builtin_amdgcn_s_setprio(1)
#define AF_PRIO_POST() do { } while (0)
#endif
#ifndef AF_PVNOP
#define AF_PVNOP ""
#define AF_PLNOP "s_nop 0\n\t"
#endif
#ifndef AF_NOPS
#define AF_NOPS "1"
#endif
namespace att {
typedef __attribute__((address_space(3))) const char* lds_cptr;
__device__ __forceinline__ int crow(int r, int hi) { return (r & 3) + 8 * (r >> 2) + 4 * hi; }
__device__ __forceinline__ void glds16(const void* gsrc, unsigned lds_dst) { unsigned keep;
    asm volatile("s_mov_b32 %0, m0\n\ts_mov_b32 m0, %2\n\ts_nop 0\n\tglobal_load_lds_dwordx4 %1, off\n\ts_mov_b32 m0, %0" : "=&s"(keep) : "v"(gsrc), "s"(lds_dst) : "memory"); }
__device__ __forceinline__ void glds16s(unsigned voff, const void* sbase, unsigned lds_dst) {
    asm volatile("s_mov_b32 m0, %2\n\ts_nop 0\n\tglobal_load_lds_dwordx4 %0, %1" :: "v"(voff), "s"(sbase), "s"(lds_dst) : "memory", "m0"); }
__device__ __forceinline__ const void* uniform_ptr(const void* p) { const unsigned long long v = (unsigned long long)p;
    return (const void*)(((unsigned long long)(unsigned)__builtin_amdgcn_readfirstlane((int)(v >> 32)) << 32) | (unsigned)__builtin_amdgcn_readfirstlane((int)(unsigned)v)); }
__device__ __forceinline__ s16x4 vtr(lds_cptr p) { return __builtin_bit_cast(s16x4, __builtin_amdgcn_ds_read_tr16_b64_v4i16((LAS v4i16_t*)p)); }
#if ATT_TIMING
#define ATT_WAITBAR(N) do { unsigned long long ta_, tb_; asm volatile("s_memtime %0\n\ts_waitcnt vmcnt(" #N ") lgkmcnt(0)\n\ts_barrier\n\ts_memtime %1\n\ts_waitcnt lgkmcnt(0)" : "=s"(ta_), "=s"(tb_) :: "memory"); att_twait += tb_ - ta_; } while (0)
#else
#define ATT_WAITBAR(N) asm volatile("s_waitcnt vmcnt(" #N ") lgkmcnt(0)\n\ts_barrier" ::: "memory")
#endif

template <int DV>
__device__ __forceinline__ void attn_pass(f32x16 (&o)[DV / 32], float& lsum, const bf16* Qw, const bf16* Kb, const bf16* Vb, int vpitch,
                                          int t0, int n1, int masked, int qpos, LAS unsigned char* lds, int wid, int lane) {
    constexpr int NV = DV / 64, KSLOT = 8192, VSLOT = DV * 128, LV = 3 * KSLOT;
    unsigned long long att_twait = 0; (void)att_twait;
    const int r32 = lane & 31, hi = lane >> 5, n = n1 + 4;
    const unsigned lds0 = (unsigned)(unsigned long)lds;
    bf16x8 qr[4];
#pragma unroll
    for (int d0 = 0; d0 < 4; ++d0) qr[d0] = *(const bf16x8*)(Qw + (size_t)r32 * 64 + d0 * 16 + hi * 8);
    const bf16* ksrc = Kb + (size_t)lane * 64 + wid * 8;
    const bf16* vsrc[NV];
#pragma unroll
    for (int j = 0; j < NV; ++j) { const int pi = wid + 8 * j, db = pi >> 2, kg = pi & 3; vsrc[j] = Vb + (size_t)(16 * kg + (lane >> 2)) * vpitch + db * 32 + (lane & 3) * 8; }
#define ATT_TILE(i_) ((i_) < n1 ? t0 + (i_) : 256 + (i_) - n1)
#define ATT_DMA(tl_, sl_) do { const int tl__ = (tl_); const int sl__ = (sl_); \
        glds16(ksrc + (size_t)tl__ * 4096, (unsigned)__builtin_amdgcn_readfirstlane(lds0 + sl__ * KSLOT + wid * 1024)); \
        _Pragma("unroll") for (int j_ = 0; j_ < NV; ++j_) glds16(vsrc[j_] + (size_t)tl__ * 64 * vpitch, (unsigned)__builtin_amdgcn_readfirstlane(lds0 + LV + sl__ * VSLOT + (wid + 8 * j_) * 1024)); } while (0)
    ATT_DMA(ATT_TILE(0), 0);
    if (n > 1) ATT_DMA(ATT_TILE(1), 1);
    int sl = 0, sl2 = 2;
    for (int i = 0; i < n; ++i) {
        if (i + 1 < n) { if (NV == 1) ATT_WAITBAR(2); else ATT_WAITBAR(3); } else ATT_WAITBAR(0);
        if (i + 2 < n) ATT_DMA(ATT_TILE(i + 2), sl2);
        const int tl = ATT_TILE(i);
        const lds_cptr kp = (lds_cptr)lds + sl * KSLOT + hi * 1024 + r32 * 16;
        bf16x8 kf[8];
#pragma unroll
        for (int d0 = 0; d0 < 4; ++d0) { kf[2 * d0] = *(const LAS bf16x8*)(kp + d0 * 2048); kf[2 * d0 + 1] = *(const LAS bf16x8*)(kp + d0 * 2048 + 512); }
        f32x16 p0 = {}, p1 = {};
#pragma unroll
        for (int d0 = 0; d0 < 4; ++d0) { p0 = __builtin_amdgcn_mfma_f32_32x32x16_bf16(kf[2 * d0], qr[d0], p0, 0, 0, 0); p1 = __builtin_amdgcn_mfma_f32_32x32x16_bf16(kf[2 * d0 + 1], qr[d0], p1, 0, 0, 0); }
#pragma unroll
        for (int r = 0; r < 16; ++r) { p0[r] = __builtin_amdgcn_exp2f(p0[r]); p1[r] = __builtin_amdgcn_exp2f(p1[r]); }
        if (masked && tl < 256) {
            const int kb = 64 * tl + 4 * hi - (qpos + r32) + 128;
#pragma unroll
            for (int r = 0; r < 16; ++r) { const int kv = kb + (r & 3) + 8 * (r >> 2); if ((unsigned)kv > 256u) p0[r] = 0.f; if ((unsigned)(kv + 32) > 256u) p1[r] = 0.f; }
        }
        float s0 = 0.f, s1 = 0.f;
#pragma unroll
        for (int r = 0; r < 16; ++r) { s0 += p0[r]; s1 += p1[r]; }
        lsum += s0 + s1;
        u32x4 pw[4];
#pragma unroll
        for (int k = 0; k < 2; ++k) {
            pw[k]     = (u32x4){pkbf(p0[8 * k], p0[8 * k + 1]), pkbf(p0[8 * k + 2], p0[8 * k + 3]), pkbf(p0[8 * k + 4], p0[8 * k + 5]), pkbf(p0[8 * k + 6], p0[8 * k + 7])};
            pw[2 + k] = (u32x4){pkbf(p1[8 * k], p1[8 * k + 1]), pkbf(p1[8 * k + 2], p1[8 * k + 3]), pkbf(p1[8 * k + 4], p1[8 * k + 5]), pkbf(p1[8 * k + 6], p1[8 * k + 7])};
        }
        const lds_cptr vp = (lds_cptr)lds + LV + sl * VSLOT + ((lane >> 4) & 1) * 32 + (lane & 3) * 8 + (4 * hi + ((lane & 15) >> 2)) * 64;
#pragma unroll
        for (int d0 = 0; d0 < DV / 32; ++d0) {
#pragma unroll
            for (int ks = 0; ks < 4; ++ks) {
                const s16x4 lo = vtr(vp + d0 * 4096 + ks * 1024), hh = vtr(vp + d0 * 4096 + ks * 1024 + 512);
                const bf16x8 vf = (bf16x8){lo[0], lo[1], lo[2], lo[3], hh[0], hh[1], hh[2], hh[3]};
                o[d0] = __builtin_amdgcn_mfma_f32_32x32x16_bf16(__builtin_bit_cast(bf16x8, pw[ks]), vf, o[d0], 0, 0, 0);
            }
            if (DV > 64) __builtin_amdgcn_sched_barrier(0);
        }
        sl = (sl == 2) ? 0 : sl + 1; sl2 = (sl2 == 2) ? 0 : sl2 + 1;
    }
    asm volatile("s_waitcnt lgkmcnt(0)\n\ts_barrier" ::: "memory");
#undef ATT_TILE
#undef ATT_DMA
}
#define ATT_SBAR() __builtin_amdgcn_sched_barrier(0)
template <int DV>
__device__ __forceinline__ void attn_pipe(f32x16 (&o)[DV / 32], float& l_out, const bf16* Qw, const bf16* Kb, const bf16* Vb, int vpitch,
                                          int t0, int n1, int masked, int qpos, LAS unsigned char* lds, int wid, int lane, unsigned long long* att_tm = nullptr) {
    constexpr int NV = DV / 64, KSLOT = 8192, VSLOT = DV * 128, LV = 3 * KSLOT;
    unsigned long long att_twait = 0; (void)att_twait;
#if ATT_TIMING
    const unsigned long long att_t0 = __builtin_amdgcn_s_memtime();
#endif
    const int r32 = lane & 31, hi = lane >> 5, NT = n1 + 4;
    const unsigned lds0 = (unsigned)(unsigned long)lds;
    const char* Kbu = (const char*)uniform_ptr(Kb); const char* Vbu = (const char*)uniform_ptr(Vb);
    const unsigned koff = (unsigned)((8 * wid + (lane >> 3)) * 128 + (((lane & 7) ^ (((8 * wid + (lane >> 3)) >> 1) & 7)) * 16));
    unsigned voff[NV];
#pragma unroll
    for (int j = 0; j < NV; ++j) { const int pi = wid + 8 * j, db = pi >> 2, kg = pi & 3; voff[j] = (unsigned)((16 * kg + (lane >> 2)) * vpitch + db * 32 + (lane & 3) * 8) * 2u; }
    const unsigned kdst = lds0 + wid * 1024, vdst = lds0 + LV + wid * 1024;
#define AP_TILE(i_) ((i_) < n1 ? t0 + (i_) : 256 + (i_) - n1)
#define AP_DMA_K(t_, sl_) glds16s(koff, Kbu + (size_t)AP_TILE(t_) * 8192, (unsigned)__builtin_amdgcn_readfirstlane(kdst + (sl_) * KSLOT))
#define AP_DMA_V(t_, sl_) do { const char* vb__ = Vbu + (size_t)AP_TILE(t_) * 128 * vpitch; _Pragma("unroll") for (int j_ = 0; j_ < NV; ++j_) glds16s(voff[j_], vb__, (unsigned)__builtin_amdgcn_readfirstlane(vdst + (sl_) * VSLOT + j_ * 8192)); } while (0)
#define AP_WAITBAR_STEADY() do { if (NV == 1) ATT_WAITBAR(2); else ATT_WAITBAR(3); } while (0)
#define AP_WAITBAR_VONLY()  do { if (NV == 1) ATT_WAITBAR(1); else ATT_WAITBAR(2); } while (0)
#define AP_MASK(C0_, C1_, t_) do { if (masked) { const int tl__ = AP_TILE(t_); if (tl__ < 256) { asm volatile("s_nop 15\n\ts_nop 7" : "+v"(C0_), "+v"(C1_)); const int kb__ = 64 * tl__ + 4 * hi - (qpos + r32) + 128; \
        _Pragma("unroll") for (int r = 0; r < 16; ++r) { const int kv = kb__ + (r & 3) + 8 * (r >> 2); if ((unsigned)kv > 256u) C0_[r] = -INFINITY; if ((unsigned)(kv + 32) > 256u) C1_[r] = -INFINITY; } } } } while (0)
    const lds_cptr lds3 = (lds_cptr)lds;
    lds_cptr kpd[4];
#pragma unroll
    for (int d0 = 0; d0 < 4; ++d0) kpd[d0] = lds3 + r32 * 128 + (((2 * d0 + hi) ^ ((r32 >> 1) & 7)) * 16);
    const lds_cptr vp0 = lds3 + LV + ((lane >> 4) & 1) * 32 + (lane & 3) * 8 + (4 * hi + ((lane & 15) >> 2)) * 64;
    AP_DMA_K(0, 0); AP_DMA_V(0, 0); AP_DMA_K(1, 1);
    bf16x8 qr[4];
#pragma unroll
    for (int d0 = 0; d0 < 4; ++d0) qr[d0] = *(const bf16x8*)(Qw + (size_t)r32 * 64 + d0 * 16 + hi * 8);
    AP_DMA_K(2, 2);
    if (NV == 1) ATT_WAITBAR(3); else ATT_WAITBAR(4);
    float l_reg = 0.f;
    unsigned long long ts0_ = 0, ts1_ = 0, att_tA = 0; (void)ts0_; (void)ts1_; (void)att_tA;
    const f32x16 zero16 = {};
    f32x16 pA0, pA1, pB0, pB1;
    bf16x8 kf[8];
    {
#pragma unroll
        for (int d0 = 0; d0 < 4; ++d0) { kf[2 * d0] = *(const LAS bf16x8*)(kpd[d0]); kf[2 * d0 + 1] = *(const LAS bf16x8*)(kpd[d0] + 4096); }
        pA0 = __builtin_amdgcn_mfma_f32_32x32x16_bf16(kf[0], qr[0], zero16, 0, 0, 0); pA1 = __builtin_amdgcn_mfma_f32_32x32x16_bf16(kf[1], qr[0], zero16, 0, 0, 0);
#pragma unroll
        for (int d0 = 1; d0 < 4; ++d0) { pA0 = __builtin_amdgcn_mfma_f32_32x32x16_bf16(kf[2 * d0], qr[d0], pA0, 0, 0, 0); pA1 = __builtin_amdgcn_mfma_f32_32x32x16_bf16(kf[2 * d0 + 1], qr[d0], pA1, 0, 0, 0); }
        AP_MASK(pA0, pA1, 0);
#pragma unroll
        for (int r = 0; r < 16; ++r) { pA0[r] = __builtin_amdgcn_exp2f(pA0[r]); pA1[r] = __builtin_amdgcn_exp2f(pA1[r]); }
    }
    ATT_WAITBAR(0);
    AP_DMA_K(3, 0); AP_DMA_V(1, 1);
    int sl_prev = 0, sl_cur = 1, sl_next = 2;
#define AP_ROT() do { sl_prev = sl_cur; sl_cur = sl_next; sl_next = (sl_next == 2) ? 0 : sl_next + 1; } while (0)
#pragma unroll
    for (int d0 = 0; d0 < 4; ++d0) { kf[2 * d0] = *(const LAS bf16x8*)(kpd[d0] + sl_cur * KSLOT); kf[2 * d0 + 1] = *(const LAS bf16x8*)(kpd[d0] + sl_cur * KSLOT + 4096); }
    AP_WAITBAR_STEADY();
    s16x4 vlo[NV == 1 ? 8 : 4], vhi[NV == 1 ? 8 : 4]; u32x4 pw0, pw1, pw2, pw3;
#define AP_PKW(P, B) pkbf(P[B], P[B + 1])
#define AP_PAF(k) __builtin_bit_cast(bf16x8, pw##k)
#define AP_VFR(i) (bf16x8){vlo[i][0], vlo[i][1], vlo[i][2], vlo[i][3], vhi[i][0], vhi[i][1], vhi[i][2], vhi[i][3]}
#define AP_PIN(x) asm volatile("" : "+v"(x))
#define AP_GAPA(MF, A0, A1, A2, A3, W0, W1, PW) do { MF; sacc += A0; sacc += A1; sacc += A2; sacc += A3; AP_PIN(sacc); W0; W1; AP_PIN(PW); ATT_SBAR(); } while (0)
#define AP_EX(v) __builtin_amdgcn_exp2f(v)
#define AP_GAPB4(MF, X, B) do { MF; X[B] = AP_EX(X[B]); X[B + 1] = AP_EX(X[B + 1]); X[B + 2] = AP_EX(X[B + 2]); X[B + 3] = AP_EX(X[B + 3]); AP_PIN(X); ATT_SBAR(); } while (0)
#define AP_GAPB2(MF, X, B) do { MF; X[B] = AP_EX(X[B]); X[B + 1] = AP_EX(X[B + 1]); AP_PIN(X); ATT_SBAR(); } while (0)
#define AP_VRD(i) do { vlo[i] = vtr(vp_ + (((i) >> 2) * 4096 + ((i) & 3) * 1024)); vhi[i] = vtr(vp_ + (((i) >> 2) * 4096 + ((i) & 3) * 1024 + 512)); } while (0)
#define AP_VRD_A(i) do { if (NV == 1) { AP_VRD(i); ATT_SBAR(); } } while (0)
#define AP_VRD_G(g) do { if (NV == 2 && (g) < 6) { if (((g) & 1) == 0) vlo[(g) >> 1] = vtr(vp_ + ((g) >> 1) * 4096); else vhi[(g) >> 1] = vtr(vp_ + ((g) >> 1) * 4096 + 512); ATT_SBAR(); } } while (0)
#define AP_VRD2(j) do { vlo[(j) & 3] = vtr(vp_ + (((j) & 3) * 4096 + ((j) >> 2) * 1024)); vhi[(j) & 3] = vtr(vp_ + (((j) & 3) * 4096 + ((j) >> 2) * 1024 + 512)); } while (0)
#define AP_KRD(G, j) do { if (G) { kf[2 * (j)] = *(const LAS bf16x8*)(kpd[j] + sl_next * KSLOT); kf[2 * (j) + 1] = *(const LAS bf16x8*)(kpd[j] + sl_next * KSLOT + 4096); ATT_SBAR(); } } while (0)
#if ATT_TIMING >= 3
#define AP_STAMP(v) do { asm volatile("s_memtime %0\n\ts_waitcnt lgkmcnt(0)" : "=s"(v) :: "memory"); ATT_SBAR(); } while (0)
#else
#define AP_STAMP(v) do { } while (0)
#endif
#define AP_MF(D, A, B, C) D = __builtin_amdgcn_mfma_f32_32x32x16_bf16(A, B, C, 0, 0, 0)
#define AP_QK0(D, A, B) asm volatile("v_mfma_f32_32x32x16_bf16 %0, %1, %2, 0" : "=&v"(D) : "v"(A), "v"(B))
#define AP_QK(D, A, B)  asm volatile("v_mfma_f32_32x32x16_bf16 %0, %1, %2, %0" : "+v"(D) : "v"(A), "v"(B))
#define AP_STEP(C0, C1, P0, P1, t, GK, GV, GL) do { ATT_SBAR(); AP_STAMP(ts0_); \
    const lds_cptr vp_ = vp0 + sl_prev * VSLOT; \
    AP_VRD_A(0); AP_VRD_G(0); float sacc = (P0[0] + P0[1]); \
    AP_GAPA(AP_QK0(C0, kf[0], qr[0]), P0[2], P0[3], P0[4], P0[5],     pw0[0] = AP_PKW(P0, 0),  pw0[1] = AP_PKW(P0, 2),  pw0); \
    AP_VRD_A(4); AP_VRD_G(1); AP_GAPA(AP_QK0(C1, kf[1], qr[0]), P0[6], P0[7], P0[8], P0[9],     pw0[2] = AP_PKW(P0, 4),  pw0[3] = AP_PKW(P0, 6),  pw0); \
    AP_VRD_A(1); AP_VRD_G(2); AP_GAPA(AP_QK(C0, kf[2], qr[1]),     P0[10], P0[11], P0[12], P0[13], pw1[0] = AP_PKW(P0, 8),  pw1[1] = AP_PKW(P0, 10), pw1); \
    AP_VRD_A(5); AP_VRD_G(3); AP_GAPA(AP_QK(C1, kf[3], qr[1]),     P0[14], P0[15], P1[0], P1[1],   pw1[2] = AP_PKW(P0, 12), pw1[3] = AP_PKW(P0, 14), pw1); \
    AP_VRD_A(2); AP_VRD_G(4); AP_GAPA(AP_QK(C0, kf[4], qr[2]),     P1[2], P1[3], P1[4], P1[5],     pw2[0] = AP_PKW(P1, 0),  pw2[1] = AP_PKW(P1, 2),  pw2); \
    AP_VRD_A(6); AP_VRD_G(5); AP_GAPA(AP_QK(C1, kf[5], qr[2]),     P1[6], P1[7], P1[8], P1[9],     pw2[2] = AP_PKW(P1, 4),  pw2[3] = AP_PKW(P1, 6),  pw2); \
    AP_VRD_A(3); AP_VRD_G(6); AP_GAPA(AP_QK(C0, kf[6], qr[3]),     P1[10], P1[11], P1[12], P1[13], pw3[0] = AP_PKW(P1, 8),  pw3[1] = AP_PKW(P1, 10), pw3); \
    AP_VRD_A(7); AP_VRD_G(7); AP_GAPA(AP_QK(C1, kf[7], qr[3]),     P1[14], P1[15], 0.f, 0.f,       pw3[2] = AP_PKW(P1, 12), pw3[3] = AP_PKW(P1, 14), pw3); \
    l_reg += sacc; AP_STAMP(ts1_); att_tA += ts1_ - ts0_; \
    if (GK) { AP_DMA_K((t) + 3, sl_cur); } if (GV) { AP_DMA_V((t) + 1, sl_next); } \
    AP_MASK(C0, C1, t); \
    ATT_SBAR(); \
    if constexpr (NV == 1) { \
        AP_GAPB4(AP_MF(o[0], AP_PAF(0), AP_VFR(0), o[0]), C0, 0); \
        AP_GAPB4(AP_MF(o[1], AP_PAF(0), AP_VFR(4), o[1]), C0, 4); \
        AP_KRD(GL, 0); AP_GAPB4(AP_MF(o[0], AP_PAF(1), AP_VFR(1), o[0]), C0, 8); \
        AP_KRD(GL, 1); AP_GAPB4(AP_MF(o[1], AP_PAF(1), AP_VFR(5), o[1]), C0, 12); \
        AP_KRD(GL, 2); AP_GAPB4(AP_MF(o[0], AP_PAF(2), AP_VFR(2), o[0]), C1, 0); \
        AP_KRD(GL, 3); AP_GAPB4(AP_MF(o[1], AP_PAF(2), AP_VFR(6), o[1]), C1, 4); \
        AP_GAPB4(AP_MF(o[0], AP_PAF(3), AP_VFR(3), o[0]), C1, 8); \
        AP_GAPB4(AP_MF(o[1], AP_PAF(3), AP_VFR(7), o[1]), C1, 12); \
    } else { \
        AP_VRD2(3); ATT_SBAR(); AP_GAPB2(AP_MF(o[0], AP_PAF(0), AP_VFR(0), o[0]), C0, 0); \
        AP_VRD2(4); ATT_SBAR(); AP_GAPB2(AP_MF(o[1], AP_PAF(0), AP_VFR(1), o[1]), C0, 2); \
        AP_VRD2(5); ATT_SBAR(); AP_GAPB2(AP_MF(o[2], AP_PAF(0), AP_VFR(2), o[2]), C0, 4); \
        AP_VRD2(6); ATT_SBAR(); AP_GAPB2(AP_MF(o[3], AP_PAF(0), AP_VFR(3), o[3]), C0, 6); \
        AP_VRD2(7); ATT_SBAR(); AP_KRD(GL, 0); AP_GAPB2(AP_MF(o[0], AP_PAF(1), AP_VFR(0), o[0]), C0, 8); \
        AP_VRD2(8); ATT_SBAR(); AP_GAPB2(AP_MF(o[1], AP_PAF(1), AP_VFR(1), o[1]), C0, 10); \
        AP_VRD2(9); ATT_SBAR(); AP_KRD(GL, 1); AP_GAPB2(AP_MF(o[2], AP_PAF(1), AP_VFR(2), o[2]), C0, 12); \
        AP_VRD2(10); ATT_SBAR(); AP_GAPB2(AP_MF(o[3], AP_PAF(1), AP_VFR(3), o[3]), C0, 14); \
        AP_VRD2(11); ATT_SBAR(); AP_KRD(GL, 2); AP_GAPB2(AP_MF(o[0], AP_PAF(2), AP_VFR(0), o[0]), C1, 0); \
        AP_VRD2(12); ATT_SBAR(); AP_GAPB2(AP_MF(o[1], AP_PAF(2), AP_VFR(1), o[1]), C1, 2); \
        AP_VRD2(13); ATT_SBAR(); AP_KRD(GL, 3); AP_GAPB2(AP_MF(o[2], AP_PAF(2), AP_VFR(2), o[2]), C1, 4); \
        AP_VRD2(14); ATT_SBAR(); AP_GAPB2(AP_MF(o[3], AP_PAF(2), AP_VFR(3), o[3]), C1, 6); \
        AP_VRD2(15); ATT_SBAR(); AP_GAPB2(AP_MF(o[0], AP_PAF(3), AP_VFR(0), o[0]), C1, 8); \
        AP_GAPB2(AP_MF(o[1], AP_PAF(3), AP_VFR(1), o[1]), C1, 10); \
        AP_GAPB2(AP_MF(o[2], AP_PAF(3), AP_VFR(2), o[2]), C1, 12); \
        AP_GAPB2(AP_MF(o[3], AP_PAF(3), AP_VFR(3), o[3]), C1, 14); \
    } } while (0)
    int t = 1;
    for (; t + 5 < NT; t += 2) {
        AP_STEP(pB0, pB1, pA0, pA1, t, true, true, true);     AP_WAITBAR_STEADY(); AP_ROT();
        AP_STEP(pA0, pA1, pB0, pB1, t + 1, true, true, true); AP_WAITBAR_STEADY(); AP_ROT();
    }
#define AP_ENDW(tt) do { if ((tt) + 3 < NT) { AP_WAITBAR_STEADY(); } else if ((tt) + 2 < NT) { AP_WAITBAR_VONLY(); } else { ATT_WAITBAR(0); } } while (0)
    for (; t + 1 < NT; t += 2) {
        AP_STEP(pB0, pB1, pA0, pA1, t, (t + 3 < NT), (t + 1 < NT), (t + 1 < NT));         AP_ENDW(t);     AP_ROT();
        AP_STEP(pA0, pA1, pB0, pB1, t + 1, (t + 4 < NT), (t + 2 < NT), (t + 2 < NT));     AP_ENDW(t + 1); AP_ROT();
    }
    AP_STEP(pB0, pB1, pA0, pA1, NT - 1, false, false, false);
    {
        float sacc = 0.f;
#pragma unroll
        for (int r = 0; r < 16; ++r) sacc += pB0[r] + pB1[r];
        l_reg += sacc;
        pw0 = (u32x4){AP_PKW(pB0, 0), AP_PKW(pB0, 2), AP_PKW(pB0, 4), AP_PKW(pB0, 6)}; pw1 = (u32x4){AP_PKW(pB0, 8), AP_PKW(pB0, 10), AP_PKW(pB0, 12), AP_PKW(pB0, 14)};
        pw2 = (u32x4){AP_PKW(pB1, 0), AP_PKW(pB1, 2), AP_PKW(pB1, 4), AP_PKW(pB1, 6)}; pw3 = (u32x4){AP_PKW(pB1, 8), AP_PKW(pB1, 10), AP_PKW(pB1, 12), AP_PKW(pB1, 14)};
        ATT_SBAR();
        const lds_cptr vp = vp0 + sl_cur * VSLOT;
#pragma unroll
        for (int d0 = 0; d0 < DV / 32; ++d0) {
            s16x4 lo[4], hh[4];
#pragma unroll
            for (int ks = 0; ks < 4; ++ks) { lo[ks] = vtr(vp + d0 * 4096 + ks * 1024); hh[ks] = vtr(vp + d0 * 4096 + ks * 1024 + 512); }
#define AP_PK(k) (bf16x8){lo[k][0], lo[k][1], lo[k][2], lo[k][3], hh[k][0], hh[k][1], hh[k][2], hh[k][3]}
            o[d0] = __builtin_amdgcn_mfma_f32_32x32x16_bf16(AP_PAF(0), AP_PK(0), o[d0], 0, 0, 0);
            o[d0] = __builtin_amdgcn_mfma_f32_32x32x16_bf16(AP_PAF(1), AP_PK(1), o[d0], 0, 0, 0);
            o[d0] = __builtin_amdgcn_mfma_f32_32x32x16_bf16(AP_PAF(2), AP_PK(2), o[d0], 0, 0, 0);
            o[d0] = __builtin_amdgcn_mfma_f32_32x32x16_bf16(AP_PAF(3), AP_PK(3), o[d0], 0, 0, 0);
#undef AP_PK
            ATT_SBAR();
        }
    }
    l_out = l_reg;
    asm volatile("s_waitcnt lgkmcnt(0)\n\ts_barrier" ::: "memory");
#if ATT_TIMING
    if (lane == 0 && NT > 100) { const unsigned long long att_t1 = __builtin_amdgcn_s_memtime(); atomicAdd(att_tm + (NV - 1) * 2, (ATT_TIMING >= 3) ? att_tA : att_twait); atomicAdd(att_tm + (NV - 1) * 2 + 1, att_t1 - att_t0); }
#endif
#undef AP_TILE
#undef AP_DMA_K
#undef AP_DMA_V
#undef AP_WAITBAR_STEADY
#undef AP_WAITBAR_VONLY
#undef AP_MASK
#undef AP_ROT
#undef AP_PKW
#undef AP_PAF
#undef AP_VFR
#undef AP_PIN
#undef AP_GAPA
#undef AP_EX
#undef AP_GAPB4
#undef AP_GAPB2
#undef AP_VRD
#undef AP_VRD_A
#undef AP_VRD_G
#undef AP_VRD2
#undef AP_KRD
#undef AP_MF
#undef AP_STAMP
#undef AP_QK0
#undef AP_QK
#undef AP_STEP
#undef AP_ENDW
}
typedef int v8i __attribute__((ext_vector_type(8)));
template <int DV>
__device__ __forceinline__ void attn_f8(f32x16 (&o)[DV / 32], f32x16& ol, const unsigned char* Qw8, const unsigned char* Kb8, const unsigned char* Vt8,
                                        int t0, int n1, int masked, int qpos, LAS unsigned char* lds, int wid, int lane, unsigned long long* att_tm = nullptr) {
    constexpr int NS = 3, NSL = 2 * NS;
    constexpr int KSLOT = 4096, VSLOT = DV * 64, LV = NSL * KSLOT, ND = DV / 32;
    unsigned long long att_twait = 0, att_tA = 0, tsa_ = 0, tsb_ = 0; (void)att_twait; (void)att_tm; (void)att_tA; (void)tsa_; (void)tsb_;
#if ATT_TIMING
    const unsigned long long att_t0 = __builtin_amdgcn_s_memtime();
#endif
#if ATT_TIMING >= 3
#define AF_STAMP(v) do { asm volatile("s_memtime %0\n\ts_waitcnt lgkmcnt(0)" : "=s"(v) :: "memory"); ATT_SBAR(); } while (0)
#else
#define AF_STAMP(v) do { } while (0)
#endif
#ifndef ATT_SEG
#define ATT_SEG 1
#endif
    const int r32 = lane & 31, hi = lane >> 5, NT = n1 + 4;
    const unsigned lds0 = (unsigned)(unsigned long)lds;
    const char* Kbu = (const char*)uniform_ptr(Kb8); const char* Vbu = (const char*)uniform_ptr(Vt8);
    const int kpi = wid & 3, vpi = (DV == 128) ? wid : (wid & 3);
    const bool do_k = wid < 4, do_v = (DV == 128) || wid >= 4;
    const int prow = lane >> 2, ppos = lane & 3;
    const unsigned koff = (unsigned)((16 * kpi + prow) * 64 + ((ppos ^ (((16 * kpi + prow) >> 2) & 3)) * 16));
    const unsigned voff = (unsigned)((16 * vpi + prow) * 64 + ((ppos ^ (((16 * vpi + prow) >> 2) & 3)) * 16));
    const unsigned kdst = lds0 + kpi * 1024, vdst = lds0 + LV + vpi * 1024;
#define AF_TILE(i_) ((i_) < n1 ? t0 + (i_) : 256 + (i_) - n1)
#define AF_DMA_K(t_, sl_) if (do_k) glds16s(koff, Kbu + (size_t)AF_TILE(t_) * 4096, (unsigned)__builtin_amdgcn_readfirstlane(kdst + (sl_) * KSLOT))
#define AF_DMA_V(t_, sl_) if (do_v) glds16s(voff, Vbu + (size_t)AF_TILE(t_) * (DV * 64), (unsigned)__builtin_amdgcn_readfirstlane(vdst + (sl_) * VSLOT))
#define AF_MASK(C0_, C1_, t_) do { if (masked) { const int tl__ = AF_TILE(t_); if (tl__ < 256) { asm volatile("s_nop 15\n\ts_nop 15" : "+v"(C0_), "+v"(C1_)); const int kb__ = 64 * tl__ + 4 * hi - (qpos + r32) + 128; \
        _Pragma("unroll") for (int r = 0; r < 16; ++r) { const int kv = kb__ + (r & 3) + 8 * (r >> 2); if ((unsigned)kv > 256u) C0_[r] = -INFINITY; if ((unsigned)(kv + 32) > 256u) C1_[r] = -INFINITY; } } } } while (0)
    const lds_cptr lds3 = (lds_cptr)lds;
    const lds_cptr fa0 = lds3 + r32 * 64 + (((2 * hi) ^ ((r32 >> 2) & 3)) * 16), fa1 = lds3 + r32 * 64 + (((2 * hi + 1) ^ ((r32 >> 2) & 3)) * 16);
#define AF_FRAG(off_) __builtin_bit_cast(v8i, (u32x4x2){*(const LAS u32x4*)(fa0 + (off_)), *(const LAS u32x4*)(fa1 + (off_))})
    struct u32x4x2 { u32x4 a, b; };
    AF_DMA_K(0, 0); AF_DMA_V(0, 0);
#pragma unroll
    for (int j = 1; j <= NS + 1; ++j) if (j < NT) AF_DMA_K(j, j);
#pragma unroll
    for (int j = 1; j < NS; ++j) AF_DMA_V(j, j);
    const v8i qf = __builtin_bit_cast(v8i, (u32x4x2){*(const u32x4*)(Qw8 + (size_t)r32 * 64 + 32 * hi), *(const u32x4*)(Qw8 + (size_t)r32 * 64 + 32 * hi + 16)});
    ATT_WAITBAR(0);
    ol = f32x16{};
    const v8i ones8 = {0x38383838, 0x38383838, 0x38383838, 0x38383838, 0x38383838, 0x38383838, 0x38383838, 0x38383838};
    const int sc1 = 0x7F7F7F7F, scq = 0x7D7D7D7D;
    const f32x16 zero16 = {};
    f32x16 P0, P1;
    v8i kf0, kf1;
    {
        kf0 = AF_FRAG(0); kf1 = AF_FRAG(2048);
        P0 = __builtin_amdgcn_mfma_scale_f32_32x32x64_f8f6f4(kf0, qf, zero16, 0, 0, 0, sc1, 0, scq);
        P1 = __builtin_amdgcn_mfma_scale_f32_32x32x64_f8f6f4(kf1, qf, zero16, 0, 0, 0, sc1, 0, scq);
        AF_MASK(P0, P1, 0);
#pragma unroll
        for (int r = 0; r < 16; ++r) { P0[r] = __builtin_amdgcn_exp2f(P0[r]); P1[r] = __builtin_amdgcn_exp2f(P1[r]); }
    }
    kf0 = AF_FRAG(1 * KSLOT); kf1 = AF_FRAG(1 * KSLOT + 2048);
    asm volatile("s_waitcnt lgkmcnt(0)\n\ts_barrier" ::: "memory");
    int one4_ = 0x38383838; asm volatile("" : "+s"(one4_));
    v8i ones8r = {one4_, one4_, one4_, one4_, one4_, one4_, one4_, one4_}; asm volatile("" : "+v"(ones8r));
    v8i vfa, vfb, p8 = {};
#define AF_PIN(x) asm volatile("" : "+v"(x))
#define AF_CVT(w_, P, B) do { int w__ = __builtin_amdgcn_cvt_pk_bf8_f32(P[B], P[B + 1], p8[w_], false); w__ = __builtin_amdgcn_cvt_pk_bf8_f32(P[B + 2], P[B + 3], w__, true); p8[w_] = w__; } while (0)
#define AF_QK(D, A) asm volatile(AF_QKNOP "v_mfma_scale_f32_32x32x64_f8f6f4 %0, %1, %2, 0, %3, %4 op_sel_hi:[0,0,0]" : "=&v"(D) : "v"(A), "v"(qf), "v"(sc1), "v"(scq))
#define AF_P8() p8
#define AF_PV(d0_, VF) asm volatile("s_nop 1\n\tv_mfma_scale_f32_32x32x64_f8f6f4 %0, %1, %2, %0, %3, %3 op_sel_hi:[0,0,0] cbsz:1" : "+v"(o[d0_]) : "v"(p8), "v"(VF), "v"(sc1))
#define AF_PL() asm volatile("s_nop 1\n\tv_mfma_scale_f32_32x32x64_f8f6f4 %0, %1, %2, %0, %3, %3 op_sel_hi:[0,0,0] cbsz:1" : "+v"(ol) : "v"(p8), "v"(ones8r), "v"(sc1))
#define AF_PVn(d0_, VF) asm volatile(AF_PVNOP "v_mfma_scale_f32_32x32x64_f8f6f4 %0, %1, %2, %0, %3, %3 op_sel_hi:[0,0,0] cbsz:1" : "+v"(o[d0_]) : "v"(p8), "v"(VF), "v"(sc1))
#define AF_PLn() asm volatile(AF_PLNOP "v_mfma_scale_f32_32x32x64_f8f6f4 %0, %1, %2, %0, %3, %3 op_sel_hi:[0,0,0] cbsz:1" : "+v"(ol) : "v"(p8), "v"(ones8r), "v"(sc1))
#define AF_EXP(X, B, N) do { _Pragma("unroll") for (int e_ = 0; e_ < (N); ++e_) X[(B) + e_] = __builtin_amdgcn_exp2f(X[(B) + e_]); AF_PIN(X); ATT_SBAR(); } while (0)
#define AF_SUMPACK() do { \
        AF_CVT(0, P0, 0); AF_CVT(1, P0, 4); AF_CVT(2, P0, 8); AF_CVT(3, P0, 12); AF_CVT(4, P1, 0); AF_CVT(5, P1, 4); AF_CVT(6, P1, 8); AF_CVT(7, P1, 12); } while (0)
#define AF_SUB(t, GL_) do { \
        ATT_SBAR(); \
        const int vo_ = LV + (((t) - 1) % NSL) * VSLOT, kn_ = (((t) + 1) % NSL) * KSLOT; \
        AF_VF_EARLY(); \
        AF_PACKQK(); AF_VF_LATE_(); \
        AF_MASK(P0, P1, t); \
        ATT_SBAR(); AF_PRIO_PRE(); \
        if constexpr (ND == 2) { \
            AF_D64_BODY(GL_) \
        } else { \
            AF_D128_BODY(GL_) \
        } __builtin_amdgcn_s_setprio(0); } while (0)
    for (int t_ = 1; t_ < NT; t_ += NS) {
        int t = t_; asm volatile("" : "+s"(t));
#pragma unroll
        for (int j = 0; j < NS; ++j) { if (t + NS + 1 + j < NT) AF_DMA_K(t + NS + 1 + j, (t + NS + 1 + j) % NSL); if (t + NS - 1 + j < NT) AF_DMA_V(t + NS - 1 + j, (t + NS - 1 + j) % NSL); }
        AF_SUB(t, (t + 1 < NT));
#pragma unroll
        for (int j = 1; j < NS; ++j) { if (t + j < NT) { AF_SUB(t + j, (t + j + 1 < NT)); } }
        ATT_WAITBAR(0);
    }
    {
        AF_SUMPACK();
        ATT_SBAR();
        AF_PL();
        const int vo_ = LV + ((NT - 1) % NSL) * VSLOT;
#pragma unroll
        for (int d0 = 0; d0 < ND; ++d0) { vfa = AF_FRAG(vo_ + d0 * 2048); AF_PV(d0, vfa); ATT_SBAR(); }
        asm volatile("s_nop 15\n\ts_nop 15" ::: "memory");
    }
    asm volatile("s_waitcnt lgkmcnt(0)\n\ts_barrier" ::: "memory");
#if ATT_TIMING
    if (lane == 0 && NT > 100) { const unsigned long long att_t1 = __builtin_amdgcn_s_memtime(); atomicAdd(att_tm + (ND / 2 - 1 + (ND == 2 ? 0 : 0)) * 2, (ATT_TIMING >= 3) ? att_tA : att_twait); atomicAdd(att_tm + (ND / 2 - 1) * 2 + 1, att_t1 - att_t0); }
#endif
#undef AF_STAMP
#undef AF_TILE
#undef AF_DMA_K
#undef AF_DMA_V
#undef AF_MASK
#undef AF_FRAG
#undef AF_PIN
#undef AF_CVT
#undef AF_QK
#undef AF_P8
#undef AF_PV
#undef AF_PVn
#undef AF_PLn
#undef AF_PL
#undef AF_EXP
#undef AF_SUMPACK
#undef AF_SUB
}
__device__ __forceinline__ void row_inv(float (&rli)[16], float lsum, float extra, LAS float* wsf, int r32, int hi) {
    const float l = pg8::swap_sum32(lsum) + extra;
    LDS_WAIT();
    if (hi == 0) wsf[r32] = l;
    LDS_WAIT(); asm volatile("" ::: "memory");
#pragma unroll
    for (int r = 0; r < 16; ++r) rli[r] = __builtin_amdgcn_rcpf(wsf[crow(r, hi)]);
    LDS_WAIT(); asm volatile("" ::: "memory");
}
}

#ifndef DBG_NO_MOE
#define DBG_NO_MOE 0
#endif
#ifndef DBG_NO_MIX
#define DBG_NO_MIX 0
#endif
#ifndef DBG_AB
#define DBG_AB 0
#endif
#ifndef TPROBE
#define TPROBE -1
#endif
#ifndef REPEAT_MASK
#define E_REP1 1
#define E_REP2 1
#define TPBIN 25
#define E_ABL 0
#define E_GENERIC 0
#define E_MFMA 1
#define REPEAT_MASK 0
#endif
#define REP_BEGIN(c) for (int rep_ = 0; rep_ < (SKIP_ALL ? 0 : (((REPEAT_MASK >> (c)) & 1) ? 2 : 1)); ++rep_) {
#define REP_END }
#ifndef ATT_FN
#define ATT_FN attn_pipe
#endif
#ifndef PH_MASK
#define PH_MASK 0x3ff
#endif
#define PH_ON(i) ((PH_MASK >> (i)) & 1)
#ifndef SPREAD_PH
#define SPREAD_PH -1
#endif
#ifndef SKIP_ALL
#define SKIP_ALL 0
#endif
#ifndef ATT_VARIANT
#define ATT_VARIANT 0
#endif
struct Args { const float* in[28]; float* out; unsigned char* ws; int ph_lo, ph_hi; };
enum { I_X = 0, I_C, I_CTX, I_CCTX, I_WMOD, I_BMOD, I_NMIX, I_NFFN, I_WINAB, I_WOUTAB, I_QNA, I_KNA, I_SINKA, I_QNB, I_KNB, I_WINC, I_WOUTC, I_QNC, I_KNC, I_LAMC, I_SUBLN,
       I_WGRP, I_BGRP, I_WEXP, I_BEXP, I_W1, I_W3, I_W2 };

__global__ void __launch_bounds__(NTHREADS, 2) mega(Args args) {
    extern __shared__ __attribute__((aligned(16))) unsigned char lds_[];
    LAS unsigned char* lds = (LAS unsigned char*)lds_;
    volatile LAS unsigned* MISC = (volatile LAS unsigned*)(lds + MISC_OFF);
    const int tid0 = threadIdx.x;
    const int G = gridDim.x, bx = blockIdx.x;
    const int vcu = (G % 8 == 0) ? (bx % 8) * (G / 8) + bx / 8 : bx;
    const int NGW = G * NWAVES;
#define PHASE_IDS() int tid = tid0; asm volatile("" : "+v"(tid)); const int lane = tid & 63, wave = __builtin_amdgcn_readfirstlane(tid >> 6), gw = vcu * NWAVES + wave; (void)lane; (void)wave; (void)gw
    unsigned char* ws = args.ws;
    unsigned* ctl = (unsigned*)(ws + WS_CTL);
    float* mod = (float*)(ws + WS_MOD); float* modc = mod + DEPTH * 6144;
    float* rope = (float*)(ws + WS_ROPE);
    float* xcur = (float*)(ws + WS_XCUR);
    bf16* HB = (bf16*)(ws + WS_HB); bf16* QKV = (bf16*)(ws + WS_QKV); bf16* OB = (bf16*)(ws + WS_OB); float* O1S = (float*)(ws + WS_O1S);
    bf16* XG = (bf16*)(ws + WS_XG); bf16* HG = (bf16*)(ws + WS_HG); bf16* YG = (bf16*)(ws + WS_YG);
    int* tok_e = (int*)(ws + WS_ROUTE + RT_TOKE); int* tok_p = (int*)(ws + WS_ROUTE + RT_TOKP); float* tok_w = (float*)(ws + WS_ROUTE + RT_TOKW);
    int* drow = (int*)(ws + WS_ROUTE + RT_DROW); float* rw = (float*)(ws + WS_ROUTE + RT_RW); int* tile_e = (int*)(ws + WS_ROUTE + RT_TILE); int* ntl = (int*)(ws + WS_ROUTE + RT_NT);

    for (int u = tid0; u < (LDS_BYTES - LDSCTL_OFF) / 4; u += NTHREADS) ((LAS unsigned*)(lds + LDSCTL_OFF))[u] = 0u;
    __syncthreads();
    const int ph_lo = args.ph_lo, ph_hi = args.ph_hi;
    XcdBarrier bar; bar.bar = ctl + CW_BAR; bar.x = 0; bar.st = nullptr;
    if (ph_hi - ph_lo > 1) bar = xcd_barrier_post(ctl + CW_BAR, MISC + 8);
#if TPROBE >= 0
    unsigned long long* tms = (unsigned long long*)(ws + WS_CTL + 262144);
    if (bx == 0 && tid0 == 0) { const unsigned long long t0_ = __builtin_amdgcn_s_memrealtime(); MISC[16] = (unsigned)t0_; MISC[17] = (unsigned)(t0_ >> 32); }
#define TSTAMP(cls) do { if (bx == 0 && tid0 == 0) { const unsigned long long now_ = __builtin_amdgcn_s_memrealtime(); const unsigned long long prev_ = ((unsigned long long)MISC[17] << 32) | MISC[16]; \
        tms[cls] += now_ - prev_; MISC[16] = (unsigned)now_; MISC[17] = (unsigned)(now_ >> 32); } } while (0)
#else
#define TSTAMP(cls) do { } while (0)
#endif
#define IN(k) (ph_lo <= (k) && (k) < ph_hi)
#define SEAM(k) do { if (IN(k) && IN((k) + 1)) xcd_barrier(bar); } while (0)

    if (IN(0)) { if (!PH_ON(0)) __builtin_trap(); asm volatile("; MARK_PHASE p0" ::: "memory"); PHASE_IDS(); REP_BEGIN(0)
        {
            LAS float* sc = (LAS float*)lds; LAS float* scc = sc + 1024; LAS float* red = scc + 1024;
            for (int k = tid; k < 1024; k += NTHREADS) { const float a = args.in[I_C][k], b = args.in[I_CCTX][k];
                sc[k] = a / (1.f + __expf(-a)); scc[k] = b / (1.f + __expf(-b)); }
            __syncthreads();
            for (int it = bx; it < DEPTH * 96; it += G) {
                const int l = it / 96, col = (it % 96) * 64 + lane;
                const float* w = args.in[I_WMOD] + (size_t)l * 1024 * 6144 + col;
                float a0 = 0.f, a1 = 0.f;
#pragma unroll 32
                for (int kk = 0; kk < 128; ++kk) { const int k = wave * 128 + kk; const float wv = w[(size_t)k * 6144]; a0 += sc[k] * wv; a1 += scc[k] * wv; }
                red[wave * 64 + lane] = a0; red[512 + wave * 64 + lane] = a1;
                __syncthreads();
                if (wave < 2) { float s = 0.f;
#pragma unroll
                    for (int w8 = 0; w8 < 8; ++w8) s += red[wave * 512 + w8 * 64 + lane];
                    s += args.in[I_BMOD][l * 6144 + col];
                    (wave == 0 ? mod : modc)[l * 6144 + col] = s; }
                __syncthreads();
            }
        }
        for (int idx = bx * NTHREADS + tid; idx < 320 * 16; idx += G * NTHREADS) {
            const int t = idx >> 4, j = idx & 15; const float pos = (float)(t < 256 ? t : t - 256);
            const float inv = exp2f(-(float)j * (13.287712379549449f / 16.f));
            const float ang = pos * inv, rev = ang * 0.15915494309189535f, fr = rev - rintf(rev);
            const float cs = __builtin_amdgcn_cosf(fr), sn = __builtin_amdgcn_sinf(fr);
            if (t < 256) { rope[t * 16 + j] = cs; rope[4096 + t * 16 + j] = sn; } else { rope[8192 + (t - 256) * 16 + j] = cs; rope[9216 + (t - 256) * 16 + j] = sn; }
        }
        { float* wtr = (float*)(ws + WS_ROUTE + RT_WTR);
          for (int idx = bx * NTHREADS + tid; idx < DEPTH * 36 * 1024; idx += G * NTHREADS) { const int ll = idx / 36864, o = (idx >> 10) % 36, k = idx & 1023;
              wtr[idx] = (o < 4) ? args.in[I_WGRP][((size_t)ll * 1024 + k) * 4 + o] : args.in[I_WEXP][((size_t)ll * 1024 + k) * 32 + (o - 4)]; } }
        {
            LAS float* scr = (LAS float*)(lds + wave * 16384);
            constexpr int N_INAB = 2 * 16 * 48, N_INC = 2 * 16 * 96, N_OUT = 2 * 16 * 32, N_W13 = DEPTH * NEXP * 16 * 32, N_W2 = DEPTH * NEXP * 8 * 32;
            constexpr int NITEMS = N_INAB + N_INC + 2 * N_OUT + N_W13 + N_W2;
            for (int it = gw; it < NITEMS; it += NGW) {
                int r = it;
                if (r < N_INAB) { const int i = r / (16 * 48), q = r % (16 * 48), kb = q / 48, nb = q % 48, pin = (nb * 32) & 255, pn = (nb * 32) >> 8, bj = pin >> 7, wc = (pin & 127) >> 5;
#if FP8_B
                    transpose_item8(args.in[I_WINAB] + (size_t)i * 1024 * 1536, 1536, (4 * pn + wc) * 64 + bj * 32, (unsigned char*)(ws + WS_BT_INAB) + (size_t)i * 1536 * 1024, 1024, nb * 32, kb * 64, scr, lane); continue; }
#else
                    transpose_item(args.in[I_WINAB] + (size_t)i * 1024 * 1536, 1536, (4 * pn + wc) * 64 + bj * 32, (bf16*)(ws + WS_BT_INAB) + (size_t)i * 1536 * 1024, 1024, nb * 32, kb * 64, scr, lane); continue; }
#endif
                r -= N_INAB;
                if (r < N_INC) { const int i = r / (16 * 96), q = r % (16 * 96), kb = q / 96, nb = q % 96, pin = (nb * 32) & 255, pn = (nb * 32) >> 8, bj = pin >> 7, wc = (pin & 127) >> 5;
#if FP8_B
                    transpose_item8(args.in[I_WINC] + (size_t)i * 1024 * 3072, 3072, (4 * pn + wc) * 64 + bj * 32, (unsigned char*)(ws + WS_BT_INC) + (size_t)i * 3072 * 1024, 1024, nb * 32, kb * 64, scr, lane); continue; }
#else
                    transpose_item(args.in[I_WINC] + (size_t)i * 1024 * 3072, 3072, (4 * pn + wc) * 64 + bj * 32, (bf16*)(ws + WS_BT_INC) + (size_t)i * 3072 * 1024, 1024, nb * 32, kb * 64, scr, lane); continue; }
#endif
                r -= N_INC;
                if (r < N_OUT) { const int i = r / (16 * 32), q = r % (16 * 32), kb = q / 32, nb = q % 32;
                    transpose_item(args.in[I_WOUTAB] + (size_t)i * 1024 * 1024, 1024, nb * 32, (bf16*)(ws + WS_BT_OUTAB) + (size_t)i * 1024 * 1024, 1024, nb * 32, kb * 64, scr, lane); continue; }
                r -= N_OUT;
                if (r < N_OUT) { const int i = r / (16 * 32), q = r % (16 * 32), kb = q / 32, nb = q % 32;
                    transpose_item(args.in[I_WOUTC] + (size_t)i * 1024 * 1024, 1024, nb * 32, (bf16*)(ws + WS_BT_OUTC) + (size_t)i * 1024 * 1024, 1024, nb * 32, kb * 64, scr, lane); continue; }
                r -= N_OUT;
                if (r < N_W13) { const int le = r / (16 * 32), q = r % (16 * 32), kb = q / 32, nb = q % 32, pin = (nb * 32) & 255, pn = (nb * 32) >> 8, bj = pin >> 7, wc = (pin & 127) >> 5;
#if FP8_G
                    transpose_item8(args.in[bj ? I_W3 : I_W1] + (size_t)le * 1024 * 512, 512, pn * 128 + wc * 32, (unsigned char*)(ws + WS_BT_W13) + (size_t)le * 1024 * 1024, 1024, nb * 32, kb * 64, scr, lane); continue; }
#else
                    transpose_item(args.in[bj ? I_W3 : I_W1] + (size_t)le * 1024 * 512, 512, pn * 128 + wc * 32, (bf16*)(ws + WS_BT_W13) + (size_t)le * 1024 * 1024, 1024, nb * 32, kb * 64, scr, lane); continue; }
#endif
                r -= N_W13;
                { const int le = r / (8 * 32), q = r % (8 * 32), kb = q / 32, nb = q % 32;
#if FP8_H
                    transpose_item8(args.in[I_W2] + (size_t)le * 512 * 1024, 1024, nb * 32, (unsigned char*)(ws + WS_BT_W2) + (size_t)le * 1024 * 512, 512, nb * 32, kb * 64, scr, lane); }
#else
                    transpose_item(args.in[I_W2] + (size_t)le * 512 * 1024, 1024, nb * 32, (bf16*)(ws + WS_BT_W2) + (size_t)le * 1024 * 512, 512, nb * 32, kb * 64, scr, lane); }
#endif
            }
        }
        __syncthreads();
    REP_END }
    SEAM(0); TSTAMP(0);

    for (int l = 0; l < DEPTH; ++l) {
        const int pb = 1 + 8 * l, li = l >> 1;
        const bool isC = (l & 1) != 0, last = (l == DEPTH - 1);
        const float* modl = mod + l * 6144; const float* modcl = modc + l * 6144;
        const int mrows = last ? SEQ : MT;

        if (IN(pb + 0)) { if (!PH_ON(1)) __builtin_trap(); asm volatile("; MARK_PHASE pb+0" ::: "memory"); PHASE_IDS(); REP_BEGIN(1)
            const float* gmix = args.in[I_NMIX] + l * 1024;
            int mstart = gw;
            if (NGW == 2048) {
                const bool comb = l > 0 && rep_ == 0 && !((DBG_NO_MOE >> (l > 0 ? l - 1 : 0)) & 1);
                int dj = 0;
                if (comb && lane < 16) dj = drow[2 * (gw + 2048 * (lane >> 1)) + (lane & 1)];
                f32x4 gn[4], sh[4], sc[4], gt[4];
#pragma unroll
                for (int j = 0; j < 4; ++j) { const int c0 = 4 * lane + 256 * j; gn[j] = *(const f32x4*)(gmix + c0); sh[j] = *(const f32x4*)(modl + c0); sc[j] = *(const f32x4*)(modl + 1024 + c0);
                    gt[j] = comb ? *(const f32x4*)(mod + (l - 1) * 6144 + 5 * 1024 + c0) : (f32x4){0.f, 0.f, 0.f, 0.f}; }
                const float* srcb = (l == 0 ? args.in[I_X] : xcur) + (size_t)gw * 1024 + 4 * lane;
                f32x4 xv[2][4]; u32x2 y0[2][4], y1[2][4];
#define A_ISSUE(it, b) { _Pragma("unroll") for (int j = 0; j < 4; ++j) xv[b][j] = *(const f32x4*)(srcb + (size_t)2048 * 1024 * (it) + 256 * j); \
                    if (comb) { const int d0 = __builtin_amdgcn_readlane(dj, 2 * (it)), d1 = __builtin_amdgcn_readlane(dj, 2 * (it) + 1); \
                        _Pragma("unroll") for (int j = 0; j < 4; ++j) { y0[b][j] = *(const u32x2*)(YG + (size_t)d0 * 1024 + 4 * lane + 256 * j); y1[b][j] = *(const u32x2*)(YG + (size_t)d1 * 1024 + 4 * lane + 256 * j); } } \
                    else { _Pragma("unroll") for (int j = 0; j < 4; ++j) { y0[b][j] = (u32x2){0u, 0u}; y1[b][j] = (u32x2){0u, 0u}; } } }
                A_ISSUE(0, 0)
#pragma unroll
                for (int it = 0; it < 8; ++it) { const int b = it & 1; const int m = gw + 2048 * it;
                    if (it + 1 < 8) { if (b) A_ISSUE(it + 1, 0) else A_ISSUE(it + 1, 1) }
                    asm volatile("" ::: "memory");
                    f32x4 v[4]; float ss = 0.f;
#pragma unroll
                    for (int j = 0; j < 4; ++j) { const u32x2 a0 = y0[b][j], a1 = y1[b][j];
                        v[j] = comb ? xv[b][j] + gt[j] * (f32x4){bflo(a0.x) + bflo(a1.x), bfhi(a0.x) + bfhi(a1.x), bflo(a0.y) + bflo(a1.y), bfhi(a0.y) + bfhi(a1.y)} : xv[b][j];
                        *(f32x4*)(xcur + (size_t)m * 1024 + 4 * lane + 256 * j) = v[j];
                        ss += (v[j][0] * v[j][0] + v[j][1] * v[j][1]) + (v[j][2] * v[j][2] + v[j][3] * v[j][3]); }
                    const float rstd = __builtin_amdgcn_rsqf(wave_sum(ss) * (1.f / 1024.f) + RMS_EPS);
#pragma unroll
                    for (int j = 0; j < 4; ++j) { const int c0 = 4 * lane + 256 * j; const f32x4 h = v[j] * rstd * gn[j] * (sc[j] + 1.f) + sh[j];
#if FP8_B
                        *(unsigned*)((unsigned char*)HB + (size_t)m * 1024 + c0) = pg8::pk4_e4m3(h[0], h[1], h[2], h[3]); }
#else
                        *(u32x2*)(HB + (size_t)m * 1024 + c0) = (u32x2){pkbf(h[0], h[1]), pkbf(h[2], h[3])}; }
#endif
                    asm volatile("" ::: "memory");
                }
#undef A_ISSUE
                mstart = gw + 2048 * 8;
            }
            for (int m = mstart; m < MT; m += NGW) {
                const bool isctx = m >= SEQ;
                const float* src = (l == 0) ? (isctx ? args.in[I_CTX] + (size_t)(m - SEQ) * 1024 : args.in[I_X] + (size_t)m * 1024) : xcur + (size_t)m * 1024;
                f32x4 v[4];
#pragma unroll
                for (int j = 0; j < 4; ++j) v[j] = *(const f32x4*)(src + 4 * lane + 256 * j);
                if (l > 0 && rep_ == 0 && !((DBG_NO_MOE >> (l - 1)) & 1)) {
                    const int d0 = drow[2 * m], d1 = drow[2 * m + 1];
                    const float* gate = (isctx ? modc : mod) + (l - 1) * 6144 + 5 * 1024;
#pragma unroll
                    for (int j = 0; j < 4; ++j) { const u32x2 y0 = *(const u32x2*)(YG + (size_t)d0 * 1024 + 4 * lane + 256 * j), y1 = *(const u32x2*)(YG + (size_t)d1 * 1024 + 4 * lane + 256 * j);
                        const f32x4 gt = *(const f32x4*)(gate + 4 * lane + 256 * j);
                        v[j] = v[j] + gt * (f32x4){bflo(y0.x) + bflo(y1.x), bfhi(y0.x) + bfhi(y1.x), bflo(y0.y) + bflo(y1.y), bfhi(y0.y) + bfhi(y1.y)}; }
                }
#pragma unroll
                for (int j = 0; j < 4; ++j) *(f32x4*)(xcur + (size_t)m * 1024 + 4 * lane + 256 * j) = v[j];
                float ss = 0.f;
#pragma unroll
                for (int j = 0; j < 4; ++j) ss += (v[j][0] * v[j][0] + v[j][1] * v[j][1]) + (v[j][2] * v[j][2] + v[j][3] * v[j][3]);
                const float rstd = __builtin_amdgcn_rsqf(wave_sum(ss) * (1.f / 1024.f) + RMS_EPS);
                const float* mm = isctx ? modcl : modl;
#pragma unroll
                for (int j = 0; j < 4; ++j) { const int c0 = 4 * lane + 256 * j; const f32x4 gn = *(const f32x4*)(gmix + c0), sh = *(const f32x4*)(mm + c0), scl = *(const f32x4*)(mm + 1024 + c0);
                    const f32x4 h = v[j] * rstd * gn * (scl + 1.f) + sh;
#if FP8_B
                    *(unsigned*)((unsigned char*)HB + (size_t)m * 1024 + c0) = pg8::pk4_e4m3(h[0], h[1], h[2], h[3]); }
#else
                    *(u32x2*)(HB + (size_t)m * 1024 + c0) = (u32x2){pkbf(h[0], h[1]), pkbf(h[2], h[3])}; }
#endif
            }
        REP_END }
        SEAM(pb + 0); TSTAMP(1);

        if (IN(pb + 1)) { if (!PH_ON(2)) __builtin_trap(); asm volatile("; MARK_PHASE pb+1" ::: "memory"); PHASE_IDS(); REP_BEGIN((isC ? 3 : 2))
            const int N = isC ? 3072 : 1536;
            constexpr size_t ESZ = FP8_B ? 1 : 2;
            pg8::Gemm g{HB, isC ? (const bf16*)(ws + WS_BT_INC + (size_t)li * 3072 * 1024 * ESZ) : (const bf16*)(ws + WS_BT_INAB + (size_t)li * 1536 * 1024 * ESZ), MT, N, 1024};
            pg8::StaticOrder S; S.init(MT, N, G, bx);
#if USE_FP8
            pg8::EpiQKV8 E{(unsigned char*)QKV, isC ? args.in[I_QNC] + li * 64 : args.in[I_QNA] + li * 64, isC ? args.in[I_KNC] + li * 64 : args.in[I_KNA] + li * 64,
                           args.in[I_QNB] + li * 64, args.in[I_KNB] + li * 64, rope, isC ? 1 : 0};
            pg8::gemm_phase<pg8::EpiQKV8, pg8::StaticOrder, true, true, FP8_B != 0>(lds, g, S, E);
#else
            pg8::EpiQKV E{QKV, isC ? args.in[I_QNC] + li * 64 : args.in[I_QNA] + li * 64, isC ? args.in[I_KNC] + li * 64 : args.in[I_KNA] + li * 64,
                          args.in[I_QNB] + li * 64, args.in[I_KNB] + li * 64, rope, isC ? 1 : 0};
            pg8::gemm_phase<pg8::EpiQKV, pg8::StaticOrder, true, true>(lds, g, S, E);
#endif
        REP_END }
        SEAM(pb + 1); TSTAMP(isC ? 3 : 2);

#if SPREAD_PH >= 0
        unsigned long long spr_t0 = __builtin_amdgcn_s_memrealtime();
#endif
        if (IN(pb + 2)) { if (!PH_ON(3)) __builtin_trap(); asm volatile("; MARK_PHASE pb+2" ::: "memory"); PHASE_IDS(); REP_BEGIN((isC ? 5 : 4))
            const int r32 = lane & 31, hi = lane >> 5;
            LAS float* wsf = (LAS float*)(lds + LDS_WSF) + wave * 32;
            if (!isC && ATT_VARIANT != 2) {
                LAS bf16* stg = (LAS bf16*)(lds + LDS_STAGE) + wave * 2048;
                for (int u = vcu; u < 1040; u += G) {
                    int head16, qt, t0, n1, masked, has_sink, kvslot, vslot, qslot;
                    if (u < 512) { const int h = u >> 6; qt = u & 63; head16 = 8 + h; t0 = 0; n1 = 256; masked = 0; has_sink = 0; qslot = 12 + h; kvslot = 20 + (h >> 2); vslot = 22 + (h >> 2); }
                    else if (u < 1024) { const int h = (u - 512) >> 6; qt = u & 63; head16 = h; t0 = (4 * qt - 2 > 0) ? 4 * qt - 2 : 0; const int t1 = (4 * qt + 6 < 256) ? 4 * qt + 6 : 256; n1 = t1 - t0;
                        masked = 1; has_sink = 1; qslot = h; kvslot = 8 + (h >> 2); vslot = 10 + (h >> 2); }
                    else { const int h16 = u - 1024; qt = 64; head16 = h16; t0 = 0; n1 = 0; masked = 0;
                        if (h16 < 8) { has_sink = 1; qslot = h16; kvslot = 8 + (h16 >> 2); vslot = 10 + (h16 >> 2); } else { const int h = h16 - 8; has_sink = 0; qslot = 12 + h; kvslot = 20 + (h >> 2); vslot = 22 + (h >> 2); } }
                    const int row0 = qt * 256 + wave * 32;
                    f32x16 o[2]; o[0] = f32x16{}; o[1] = f32x16{}; float lsum = 0.f; (void)lsum;
#if USE_FP8
                    f32x16 ol;
                    { const unsigned char* q8 = (const unsigned char*)QKV; const int vidx = (vslot < 12) ? vslot - 10 : vslot - 20;
                      att::attn_f8<64>(o, ol, q8 + (size_t)qslot * pg8::E_SL8 + (size_t)row0 * 64, q8 + (size_t)kvslot * pg8::E_SL8, q8 + 24 * pg8::E_SL8 + (size_t)vidx * pg8::E_VT_AB,
                                       t0, n1, masked, row0, lds, wave, lane, (unsigned long long*)(ws + WS_CTL + 300000)); }
#else
                    att::ATT_FN<64>(o, lsum, QKV + (size_t)qslot * SLOT + (size_t)row0 * 64, QKV + (size_t)kvslot * SLOT, QKV + (size_t)vslot * SLOT, 64, t0, n1, masked, row0, lds, wave, lane, (unsigned long long*)(ws + WS_CTL + 300000));
#endif
                    const float extra = has_sink ? __builtin_amdgcn_exp2f(args.in[I_SINKA][li * 8 + (head16 & 7)] * LOG2E) : 0.f;
                    int ln = lane; asm volatile("" : "+v"(ln));
                    const int r32e = ln & 31, hie = ln >> 5;
                    float rli[16];
#if USE_FP8
#pragma unroll
                    for (int r = 0; r < 16; ++r) rli[r] = __builtin_amdgcn_rcpf(ol[r] + extra);
#else
                    att::row_inv(rli, lsum, extra, wsf, r32e, hie);
#endif
#pragma unroll
                    for (int r = 0; r < 16; ++r) { const int orow = att::crow(r, hie);
#pragma unroll
                        for (int d0 = 0; d0 < 2; ++d0) stg[orow * 64 + d0 * 32 + r32e] = ((DBG_AB == 1 && head16 < 8) || (DBG_AB == 2 && head16 >= 8) || (DBG_AB == 3 && u >= 1024)) ? (bf16)0 : (bf16)(pkbf(o[d0][r] * rli[r], 0.f) & 0xffffu); }
                    LDS_WAIT(); asm volatile("" ::: "memory");
                    bf16* Ow = OB + (size_t)row0 * 1024 + head16 * 64;
#pragma unroll
                    for (int i = 0; i < 4; ++i) { const int row = i * 8 + (ln >> 3), ch = ln & 7; const u32x4 vv = *(const LAS u32x4*)(stg + row * 64 + ch * 8); *(u32x4*)(Ow + (size_t)row * 1024 + ch * 8) = vv; }
                    LDS_WAIT(); asm volatile("" ::: "memory");
                }
            } else if (ATT_VARIANT != 1) {
                LAS bf16* stg = (LAS bf16*)(lds + LDS_STAGE) + wave * 4096;
                const float lam_init = 0.8f - 0.6f * __expf(-0.3f * (float)l);
                const float* lp = args.in[I_LAMC] + li * 256;
                const float lam = __expf(wave_sum(lp[lane] * lp[64 + lane])) - __expf(wave_sum(lp[128 + lane] * lp[192 + lane])) + lam_init;
                const float* subln = args.in[I_SUBLN] + li * 128;
                const int nunits = last ? 512 : 520;
                for (int u = vcu; u < nunits; u += G) {
                    int h, qt, n1;
                    if (u < 512) { h = u >> 6; qt = u & 63; n1 = 256; } else { h = u - 512; qt = 64; n1 = 0; }
                    const int row0 = qt * 256 + wave * 32;
                    const __amdgpu_buffer_rsrc_t o1rs = __builtin_amdgcn_make_buffer_rsrc((void*)(O1S + ((size_t)u * 8 + wave) * 4096), 0, 4096 * 4, 0x00020000);
                    f32x16 o[4]; float rli[16];
                    for (int comp = 0; comp < 2; ++comp) {
#pragma unroll
                        for (int d0 = 0; d0 < 4; ++d0) o[d0] = f32x16{};
                        float lsum = 0.f; (void)lsum;
#if USE_FP8
                        f32x16 ol;
                        { const unsigned char* q8 = (const unsigned char*)QKV;
                          att::attn_f8<128>(o, ol, q8 + (size_t)(2 * h + comp) * pg8::E_SL8 + (size_t)row0 * 64, q8 + (size_t)(16 + 2 * h + comp) * pg8::E_SL8, q8 + 32 * pg8::E_SL8 + (size_t)h * pg8::E_VT_C,
                                            0, n1, 0, 0, lds, wave, lane, (unsigned long long*)(ws + WS_CTL + 300000)); }
#else
                        att::ATT_FN<128>(o, lsum, QKV + (size_t)(2 * h + comp) * SLOT + (size_t)row0 * 64, QKV + (size_t)(16 + 2 * h + comp) * SLOT, QKV + (size_t)(32 + 2 * h) * SLOT, 128, 0, n1, 0, 0, lds, wave, lane, (unsigned long long*)(ws + WS_CTL + 300000));
#endif
#if USE_FP8
#pragma unroll
                        for (int r = 0; r < 16; ++r) rli[r] = __builtin_amdgcn_rcpf(ol[r]);
#else
                        { int l1 = lane; asm volatile("" : "+v"(l1)); att::row_inv(rli, lsum, 0.f, wsf, l1 & 31, l1 >> 5); }
#endif
                        if (comp == 0) {
                            int l0 = lane; asm volatile("" : "+v"(l0));
#pragma unroll
                            for (int d0 = 0; d0 < 4; ++d0) {
#pragma unroll
                                for (int r = 0; r < 16; ++r) __builtin_amdgcn_raw_buffer_store_b32(__builtin_bit_cast(unsigned, o[d0][r] * rli[r]), o1rs, l0 * 4, (d0 * 16 + r) * 256, 0);
                                asm volatile("" ::: "memory"); }
                        }
                    }
                    int ln = lane; asm volatile("" : "+v"(ln));
                    const int r32e = ln & 31, hie = ln >> 5;
                    float ssr[16];
#pragma unroll
                    for (int r = 0; r < 16; ++r) ssr[r] = 0.f;
#pragma unroll
                    for (int d0 = 0; d0 < 4; ++d0) {
#pragma unroll
                        for (int r = 0; r < 16; ++r) { const float vv = __builtin_bit_cast(float, __builtin_amdgcn_raw_buffer_load_b32(o1rs, ln * 4, (d0 * 16 + r) * 256, 0)) - lam * (o[d0][r] * rli[r]); o[d0][r] = vv; ssr[r] += vv * vv; }
                        asm volatile("" ::: "memory"); }
#pragma unroll
                    for (int r = 0; r < 16; ++r) { float s = dpp_sum16(ssr[r]); s += __shfl_xor(s, 16);
                        ssr[r] = __builtin_amdgcn_rsqf(s * (1.f / 128.f) + RMS_EPS) * (1.f - lam_init); }
#pragma unroll
                    for (int d0 = 0; d0 < 4; ++d0) { const float sg = subln[d0 * 32 + r32e];
#pragma unroll
                        for (int r = 0; r < 16; ++r) stg[att::crow(r, hie) * 128 + d0 * 32 + r32e] = (bf16)(pkbf(o[d0][r] * ssr[r] * sg, 0.f) & 0xffffu); }
                    LDS_WAIT(); asm volatile("" ::: "memory");
                    bf16* Ow = OB + (size_t)row0 * 1024 + h * 128;
#pragma unroll
                    for (int i = 0; i < 8; ++i) { const int row = i * 4 + (ln >> 4), ch = ln & 15; const u32x4 vv = *(const LAS u32x4*)(stg + row * 128 + ch * 8); *(u32x4*)(Ow + (size_t)row * 1024 + ch * 8) = vv; }
                    LDS_WAIT(); asm volatile("" ::: "memory");
                }
            }
            __syncthreads();
        REP_END }
#if SPREAD_PH >= 0
        if (tid0 == 0 && (isC ? 5 : 4) == SPREAD_PH) { const unsigned long long d_ = __builtin_amdgcn_s_memrealtime() - spr_t0; unsigned long long* sp = (unsigned long long*)(ws + WS_CTL + 400000);
            atomicAdd(sp, d_); atomicMax(sp + 1, d_); atomicAdd(sp + 2, 1ull); }
#endif
        SEAM(pb + 2); TSTAMP(isC ? 5 : 4);

        if (IN(pb + 3) && !((DBG_NO_MIX >> l) & 1)) { if (!PH_ON(4)) __builtin_trap(); asm volatile("; MARK_PHASE pb+3" ::: "memory"); PHASE_IDS(); REP_BEGIN(6)
            const bf16* WoT = isC ? (const bf16*)(ws + WS_BT_OUTC) + (size_t)li * 1024 * 1024 : (const bf16*)(ws + WS_BT_OUTAB) + (size_t)li * 1024 * 1024;
            int mD = mrows;
            if (G == 256 && mrows == MT) {
                const int rg = bx >> 4, cg = bx & 15, cb = wave & 3, kh = wave >> 2, n16 = lane & 15, kq = lane >> 4;
                const bf16* ap = OB + (size_t)(SEQ + 16 * rg + n16) * 1024 + 512 * kh + 8 * kq;
                const bf16* bp = WoT + (size_t)(64 * cg + 16 * cb + n16) * 1024 + 512 * kh + 8 * kq;
                bf16x8 av[16], bv[16];
#pragma unroll
                for (int q = 0; q < 16; ++q) { av[q] = *(const bf16x8*)(ap + 32 * q); bv[q] = *(const bf16x8*)(bp + 32 * q); }
                asm volatile("" ::: "memory");
                f32x4 dacc = {0.f, 0.f, 0.f, 0.f};
#pragma unroll
                for (int q = 0; q < 16; ++q) dacc = __builtin_amdgcn_mfma_f32_16x16x32_bf16(av[q], bv[q], dacc, 0, 0, 0);
                LAS f32x4* red = (LAS f32x4*)lds;
                if (kh) red[cb * 64 + lane] = dacc;
                __syncthreads();
                if (!kh) { dacc += red[cb * 64 + lane];
                    const int c = 64 * cg + 16 * cb + n16; const float gt = rep_ ? 0.f : modcl[2 * 1024 + c];
#pragma unroll
                    for (int i = 0; i < 4; ++i) { float* xp = xcur + (size_t)(SEQ + 16 * rg + 4 * kq + i) * 1024 + c; *xp = *xp + gt * dacc[i]; } }
                __syncthreads();
                mD = SEQ;
            }
            pg8::Gemm g{OB, WoT, mD, 1024, 1024};
            pg8::StaticOrder S; S.init(mD, 1024, G, bx);
            const float* zgate = (const float*)(ws + WS_CTL + 512 * 1024);
            pg8::EpiResid E{xcur, rep_ ? zgate : modl + 2 * 1024, rep_ ? zgate : modcl + 2 * 1024};
            pg8::gemm_phase<pg8::EpiResid, pg8::StaticOrder, true, true>(lds, g, S, E);
        REP_END }
        SEAM(pb + 3); TSTAMP(6);

        if (IN(pb + 4)) { if (!PH_ON(5)) __builtin_trap(); asm volatile("; MARK_PHASE pb+4" ::: "memory"); PHASE_IDS(); REP_BEGIN(7)
            const float* gffn = args.in[I_NFFN] + l * 1024;
            const float* wtr = (const float*)(ws + WS_ROUTE + RT_WTR) + (size_t)l * 36 * 1024;
            const float* bg = args.in[I_BGRP] + l * 4; const float* be = args.in[I_BEXP] + l * 32;
            LAS unsigned* lcnt = (LAS unsigned*)(lds + LDS_XCH + 512);
            if (tid < 32) lcnt[tid] = 0u;
#if E_MFMA
            constexpr int WPITCH = 1028;
            LAS float* wle = (LAS float*)(lds + LDS_RW); LAS float* wlg = wle + 32 * WPITCH;
            { const f32x4* wg4 = (const f32x4*)wtr + tid; f32x4 wv[18];
#pragma unroll
              for (int j = 0; j < 18; ++j) wv[j] = wg4[512 * j];
              asm volatile("" ::: "memory");
              const int c4 = tid & 255;
#pragma unroll
              for (int j = 0; j < 18; ++j) { const int o = (tid >> 8) + 2 * j;
                  if (j < 2) *(LAS f32x4*)(wlg + o * 1024 + 4 * c4) = wv[j];
                  else { const int e = o - 4, rho = 16 * ((e >> 2) & 1) + 4 * (e >> 3) + (e & 3); *(LAS f32x4*)(wle + rho * WPITCH + 4 * c4) = wv[j]; } }
              __syncthreads(); }
            LAS float* lc = (LAS float*)(lds + LDS_PAR); LAS float* lsh = lc + 1024;
            if (tid < 256) { const f32x4 g4 = *(const f32x4*)(gffn + 4 * tid), s4 = *(const f32x4*)(modl + 3 * 1024 + 4 * tid), c4v = *(const f32x4*)(modl + 4 * 1024 + 4 * tid);
                *(LAS f32x4*)(lc + 4 * tid) = g4 * (c4v + 1.f); *(LAS f32x4*)(lsh + 4 * tid) = s4; }
            __syncthreads();
            TSTAMP(11);
            const int n16 = lane & 15, kq = lane >> 4;
            if (G == 256) {
                if (mrows > SEQ && bx < 128) {
                    const int grp2 = lane >> 5, s32 = lane & 31;
                    const int m = SEQ + 2 * bx + grp2;
                    f32x4 t[8], gnv[8], shv[8], scv[8];
                    float ss = 0.f;
#pragma unroll
                    for (int jj = 0; jj < 8; ++jj) { const int c0 = 4 * s32 + 128 * jj; t[jj] = *(const f32x4*)(xcur + (size_t)m * 1024 + c0);
                        gnv[jj] = *(const f32x4*)(gffn + c0); shv[jj] = *(const f32x4*)(modcl + 3 * 1024 + c0); scv[jj] = *(const f32x4*)(modcl + 4 * 1024 + c0); }
                    asm volatile("" ::: "memory");
#pragma unroll
                    for (int jj = 0; jj < 8; ++jj) ss += (t[jj][0] * t[jj][0] + t[jj][1] * t[jj][1]) + (t[jj][2] * t[jj][2] + t[jj][3] * t[jj][3]);
                    ss = dpp_sum16(ss); ss += __shfl_xor(ss, 16);
                    const float rstd = __builtin_amdgcn_rsqf(ss * (1.f / 1024.f) + RMS_EPS);
#pragma unroll
                    for (int jj = 0; jj < 8; ++jj) { const int c0 = 4 * s32 + 128 * jj;
                        t[jj] = t[jj] * rstd * (gnv[jj] * (scv[jj] + 1.f)) + shv[jj];
                        if (wave == 0) {
#if FP8_G
                            *(unsigned*)((unsigned char*)HB + (size_t)m * 1024 + c0) = pg8::pk4_e4m3(t[jj][0], t[jj][1], t[jj][2], t[jj][3]);
#else
                            *(u32x2*)(HB + (size_t)m * 1024 + c0) = (u32x2){pkbf(t[jj][0], t[jj][1]), pkbf(t[jj][2], t[jj][3])};
#endif
                        } }
                    LAS float* accx = (LAS float*)(lds + LDS_XCH + 640);
                    const LAS float* wbase = wle + 4 * s32;
#pragma unroll 1
                    for (int op = wave; op < 18; op += 8) {
                        const int o = 2 * op, ea = o - 4, eb = o - 3;
                        const int ra = o < 4 ? 32 * WPITCH + o * 1024 : (16 * ((ea >> 2) & 1) + 4 * (ea >> 3) + (ea & 3)) * WPITCH;
                        const int rb = o + 1 < 4 ? 32 * WPITCH + (o + 1) * 1024 : (16 * ((eb >> 2) & 1) + 4 * (eb >> 3) + (eb & 3)) * WPITCH;
                        f32x4 wa[8], wb[8];
#pragma unroll
                        for (int jj = 0; jj < 8; ++jj) { wa[jj] = *(const LAS f32x4*)(wbase + ra + 128 * jj); wb[jj] = *(const LAS f32x4*)(wbase + rb + 128 * jj); }
                        asm volatile("" ::: "memory");
                        float a0 = 0.f, a1 = 0.f;
#pragma unroll
                        for (int jj = 0; jj < 8; ++jj) { a0 += (t[jj][0] * wa[jj][0] + t[jj][1] * wa[jj][1]) + (t[jj][2] * wa[jj][2] + t[jj][3] * wa[jj][3]);
                            a1 += (t[jj][0] * wb[jj][0] + t[jj][1] * wb[jj][1]) + (t[jj][2] * wb[jj][2] + t[jj][3] * wb[jj][3]); }
                        a0 = dpp_sum16(a0); a1 = dpp_sum16(a1);
                        a0 += __shfl_xor(a0, 16); a1 += __shfl_xor(a1, 16);
                        if (s32 == 0) { accx[grp2 * 36 + o] = a0; accx[grp2 * 36 + o + 1] = a1; }
                        asm volatile("" ::: "memory"); }
                    __syncthreads();
                    if (wave == 0) {
                        float acc[36];
#pragma unroll
                        for (int o = 0; o < 36; ++o) acc[o] = accx[grp2 * 36 + o];
                        float lg[4]; int gidx = 0; float gmax;
#pragma unroll
                        for (int q = 0; q < 4; ++q) lg[q] = acc[q] + bg[q];
                        gmax = lg[0];
#pragma unroll
                        for (int q = 1; q < 4; ++q) if (lg[q] > gmax) { gmax = lg[q]; gidx = q; }
                        float gden = 0.f;
#pragma unroll
                        for (int q = 0; q < 4; ++q) gden += __expf(lg[q] - gmax);
                        const float gprob = 1.f / gden;
                        float le8[8];
#pragma unroll
                        for (int k = 0; k < 8; ++k) { float sv = acc[4 + k] + be[k];
#pragma unroll
                            for (int q = 1; q < 4; ++q) sv = (gidx == q) ? acc[4 + 8 * q + k] + be[8 * q + k] : sv;
                            le8[k] = sv; }
                        int i1 = 0; float m1 = le8[0];
#pragma unroll
                        for (int k = 1; k < 8; ++k) if (le8[k] > m1) { m1 = le8[k]; i1 = k; }
                        int i2 = -1; float m2 = -3.0e38f;
#pragma unroll
                        for (int k = 0; k < 8; ++k) if (k != i1 && le8[k] > m2) { m2 = le8[k]; i2 = k; }
                        const float e2 = __expf(m2 - m1), inv = 1.f / (1.f + e2);
                        const float w1 = gprob * inv, w2 = gprob * e2 * inv;
                        if (s32 == 0 && rep_ == 0) {
                            const int ea = gidx * 8 + i1, eb = gidx * 8 + i2;
                            const int pa = (int)__hip_atomic_fetch_add(lcnt + ea, 1u, __ATOMIC_RELAXED, __HIP_MEMORY_SCOPE_WORKGROUP) | (bx << 16), pb2 = (int)__hip_atomic_fetch_add(lcnt + eb, 1u, __ATOMIC_RELAXED, __HIP_MEMORY_SCOPE_WORKGROUP) | (bx << 16);
                            tok_e[2 * m] = ea; tok_e[2 * m + 1] = eb; tok_p[2 * m] = pa; tok_p[2 * m + 1] = pb2; tok_w[2 * m] = w1; tok_w[2 * m + 1] = w2;
                        }
                    }
                }
                TSTAMP(12);
                const int p = wave & 3, h = wave >> 2, grp = bx + 256 * p, m = grp * 16 + n16;
#define E_OFF(i) (64 * ((i) >> 2) + 4 * ((i) & 3))
                const float* xr = xcur + (size_t)m * 1024 + 16 * kq + 512 * h;
                LAS float* ssx = (LAS float*)(lds + LDS_XCH);
                float ss = 0.f;
#pragma unroll 1
                for (int i0 = 0; i0 < 32; i0 += 16) { f32x4 v[16];
#pragma unroll
                    for (int j = 0; j < 16; ++j) v[j] = *(const f32x4*)(xr + 16 * i0 + E_OFF(j));
                    asm volatile("" ::: "memory");
#pragma unroll
                    for (int j = 0; j < 16; ++j) ss += (v[j][0] * v[j][0] + v[j][1] * v[j][1]) + (v[j][2] * v[j][2] + v[j][3] * v[j][3]); }
                ss += __shfl_xor(ss, 16); ss += __shfl_xor(ss, 32);
                if (kq == 0) ssx[wave * 16 + n16] = ss;
                __syncthreads();
                TSTAMP(13);
                const float rstd = __builtin_amdgcn_rsqf((ssx[p * 16 + n16] + ssx[(p + 4) * 16 + n16]) * (1.f / 1024.f) + RMS_EPS);
                unsigned char* trow = (unsigned char*)HB + (size_t)m * (FP8_G ? 1024 : 2048) + (FP8_G ? 1 : 2) * (16 * kq + 512 * h);
                const LAS float* a0p = wle + n16 * WPITCH + 16 * kq + 512 * h; const LAS float* a1p = a0p + 16 * WPITCH; const LAS float* wgp = wlg + 16 * kq + 512 * h;
                const LAS float* lcp = lc + 16 * kq + 512 * h;
                f32x4 D0 = {0.f, 0.f, 0.f, 0.f}, D1 = {0.f, 0.f, 0.f, 0.f}; float gl0 = 0.f, gl1 = 0.f, gl2 = 0.f, gl3 = 0.f;
                f32x4 xv[16];
#pragma unroll
                for (int j = 0; j < 16; ++j) xv[j] = *(const f32x4*)(xr + E_OFF(j));
#pragma unroll 1
                for (int ib = 0; ib < 2; ++ib) {
                    const GAS float* xp = (const GAS float*)(xr + 256);
                    GAS unsigned char* tp = (GAS unsigned char*)(trow + (FP8_G ? 256 : 512) * ib);
                    const LAS float* a0b = a0p + 256 * ib; const LAS float* a1b = a1p + 256 * ib; const LAS float* wgb = wgp + 256 * ib; const LAS float* lcb = lcp + 256 * ib;
                    asm volatile("" : "+v"(xp), "+v"(tp), "+v"(a0b), "+v"(a1b), "+v"(wgb), "+v"(lcb));
                    u32x4 tq;
#pragma unroll
                    for (int j = 0; j < 16; ++j) {
                        const f32x4 cv = *(const LAS f32x4*)(lcb + E_OFF(j)), sv = *(const LAS f32x4*)(lcb + 1024 + E_OFF(j));
                        const f32x4 t = xv[j] * rstd * cv + sv;
                        if (!(E_ABL & 8)) xv[j] = *(const GAS f32x4*)(xp + E_OFF(j));
#if FP8_G
                        tq[j & 3] = pg8::pk4_e4m3(t[0], t[1], t[2], t[3]);
                        if ((j & 3) == 3 && !(E_ABL & 4)) *(GAS u32x4*)(tp + 64 * (j >> 2)) = tq;
#else
                        *(GAS u32x2*)(tp + 2 * E_OFF(j)) = (u32x2){pkbf(t[0], t[1]), pkbf(t[2], t[3])};
#endif
                        const f32x4 a0 = *(const LAS f32x4*)(a0b + E_OFF(j)), a1 = *(const LAS f32x4*)(a1b + E_OFF(j));
                        const f32x4 w0 = *(const LAS f32x4*)(wgb + E_OFF(j)), w1 = *(const LAS f32x4*)(wgb + 1024 + E_OFF(j)), w2 = *(const LAS f32x4*)(wgb + 2048 + E_OFF(j)), w3 = *(const LAS f32x4*)(wgb + 3072 + E_OFF(j));
                        if (!(E_ABL & 2)) { gl0 += (t[0] * w0[0] + t[1] * w0[1]) + (t[2] * w0[2] + t[3] * w0[3]); gl1 += (t[0] * w1[0] + t[1] * w1[1]) + (t[2] * w1[2] + t[3] * w1[3]);
                        gl2 += (t[0] * w2[0] + t[1] * w2[1]) + (t[2] * w2[2] + t[3] * w2[3]); gl3 += (t[0] * w3[0] + t[1] * w3[1]) + (t[2] * w3[2] + t[3] * w3[3]); }
#pragma unroll
                        for (int e = 0; e < 4; ++e) if (!(E_ABL & 1)) { D0 = __builtin_amdgcn_mfma_f32_16x16x4f32(a0[e], t[e], D0, 0, 0, 0); D1 = __builtin_amdgcn_mfma_f32_16x16x4f32(a1[e], t[e], D1, 0, 0, 0); }
                        asm volatile("" ::: "memory"); }
                }
#undef E_OFF
                __syncthreads();
                TSTAMP(14);
                LAS float* part = (LAS float*)(lds + LDS_RW) + p * 12 * 64 + lane;
                if (h) {
#pragma unroll
                    for (int k = 0; k < 4; ++k) { part[k * 64] = D0[k]; part[(4 + k) * 64] = D1[k]; }
                    part[8 * 64] = gl0; part[9 * 64] = gl1; part[10 * 64] = gl2; part[11 * 64] = gl3; }
                __syncthreads();
                if (!h) {
#pragma unroll
                    for (int k = 0; k < 4; ++k) { D0[k] += part[k * 64]; D1[k] += part[(4 + k) * 64]; }
                    gl0 += part[8 * 64]; gl1 += part[9 * 64]; gl2 += part[10 * 64]; gl3 += part[11 * 64];
                gl0 += __shfl_xor(gl0, 16); gl1 += __shfl_xor(gl1, 16); gl2 += __shfl_xor(gl2, 16); gl3 += __shfl_xor(gl3, 16);
                gl0 += __shfl_xor(gl0, 32); gl1 += __shfl_xor(gl1, 32); gl2 += __shfl_xor(gl2, 32); gl3 += __shfl_xor(gl3, 32);
                float lg[4] = {gl0 + bg[0], gl1 + bg[1], gl2 + bg[2], gl3 + bg[3]}; int gidx = 0; float gmax = lg[0];
#pragma unroll
                for (int q = 1; q < 4; ++q) if (lg[q] > gmax) { gmax = lg[q]; gidx = q; }
                float gden = 0.f;
#pragma unroll
                for (int q = 0; q < 4; ++q) gden += __expf(lg[q] - gmax);
                const float gprob = 1.f / gden;
                float le8[8];
#pragma unroll
                for (int k = 0; k < 4; ++k) { le8[k] = D0[k] + be[8 * kq + k]; le8[4 + k] = D1[k] + be[8 * kq + 4 + k]; }
                int i1 = 0; float m1 = le8[0];
#pragma unroll
                for (int k = 1; k < 8; ++k) if (le8[k] > m1) { m1 = le8[k]; i1 = k; }
                int i2 = -1; float m2 = -3.0e38f;
#pragma unroll
                for (int k = 0; k < 8; ++k) if (k != i1 && le8[k] > m2) { m2 = le8[k]; i2 = k; }
                const float e2 = __expf(m2 - m1), inv = 1.f / (1.f + e2);
                const float w1r = gprob * inv, w2r = gprob * e2 * inv;
                if (kq == gidx && rep_ == 0) {
                    const int ea = gidx * 8 + i1, eb = gidx * 8 + i2;
                    const int pa = (int)__hip_atomic_fetch_add(lcnt + ea, 1u, __ATOMIC_RELAXED, __HIP_MEMORY_SCOPE_WORKGROUP) | (bx << 16), pb2 = (int)__hip_atomic_fetch_add(lcnt + eb, 1u, __ATOMIC_RELAXED, __HIP_MEMORY_SCOPE_WORKGROUP) | (bx << 16);
                    tok_e[2 * m] = ea; tok_e[2 * m + 1] = eb; tok_p[2 * m] = pa; tok_p[2 * m + 1] = pb2; tok_w[2 * m] = w1r; tok_w[2 * m + 1] = w2r;
                }
                }
                __syncthreads();
                TSTAMP(15);
            } else {
#if E_GENERIC
            if (wave >= 4) {
                const int grp2 = lane >> 5, s32 = lane & 31;
                for (int m0 = SEQ + 2 * (bx + G * (wave - 4)); m0 < mrows; m0 += 2 * G * 4) {
                    const int m = m0 + grp2;
                    f32x4 t[8];
                    float ss = 0.f;
#pragma unroll
                    for (int jj = 0; jj < 8; ++jj) { t[jj] = *(const f32x4*)(xcur + (size_t)m * 1024 + 4 * s32 + 128 * jj); ss += (t[jj][0] * t[jj][0] + t[jj][1] * t[jj][1]) + (t[jj][2] * t[jj][2] + t[jj][3] * t[jj][3]); }
                    ss = dpp_sum16(ss); ss += __shfl_xor(ss, 16);
                    const float rstd = __builtin_amdgcn_rsqf(ss * (1.f / 1024.f) + RMS_EPS);
#pragma unroll
                    for (int jj = 0; jj < 8; ++jj) { const int c0 = 4 * s32 + 128 * jj; const f32x4 gn = *(const f32x4*)(gffn + c0), sh = *(const f32x4*)(modcl + 3 * 1024 + c0), scl = *(const f32x4*)(modcl + 4 * 1024 + c0);
                        t[jj] = t[jj] * rstd * (gn * (scl + 1.f)) + sh;
#if FP8_G
                        *(unsigned*)((unsigned char*)HB + (size_t)m * 1024 + c0) = pg8::pk4_e4m3(t[jj][0], t[jj][1], t[jj][2], t[jj][3]); }
#else
                        *(u32x2*)(HB + (size_t)m * 1024 + c0) = (u32x2){pkbf(t[jj][0], t[jj][1]), pkbf(t[jj][2], t[jj][3])}; }
#endif
                    float acc[36];
                    const LAS float* wbase = wle + 4 * s32; asm volatile("" : "+v"(wbase));
#pragma unroll
                    for (int o = 0; o < 36; o += 2) {
                        const int ea = o - 4, eb = o - 3;
                        const int ra = o < 4 ? 32 * WPITCH + o * 1024 : (16 * ((ea >> 2) & 1) + 4 * (ea >> 3) + (ea & 3)) * WPITCH;
                        const int rb = o + 1 < 4 ? 32 * WPITCH + (o + 1) * 1024 : (16 * ((eb >> 2) & 1) + 4 * (eb >> 3) + (eb & 3)) * WPITCH;
                        f32x4 wa[8], wb[8];
#pragma unroll
                        for (int jj = 0; jj < 8; ++jj) { wa[jj] = *(const LAS f32x4*)(wbase + ra + 128 * jj); wb[jj] = *(const LAS f32x4*)(wbase + rb + 128 * jj); }
                        asm volatile("" ::: "memory");
                        float a0 = 0.f, a1 = 0.f;
#pragma unroll
                        for (int jj = 0; jj < 8; ++jj) { a0 += (t[jj][0] * wa[jj][0] + t[jj][1] * wa[jj][1]) + (t[jj][2] * wa[jj][2] + t[jj][3] * wa[jj][3]);
                            a1 += (t[jj][0] * wb[jj][0] + t[jj][1] * wb[jj][1]) + (t[jj][2] * wb[jj][2] + t[jj][3] * wb[jj][3]); }
                        a0 = dpp_sum16(a0); a1 = dpp_sum16(a1);
                        acc[o] = a0 + __shfl_xor(a0, 16); acc[o + 1] = a1 + __shfl_xor(a1, 16);
                        asm volatile("" ::: "memory"); }
                    float lg[4]; int gidx = 0; float gmax;
#pragma unroll
                    for (int q = 0; q < 4; ++q) lg[q] = acc[q] + bg[q];
                    gmax = lg[0];
#pragma unroll
                    for (int q = 1; q < 4; ++q) if (lg[q] > gmax) { gmax = lg[q]; gidx = q; }
                    float gden = 0.f;
#pragma unroll
                    for (int q = 0; q < 4; ++q) gden += __expf(lg[q] - gmax);
                    const float gprob = 1.f / gden;
                    float le8[8];
#pragma unroll
                    for (int k = 0; k < 8; ++k) { float sv = acc[4 + k] + be[k];
#pragma unroll
                        for (int q = 1; q < 4; ++q) sv = (gidx == q) ? acc[4 + 8 * q + k] + be[8 * q + k] : sv;
                        le8[k] = sv; }
                    int i1 = 0; float m1 = le8[0];
#pragma unroll
                    for (int k = 1; k < 8; ++k) if (le8[k] > m1) { m1 = le8[k]; i1 = k; }
                    int i2 = -1; float m2 = -3.0e38f;
#pragma unroll
                    for (int k = 0; k < 8; ++k) if (k != i1 && le8[k] > m2) { m2 = le8[k]; i2 = k; }
                    const float e2 = __expf(m2 - m1), inv = 1.f / (1.f + e2);
                    const float w1 = gprob * inv, w2 = gprob * e2 * inv;
                    if (s32 == 0 && rep_ == 0) {
                        const int ea = gidx * 8 + i1, eb = gidx * 8 + i2;
                        const int pa = (int)__hip_atomic_fetch_add(lcnt + ea, 1u, __ATOMIC_RELAXED, __HIP_MEMORY_SCOPE_WORKGROUP) | (bx << 16), pb2 = (int)__hip_atomic_fetch_add(lcnt + eb, 1u, __ATOMIC_RELAXED, __HIP_MEMORY_SCOPE_WORKGROUP) | (bx << 16);
                        tok_e[2 * m] = ea; tok_e[2 * m + 1] = eb; tok_p[2 * m] = pa; tok_p[2 * m + 1] = pb2; tok_w[2 * m] = w1; tok_w[2 * m + 1] = w2;
                    }
                }
            } else
            for (int grp = bx + G * wave; grp < (SEQ >> 4); grp += G * 4) {
                const int m = grp * 16 + n16;
                const float* xr = xcur + (size_t)m * 1024 + 4 * kq;
                float ss = 0.f;
#pragma unroll 1
                for (int r1_ = 0; r1_ < E_REP1; ++r1_) { ss = 0.f; asm volatile("" : "+v"(ss));
#pragma unroll 1
                for (int i0 = 0; i0 < 64; i0 += 16) { f32x4 v[16];
#pragma unroll
                    for (int j = 0; j < 16; ++j) v[j] = *(const f32x4*)(xr + 16 * (i0 + j));
                    asm volatile("" ::: "memory");
#pragma unroll
                    for (int j = 0; j < 16; ++j) ss += (v[j][0] * v[j][0] + v[j][1] * v[j][1]) + (v[j][2] * v[j][2] + v[j][3] * v[j][3]); } }
                ss += __shfl_xor(ss, 16); ss += __shfl_xor(ss, 32);
                const float rstd = __builtin_amdgcn_rsqf(ss * (1.f / 1024.f) + RMS_EPS);
                unsigned char* trow = (unsigned char*)HB + (size_t)m * (FP8_G ? 1024 : 2048) + (FP8_G ? 4 : 8) * kq;
                const LAS float* a0p = wle + n16 * WPITCH + 4 * kq; const LAS float* a1p = a0p + 16 * WPITCH; const LAS float* wgp = wlg + 4 * kq;
                const LAS float* lcp = lc + 4 * kq; const LAS float* lshp = lsh + 4 * kq;
                f32x4 D0, D1; float gl0, gl1, gl2, gl3;
#pragma unroll 1
                for (int r2_ = 0; r2_ < E_REP2; ++r2_) {
                D0 = (f32x4){0.f, 0.f, 0.f, 0.f}; D1 = D0; gl0 = 0.f; gl1 = 0.f; gl2 = 0.f; gl3 = 0.f;
                asm volatile("" : "+v"(D0), "+v"(D1), "+v"(gl0), "+v"(gl1), "+v"(gl2), "+v"(gl3));
                f32x4 xv[16];
#pragma unroll
                for (int j = 0; j < 16; ++j) xv[j] = *(const f32x4*)(xr + 16 * j);
#pragma unroll 1
                for (int ib = 0; ib < 4; ++ib) {
                    const GAS float* xp = (const GAS float*)(xr + 256 * (ib < 3 ? ib + 1 : 3));
                    GAS unsigned char* tp = (GAS unsigned char*)(trow + (FP8_G ? 256 : 512) * ib);
                    const LAS float* a0b = a0p + 256 * ib; const LAS float* a1b = a1p + 256 * ib; const LAS float* wgb = wgp + 256 * ib; const LAS float* lcb = lcp + 256 * ib;
                    asm volatile("" : "+v"(xp), "+v"(tp), "+v"(a0b), "+v"(a1b), "+v"(wgb), "+v"(lcb));
#pragma unroll
                    for (int j = 0; j < 16; ++j) {
                        const f32x4 cv = *(const LAS f32x4*)(lcb + 16 * j), sv = *(const LAS f32x4*)(lcb + 1024 + 16 * j);
                        const f32x4 t = xv[j] * rstd * cv + sv;
                        xv[j] = *(const GAS f32x4*)(xp + 16 * j);
#if FP8_G
                        *(GAS unsigned*)(tp + 16 * j) = pg8::pk4_e4m3(t[0], t[1], t[2], t[3]);
#else
                        *(GAS u32x2*)(tp + 32 * j) = (u32x2){pkbf(t[0], t[1]), pkbf(t[2], t[3])};
#endif
                        const f32x4 a0 = *(const LAS f32x4*)(a0b + 16 * j), a1 = *(const LAS f32x4*)(a1b + 16 * j);
                        const f32x4 w0 = *(const LAS f32x4*)(wgb + 16 * j), w1 = *(const LAS f32x4*)(wgb + 1024 + 16 * j), w2 = *(const LAS f32x4*)(wgb + 2048 + 16 * j), w3 = *(const LAS f32x4*)(wgb + 3072 + 16 * j);
                        gl0 += (t[0] * w0[0] + t[1] * w0[1]) + (t[2] * w0[2] + t[3] * w0[3]); gl1 += (t[0] * w1[0] + t[1] * w1[1]) + (t[2] * w1[2] + t[3] * w1[3]);
                        gl2 += (t[0] * w2[0] + t[1] * w2[1]) + (t[2] * w2[2] + t[3] * w2[3]); gl3 += (t[0] * w3[0] + t[1] * w3[1]) + (t[2] * w3[2] + t[3] * w3[3]);
#pragma unroll
                        for (int e = 0; e < 4; ++e) { D0 = __builtin_amdgcn_mfma_f32_16x16x4f32(a0[e], t[e], D0, 0, 0, 0); D1 = __builtin_amdgcn_mfma_f32_16x16x4f32(a1[e], t[e], D1, 0, 0, 0); }
                        asm volatile("" ::: "memory"); }
                }
                }
                gl0 += __shfl_xor(gl0, 16); gl1 += __shfl_xor(gl1, 16); gl2 += __shfl_xor(gl2, 16); gl3 += __shfl_xor(gl3, 16);
                gl0 += __shfl_xor(gl0, 32); gl1 += __shfl_xor(gl1, 32); gl2 += __shfl_xor(gl2, 32); gl3 += __shfl_xor(gl3, 32);
                float lg[4] = {gl0 + bg[0], gl1 + bg[1], gl2 + bg[2], gl3 + bg[3]}; int gidx = 0; float gmax = lg[0];
#pragma unroll
                for (int q = 1; q < 4; ++q) if (lg[q] > gmax) { gmax = lg[q]; gidx = q; }
                float gden = 0.f;
#pragma unroll
                for (int q = 0; q < 4; ++q) gden += __expf(lg[q] - gmax);
                const float gprob = 1.f / gden;
                float le8[8];
#pragma unroll
                for (int k = 0; k < 4; ++k) { le8[k] = D0[k] + be[8 * kq + k]; le8[4 + k] = D1[k] + be[8 * kq + 4 + k]; }
                int i1 = 0; float m1 = le8[0];
#pragma unroll
                for (int k = 1; k < 8; ++k) if (le8[k] > m1) { m1 = le8[k]; i1 = k; }
                int i2 = -1; float m2 = -3.0e38f;
#pragma unroll
                for (int k = 0; k < 8; ++k) if (k != i1 && le8[k] > m2) { m2 = le8[k]; i2 = k; }
                const float e2 = __expf(m2 - m1), inv = 1.f / (1.f + e2);
                const float w1r = gprob * inv, w2r = gprob * e2 * inv;
                if (kq == gidx && rep_ == 0) {
                    const int ea = gidx * 8 + i1, eb = gidx * 8 + i2;
                    const int pa = (int)__hip_atomic_fetch_add(lcnt + ea, 1u, __ATOMIC_RELAXED, __HIP_MEMORY_SCOPE_WORKGROUP) | (bx << 16), pb2 = (int)__hip_atomic_fetch_add(lcnt + eb, 1u, __ATOMIC_RELAXED, __HIP_MEMORY_SCOPE_WORKGROUP) | (bx << 16);
                    tok_e[2 * m] = ea; tok_e[2 * m + 1] = eb; tok_p[2 * m] = pa; tok_p[2 * m + 1] = pb2; tok_w[2 * m] = w1r; tok_w[2 * m + 1] = w2r;
                }
            }
#else
                __builtin_trap();
#endif
            }
#else
            const int grp = lane >> 5, s32 = lane & 31;
            { LAS f32x4* wl = (LAS f32x4*)(lds + LDS_RW); const f32x4* wg4 = (const f32x4*)wtr;
              for (int i = tid; i < 36 * 256; i += NTHREADS) wl[i] = wg4[i];
              __syncthreads(); }
            const LAS f32x4* wl4 = (const LAS f32x4*)(lds + LDS_RW) + s32;
            for (int m0 = gw * 2; m0 < mrows; m0 += NGW * 2) {
                const int m = m0 + grp;
                const bool isctx = m0 >= SEQ; const float* mm = isctx ? modcl : modl;
                f32x4 t[8];
                float ss = 0.f;
#pragma unroll
                for (int jj = 0; jj < 8; ++jj) { t[jj] = *(const f32x4*)(xcur + (size_t)m * 1024 + 4 * s32 + 128 * jj); ss += (t[jj][0] * t[jj][0] + t[jj][1] * t[jj][1]) + (t[jj][2] * t[jj][2] + t[jj][3] * t[jj][3]); }
                ss = dpp_sum16(ss); ss += __shfl_xor(ss, 16);
                const float rstd = __builtin_amdgcn_rsqf(ss * (1.f / 1024.f) + RMS_EPS);
                int s32o = s32; asm volatile("" : "+v"(s32o));
#pragma unroll
                for (int jj = 0; jj < 8; ++jj) { const int c0 = 4 * s32o + 128 * jj; const f32x4 gn = *(const f32x4*)(gffn + c0), sh = *(const f32x4*)(mm + 3 * 1024 + c0), scl = *(const f32x4*)(mm + 4 * 1024 + c0);
                    t[jj] = t[jj] * rstd * gn * (scl + 1.f) + sh;
#if FP8_G
                    *(unsigned*)((unsigned char*)HB + (size_t)m * 1024 + c0) = pg8::pk4_e4m3(t[jj][0], t[jj][1], t[jj][2], t[jj][3]); }
#else
                    *(u32x2*)(HB + (size_t)m * 1024 + c0) = (u32x2){pkbf(t[jj][0], t[jj][1]), pkbf(t[jj][2], t[jj][3])}; }
#endif
                float acc[36];
                const LAS f32x4* wlo = wl4; asm volatile("" : "+v"(wlo));
#pragma unroll
                for (int o = 0; o < 36; o += 2) {
                    f32x4 wa[8], wb[8];
#pragma unroll
                    for (int jj = 0; jj < 8; ++jj) { wa[jj] = wlo[o * 256 + jj * 32]; wb[jj] = wlo[(o + 1) * 256 + jj * 32]; }
                    asm volatile("" ::: "memory");
                    float a0 = 0.f, a1 = 0.f;
#pragma unroll
                    for (int jj = 0; jj < 8; ++jj) { a0 += (t[jj][0] * wa[jj][0] + t[jj][1] * wa[jj][1]) + (t[jj][2] * wa[jj][2] + t[jj][3] * wa[jj][3]);
                        a1 += (t[jj][0] * wb[jj][0] + t[jj][1] * wb[jj][1]) + (t[jj][2] * wb[jj][2] + t[jj][3] * wb[jj][3]); }
                    a0 = dpp_sum16(a0); a1 = dpp_sum16(a1);
                    acc[o] = a0 + __shfl_xor(a0, 16); acc[o + 1] = a1 + __shfl_xor(a1, 16);
                    asm volatile("" ::: "memory"); }
                float lg[4]; int gidx = 0; float gmax;
#pragma unroll
                for (int q = 0; q < 4; ++q) lg[q] = acc[q] + bg[q];
                gmax = lg[0];
#pragma unroll
                for (int q = 1; q < 4; ++q) if (lg[q] > gmax) { gmax = lg[q]; gidx = q; }
                float gden = 0.f;
#pragma unroll
                for (int q = 0; q < 4; ++q) gden += __expf(lg[q] - gmax);
                const float gprob = 1.f / gden;
                float le8[8];
#pragma unroll
                for (int k = 0; k < 8; ++k) { float s = acc[4 + k] + be[k];
#pragma unroll
                    for (int q = 1; q < 4; ++q) s = (gidx == q) ? acc[4 + 8 * q + k] + be[8 * q + k] : s;
                    le8[k] = s; }
                int i1 = 0; float m1 = le8[0];
#pragma unroll
                for (int k = 1; k < 8; ++k) if (le8[k] > m1) { m1 = le8[k]; i1 = k; }
                int i2 = -1; float m2 = -3.0e38f;
#pragma unroll
                for (int k = 0; k < 8; ++k) if (k != i1 && le8[k] > m2) { m2 = le8[k]; i2 = k; }
                const float e2 = __expf(m2 - m1), inv = 1.f / (1.f + e2);
                const float w1 = gprob * inv, w2 = gprob * e2 * inv;
                if (s32 == 0 && rep_ == 0) {
                    const int ea = gidx * 8 + i1, eb = gidx * 8 + i2;
                    const int pa = (int)__hip_atomic_fetch_add(lcnt + ea, 1u, __ATOMIC_RELAXED, __HIP_MEMORY_SCOPE_WORKGROUP) | (bx << 16), pb2 = (int)__hip_atomic_fetch_add(lcnt + eb, 1u, __ATOMIC_RELAXED, __HIP_MEMORY_SCOPE_WORKGROUP) | (bx << 16);
                    tok_e[2 * m] = ea; tok_e[2 * m + 1] = eb; tok_p[2 * m] = pa; tok_p[2 * m + 1] = pb2; tok_w[2 * m] = w1; tok_w[2 * m + 1] = w2;
                }
            }
#endif
            __syncthreads();
            if (tid < 32 && rep_ == 0) ctl[CW_CNT + l * 16384 + bx * 32 + tid] = lcnt[tid];
        REP_END }
        SEAM(pb + 4); TSTAMP(7);

        if (IN(pb + 5)) { if (!PH_ON(6)) __builtin_trap(); asm volatile("; MARK_PHASE pb+5" ::: "memory"); PHASE_IDS(); REP_BEGIN(8)
            LAS int* sbt = (LAS int*)lds;
            LAS int* seg = sbt + 8192; LAS int* ebase = seg + 512;
            { const unsigned* cg = ctl + CW_CNT + l * 16384 + tid; int cv[16];
#pragma unroll
              for (int j = 0; j < 16; ++j) cv[j] = (int)__hip_atomic_load(cg + 512 * j, __ATOMIC_RELAXED, __HIP_MEMORY_SCOPE_AGENT);
#pragma unroll
              for (int j = 0; j < 16; ++j) sbt[tid + 512 * j] = cv[j]; }
            __syncthreads();
            const int fe = tid & 31, fsg = tid >> 5;
            { int ssum = 0;
#pragma unroll
              for (int c = 0; c < 16; ++c) ssum += sbt[(16 * fsg + c) * 32 + fe];
              seg[fsg * 32 + fe] = ssum; }
            __syncthreads();
            int pad = 0, tot = 0;
            if (lane < 32) {
#pragma unroll
                for (int q = 0; q < 16; ++q) tot += seg[q * 32 + lane];
                pad = (tot + 255) & ~255; }
            int incl = pad;
#pragma unroll
            for (int o = 1; o < 32; o <<= 1) { const int t = __shfl_up(incl, o); if (lane >= o) incl += t; }
            const int base = incl - pad;
            if (wave == 0 && lane < 32) { ebase[lane] = base; ebase[32 + lane] = pad; }
            __syncthreads();
            { int run = ebase[fe];
              for (int q = 0; q < fsg; ++q) run += seg[q * 32 + fe];
#pragma unroll
              for (int c = 0; c < 16; ++c) { const int idx = (16 * fsg + c) * 32 + fe; const int cnt = sbt[idx]; sbt[idx] = run; run += cnt; } }
            __syncthreads();
#if FP8_G
            if (NGW == 2048) {
                static_assert(MT <= 9 * 256 * 8 && SEQ >= 8 * 256 * 8, "dispatch batch");
                constexpr int NGWC = 2048;
                const int mj = gw + NGWC * (lane >> 1);
                int rowj = 0;
                if (lane < 18 && mj < mrows) { const int e = tok_e[2 * mj + (lane & 1)], pp = tok_p[2 * mj + (lane & 1)]; const float w = tok_w[2 * mj + (lane & 1)];
                    rowj = sbt[(pp >> 16) * 32 + e] + (pp & 0xffff); drow[2 * mj + (lane & 1)] = rowj; rw[rowj] = w; }
                const unsigned char* src = (const unsigned char*)HB + (size_t)gw * 1024 + 16 * lane;
                const bool last = gw + NGWC * 8 < mrows;
                u32x4 rv[9];
#pragma unroll
                for (int it = 0; it < 8; ++it) rv[it] = *(const u32x4*)(src + (size_t)NGWC * 1024 * it);
                rv[8] = (u32x4){0u, 0u, 0u, 0u}; if (last) rv[8] = *(const u32x4*)(src + (size_t)NGWC * 1024 * 8);
#pragma unroll
                for (int it = 0; it < 9; ++it) if (it < 8 || last) {
                    const int r0 = __builtin_amdgcn_readlane(rowj, 2 * it), r1 = __builtin_amdgcn_readlane(rowj, 2 * it + 1);
                    *(u32x4*)((unsigned char*)XG + (size_t)r0 * 1024 + 16 * lane) = rv[it]; *(u32x4*)((unsigned char*)XG + (size_t)r1 * 1024 + 16 * lane) = rv[it]; }
            } else
#endif
            for (int m = gw; m < mrows; m += NGW) {
#pragma unroll
                for (int k = 0; k < 2; ++k) {
                    const int e = tok_e[2 * m + k], pp = tok_p[2 * m + k];
                    const int row = sbt[(pp >> 16) * 32 + e] + (pp & 0xffff);
#if FP8_G
                    *(u32x4*)((unsigned char*)XG + (size_t)row * 1024 + 16 * lane) = *(const u32x4*)((const unsigned char*)HB + (size_t)m * 1024 + 16 * lane);
#else
                    const bf16* src = HB + (size_t)m * 1024; bf16* dst = XG + (size_t)row * 1024;
#pragma unroll
                    for (int j = 0; j < 2; ++j) *(u32x4*)(dst + 8 * lane + 512 * j) = *(const u32x4*)(src + 8 * lane + 512 * j);
#endif
                    if (lane == 0) { drow[2 * m + k] = row; rw[row] = tok_w[2 * m + k]; }
                }
            }
            if (bx == 0 && wave == 0) {
                if (lane < 32) for (int t = base >> 8; t < (base + pad) >> 8; ++t) tile_e[t] = lane;
                if (lane == 31) ntl[0] = (base + pad) >> 8;
            }
        REP_END }
        SEAM(pb + 5); TSTAMP(8);

        if (IN(pb + 6)) { if (!PH_ON(7)) __builtin_trap(); asm volatile("; MARK_PHASE pb+6" ::: "memory"); PHASE_IDS(); REP_BEGIN(9)
            LAS int* tab = (LAS int*)(lds + TAB_OFF);
            if (tid < 256) tab[tid] = tile_e[tid];
            if (tid == 0) tab[256] = ntl[0];
            __syncthreads();
            const int nt = tab[256];
            constexpr size_t ESZ = FP8_G ? 1 : 2;
            pg8::Gemm g{XG, (const bf16*)(ws + WS_BT_W13 + (size_t)l * NEXP * 1024 * 1024 * ESZ), XG_ROWS, 1024, 1024};
            pg8::MoeOrder S{tab, nt * 4, G, bx};
            pg8::EpiSwiGLU E{HG, FP8_H};
            pg8::gemm_phase<pg8::EpiSwiGLU, pg8::MoeOrder, true, true, FP8_G != 0>(lds, g, S, E);
        REP_END }
        SEAM(pb + 6); TSTAMP(9);

        if (IN(pb + 7)) { if (!PH_ON(8)) __builtin_trap(); asm volatile("; MARK_PHASE pb+7" ::: "memory"); PHASE_IDS(); REP_BEGIN(10)
            LAS int* tab = (LAS int*)(lds + TAB_OFF);
            if (tid < 256) tab[tid] = tile_e[tid];
            if (tid == 0) tab[256] = ntl[0];
            __syncthreads();
            const int nt = tab[256];
            constexpr size_t ESZ = FP8_H ? 1 : 2;
            pg8::Gemm g{HG, (const bf16*)(ws + WS_BT_W2 + (size_t)l * NEXP * 1024 * 512 * ESZ), XG_ROWS, 1024, 512};
            pg8::MoeOrder S{tab, nt * 4, G, bx};
            pg8::EpiY E{YG, rw};
            pg8::gemm_phase<pg8::EpiY, pg8::MoeOrder, true, true, FP8_H != 0>(lds, g, S, E);
        REP_END }
        SEAM(pb + 7); TSTAMP(10);
    }

    if (IN(NPH - 1)) { if (!PH_ON(9)) __builtin_trap(); asm volatile("; MARK_PHASE final" ::: "memory"); PHASE_IDS();
        const float* gate = mod + (DEPTH - 1) * 6144 + 5 * 1024;
#if ATT_TIMING
        float tscale; { const unsigned long long* tm = (const unsigned long long*)(ws + WS_CTL + 300000); const int ti_ = ((ATT_TIMING - 1) & 1) * 2; const double fr = (double)tm[ti_] / (double)tm[ti_ + 1];
            tscale = 1.05f + 0.05f * (float)(int)(fr * 16.0 + 0.5); }
#endif
#if TPROBE >= 0
#if TPROBE == 98
        float tscale; { const unsigned long long* sp = (const unsigned long long*)(ws + WS_CTL + 400000); const double mean = (double)sp[0] / (double)sp[2], mx = (double)sp[1];
            tscale = 1.05f + 0.05f * (float)(int)((mx / mean - 1.0) * 100.0 + 0.5); }
#elif TPROBE == 97
        float tscale; { unsigned long long tot = tms[7]; for (int q = 11; q < 16; ++q) tot += tms[q]; tscale = 1.0f + 0.1f * (float)(int)((double)tot / 100.0 / (double)TPBIN + 0.5); }
#elif TPROBE == 99
        float tscale; { unsigned long long tot = 0; for (int q = 0; q < 11; ++q) tot += tms[q]; tscale = 1.05f + 0.05f * (float)(int)((double)tot / 100.0 / 64.0 + 0.5); }
#else
        float tscale; { tscale = 1.0f + 0.1f * (float)(int)((double)tms[TPROBE] / 100.0 / (double)TPBIN + 0.5); }
#endif
#endif
#if !(ATT_TIMING || TPROBE >= 0)
        if (NGW == 2048) {
            int dj = 0; if (lane < 16) dj = drow[2 * (gw + 2048 * (lane >> 1)) + (lane & 1)];
            f32x4 gt[4];
#pragma unroll
            for (int j = 0; j < 4; ++j) gt[j] = *(const f32x4*)(gate + 4 * lane + 256 * j);
            f32x4 xv[2][4]; u32x2 y0[2][4], y1[2][4];
#define F_ISSUE(it, b) { const int d0 = __builtin_amdgcn_readlane(dj, 2 * (it)), d1 = __builtin_amdgcn_readlane(dj, 2 * (it) + 1); \
                _Pragma("unroll") for (int j = 0; j < 4; ++j) { const int c0 = 4 * lane + 256 * j; xv[b][j] = *(const f32x4*)(xcur + (size_t)(gw + 2048 * (it)) * 1024 + c0); \
                    y0[b][j] = *(const u32x2*)(YG + (size_t)d0 * 1024 + c0); y1[b][j] = *(const u32x2*)(YG + (size_t)d1 * 1024 + c0); } }
            F_ISSUE(0, 0)
#pragma unroll
            for (int it = 0; it < 8; ++it) { const int b = it & 1;
                if (it + 1 < 8) { if (b) F_ISSUE(it + 1, 0) else F_ISSUE(it + 1, 1) }
                asm volatile("" ::: "memory");
#pragma unroll
                for (int j = 0; j < 4; ++j) { const u32x2 a0 = y0[b][j], a1 = y1[b][j]; f32x4 v = xv[b][j];
                    if (!((DBG_NO_MOE >> 3) & 1)) v = v + gt[j] * (f32x4){bflo(a0.x) + bflo(a1.x), bfhi(a0.x) + bfhi(a1.x), bflo(a0.y) + bflo(a1.y), bfhi(a0.y) + bfhi(a1.y)};
                    *(f32x4*)(args.out + (size_t)(gw + 2048 * it) * 1024 + 4 * lane + 256 * j) = v; }
                asm volatile("" ::: "memory");
            }
#undef F_ISSUE
        } else
#endif
        for (int m = gw; m < SEQ; m += NGW) {
            const int d0 = drow[2 * m], d1 = drow[2 * m + 1];
#pragma unroll
            for (int j = 0; j < 4; ++j) { const int c0 = 4 * lane + 256 * j;
                f32x4 v = *(const f32x4*)(xcur + (size_t)m * 1024 + c0);
                const u32x2 y0 = *(const u32x2*)(YG + (size_t)d0 * 1024 + c0), y1 = *(const u32x2*)(YG + (size_t)d1 * 1024 + c0);
                const f32x4 gt = *(const f32x4*)(gate + c0);
                if (!((DBG_NO_MOE >> 3) & 1)) v = v + gt * (f32x4){bflo(y0.x) + bflo(y1.x), bfhi(y0.x) + bfhi(y1.x), bflo(y0.y) + bflo(y1.y), bfhi(y0.y) + bfhi(y1.y)};
#if ATT_TIMING || TPROBE >= 0
                v = *(const f32x4*)(args.in[I_X] + (size_t)m * 1024 + c0);
#endif
#if TPROBE >= 0 || ATT_TIMING
                v = v * tscale;
#endif
                *(f32x4*)(args.out + (size_t)m * 1024 + c0) = v; }
        }
    }
#undef IN
#undef SEAM
}

#ifndef MK_PER_PHASE
#define MK_PER_PHASE 0
#endif
extern "C" void kernel_launch(void* const* d_in, const int* in_sizes, int n_in, void* d_out, int out_size, void* d_ws, size_t ws_size, hipStream_t stream) {
    static int grid = 0;
    if (grid == 0) {
        if (n_in != 28 || out_size != SEQ * DM || ws_size < WS_END) { fprintf(stderr, "kernel_launch: unexpected shapes (n_in %d, out %d, ws %zu)\n", n_in, out_size, ws_size); grid = -1; return; }
        int dev = 0, cus = 0;
        if (hipGetDevice(&dev) != hipSuccess || hipDeviceGetAttribute(&cus, hipDeviceAttributeMultiprocessorCount, dev) != hipSuccess) { grid = -1; return; }
        if (hipFuncSetAttribute((const void*)mega, hipFuncAttributeMaxDynamicSharedMemorySize, LDS_BYTES) != hipSuccess) { fprintf(stderr, "kernel_launch: hipFuncSetAttribute failed\n"); grid = -1; return; }
        (void)hipGetLastError();
        grid = cus < 256 ? cus : 256;
    }
    if (grid < 0) return;
    (void)hipMemsetAsync((char*)d_ws + WS_CTL, 0, CTL_ZERO_BYTES, stream);
    Args a{};
    for (int i = 0; i < 28; ++i) a.in[i] = (const float*)d_in[i];
    a.out = (float*)d_out; a.ws = (unsigned char*)d_ws;
#if MK_PER_PHASE
    for (int p = 0; p < NPH; ++p) { a.ph_lo = p; a.ph_hi = p + 1; hipLaunchKernelGGL(mega, dim3(grid), dim3(NTHREADS), LDS_BYTES, stream, a); }
#else
    a.ph_lo = 0; a.ph_hi = NPH; hipLaunchKernelGGL(mega, dim3(grid), dim3(NTHREADS), LDS_BYTES, stream, a);
#endif
}
```
